# Optimizing an MI355X kernel written in HIP

```python
import math
import jax, jax.numpy as jnp
from jax import lax
import numpy as np

D_MODEL = 1024
BATCH = 4
SEQ = 8192
DEPTH = 2

N_MIXERS = 2
N_HEADS = 8
HEAD_DIM = D_MODEL // N_HEADS
ATTN_WIDTH = N_HEADS * HEAD_DIM
BLOCK = 256
TOPK_BLOCKS = 3
QUERY_CHUNK = 32
CONV_WIDTH = 3
D_FF = int(math.ceil((8 * D_MODEL / 3) / 256) * 256)
N_ATTN_LAYERS = (DEPTH + 1) // 2
N_CONV_LAYERS = DEPTH // 2
EPS = 1e-6

kernel_name = "hybrid_moba_shortconv_adaln"


def rms_norm(x, gain):
    xf = x.astype(jnp.float32)
    y = xf * lax.rsqrt(jnp.mean(xf * xf, axis=-1, keepdims=True) + EPS)
    return (y * gain.astype(jnp.float32)).astype(x.dtype)


def modulate(x, gain, shift, scale):
    return rms_norm(x, gain) * (1 + scale[:, None, :]) + shift[:, None, :]


def moba_attention(h, w_qkv, w_o, q_gain, k_gain):
    B, S, _ = h.shape
    qkv = (h @ w_qkv).reshape(B, S, 3, N_HEADS, HEAD_DIM).transpose(2, 0, 3, 1, 4)
    q = rms_norm(qkv[0], q_gain) * (HEAD_DIM ** -0.5)
    k = rms_norm(qkv[1], k_gain)
    v = qkv[2]
    n_blocks = -(-S // BLOCK)
    pad = n_blocks * BLOCK - S
    kp = jnp.pad(k, ((0, 0), (0, 0), (0, pad), (0, 0)))
    vp = jnp.pad(v, ((0, 0), (0, 0), (0, pad), (0, 0)))
    k_blocks = kp.reshape(B, N_HEADS, n_blocks, BLOCK, HEAD_DIM)
    v_blocks = vp.reshape(B, N_HEADS, n_blocks, BLOCK, HEAD_DIM)
    k_mean = jnp.mean(k_blocks.astype(jnp.float32), axis=3).astype(k.dtype)
    n_sel = min(TOPK_BLOCKS, n_blocks)
    bi = jnp.arange(B)[:, None, None, None]
    hi = jnp.arange(N_HEADS)[None, :, None, None]
    blk_ids = jnp.arange(n_blocks)

    def chunk(ci):
        q0 = ci * QUERY_CHUNK
        nb = q0 // BLOCK
        qc = lax.dynamic_slice_in_dim(q, q0, QUERY_CHUNK, axis=2)
        k_own = lax.dynamic_slice_in_dim(kp, nb * BLOCK, BLOCK, axis=2)
        v_own = lax.dynamic_slice_in_dim(vp, nb * BLOCK, BLOCK, axis=2)
        route = jnp.einsum('bhqd,bhnd->bhqn', qc, k_mean).astype(jnp.float32)
        route = jnp.where(blk_ids < nb, route, -jnp.inf)
        _, idx = lax.top_k(route, n_sel)
        k_sel = k_blocks[bi, hi, idx]
        v_sel = v_blocks[bi, hi, idx]
        qpos = q0 + jnp.arange(QUERY_CHUNK)
        kpos = nb * BLOCK + jnp.arange(BLOCK)
        s_own = jnp.einsum('bhqd,bhkd->bhqk', qc, k_own).astype(jnp.float32)
        s_own = jnp.where(kpos[None, :] <= qpos[:, None], s_own, -jnp.inf)
        s_sel = jnp.einsum('bhqd,bhqjkd->bhqjk', qc, k_sel).astype(jnp.float32)
        slot_ok = jnp.arange(n_sel) < nb
        s_sel = jnp.where(slot_ok[:, None], s_sel, -jnp.inf)
        s_sel = s_sel.reshape(B, N_HEADS, QUERY_CHUNK, n_sel * BLOCK)
        p = jax.nn.softmax(jnp.concatenate([s_own, s_sel], axis=-1), axis=-1).astype(v.dtype)
        p_own = p[..., :BLOCK]
        p_sel = p[..., BLOCK:].reshape(B, N_HEADS, QUERY_CHUNK, n_sel, BLOCK)
        return (jnp.einsum('bhqk,bhkd->bhqd', p_own, v_own)
                + jnp.einsum('bhqjk,bhqjkd->bhqd', p_sel, v_sel))

    o = lax.map(chunk, jnp.arange(S // QUERY_CHUNK))
    o = o.transpose(1, 0, 3, 2, 4).reshape(B, S, ATTN_WIDTH)
    return o @ w_o


def short_conv(h, w_in, conv_w, w_out):
    S = h.shape[1]
    b_gate, c_gate, u = jnp.split(h @ w_in, 3, axis=-1)
    u = c_gate * u
    up = jnp.pad(u, ((0, 0), (CONV_WIDTH - 1, 0), (0, 0)))
    y = sum(conv_w[j] * up[:, j:j + S] for j in range(CONV_WIDTH))
    return (b_gate * y) @ w_out


def swiglu(h, w_gate_up, w_down):
    g, u = jnp.split(h @ w_gate_up, 2, axis=-1)
    return (jax.nn.silu(g) * u) @ w_down


def setup_inputs(seed: int = 0) -> dict:
    key = jax.random.key(seed)
    ks = jax.random.split(key, 16)
    f32 = jnp.float32
    nrm = lambda k, shape, s: (jax.random.normal(k, shape, f32) * s)
    return {
        "x": nrm(ks[0], (BATCH, SEQ, D_MODEL), 1.0),
        "c": nrm(ks[1], (BATCH, D_MODEL), 1.0),
        "w_ada": nrm(ks[2], (DEPTH, D_MODEL, 6 * D_MODEL), 0.5 * D_MODEL ** -0.5),
        "b_ada": nrm(ks[3], (DEPTH, 6 * D_MODEL), 0.02),
        "norm_mix": 1.0 + nrm(ks[4], (DEPTH, D_MODEL), 0.02),
        "norm_ffn": 1.0 + nrm(ks[5], (DEPTH, D_MODEL), 0.02),
        "w_qkv": nrm(ks[6], (N_ATTN_LAYERS, D_MODEL, 3 * ATTN_WIDTH), D_MODEL ** -0.5),
        "w_o": nrm(ks[7], (N_ATTN_LAYERS, ATTN_WIDTH, D_MODEL), ATTN_WIDTH ** -0.5),
        "q_gain": 1.0 + nrm(ks[8], (N_ATTN_LAYERS, HEAD_DIM), 0.02),
        "k_gain": 1.0 + nrm(ks[9], (N_ATTN_LAYERS, HEAD_DIM), 0.02),
        "w_in": nrm(ks[10], (N_CONV_LAYERS, D_MODEL, 3 * D_MODEL), D_MODEL ** -0.5),
        "conv_w": nrm(ks[11], (N_CONV_LAYERS, CONV_WIDTH, D_MODEL), CONV_WIDTH ** -0.5),
        "w_out": nrm(ks[12], (N_CONV_LAYERS, D_MODEL, D_MODEL), D_MODEL ** -0.5),
        "w_gate_up": nrm(ks[13], (DEPTH, D_MODEL, 2 * D_FF), D_MODEL ** -0.5),
        "w_down": nrm(ks[14], (DEPTH, D_FF, D_MODEL), D_FF ** -0.5),
    }


def reference(x, c, w_ada, b_ada, norm_mix, norm_ffn, w_qkv, w_o, q_gain, k_gain,
              w_in, conv_w, w_out, w_gate_up, w_down):
    sc = jax.nn.silu(c)
    for i in range(DEPTH):
        mod = sc @ w_ada[i] + b_ada[i]
        sh_m, sc_m, g_m, sh_f, sc_f, g_f = jnp.split(mod, 6, axis=-1)
        h = modulate(x, norm_mix[i], sh_m, sc_m)
        j = i // N_MIXERS
        if i % N_MIXERS == 0:
            y = moba_attention(h, w_qkv[j], w_o[j], q_gain[j], k_gain[j])
        else:
            y = short_conv(h, w_in[j], conv_w[j], w_out[j])
        x = x + g_m[:, None, :] * y
        h = modulate(x, norm_ffn[i], sh_f, sc_f)
        x = x + g_f[:, None, :] * swiglu(h, w_gate_up[i], w_down[i])
    return x
```

```cpp
#include <hip/hip_runtime.h>
#include <cstdio>
#include <cstdint>
namespace pg8 {
#define PG8_LAS __attribute__((address_space(3)))
typedef unsigned short bf16_t;
typedef short bf16x8 __attribute__((ext_vector_type(8)));
typedef float f32x4 __attribute__((ext_vector_type(4)));
typedef unsigned u32x4 __attribute__((ext_vector_type(4)));
constexpr int BM = 256, BK = 64, HALF = 128, HTB = HALF * BK * 2  , STAGE_BYTES = 8 * HTB, NXCD = 8, WGM = 8;

__host__ __device__ __forceinline__ int lds_byte(int r, int c) { const int st = (r >> 4) * 2 + (c >> 5), rr = r & 15, cc = c & 31, ob = rr * 64 + cc * 2; return st * 1024 + (ob ^ (((ob >> 9) & 1) << 5)); }
__host__ __device__ __forceinline__ void stage_rc(int b, int& R, int& C) { const int st = b / 1024, sb = b % 1024, swz = sb ^ (((sb >> 9) & 1) << 5); R = (st >> 1) * 16 + swz / 64; C = (st & 1) * 32 + (swz % 64) / 2; }
__host__ __device__ __forceinline__ int perm32(int rho) { const int n = rho >> 4, i = rho & 15; return 8 * (i >> 2) + 4 * n + (i & 3); }

struct Unit { int pm, pn; };
struct Gemm { const bf16_t* A; const bf16_t* Bt; int M, N, K; };

struct StaticOrder {
    int nM, nN, nwg, G, c;
    __host__ __device__ void init(int M, int N, int G_, int c_) { nM = M / BM; nN = N / BM; nwg = nM * nN; G = G_; c = c_; }
    __host__ __device__ bool next(int i, Unit& u) const {
        const long L = (long)i * G + c; if (L >= nwg) return false;
        int wgid = (int)L; { const int q = nwg / NXCD, r = nwg % NXCD, xcd = wgid % NXCD, off = wgid / NXCD; wgid = (xcd < r ? xcd * (q + 1) : r * (q + 1) + (xcd - r) * q) + off; }
        const int nig = WGM * nN, gid = wgid / nig, fm = gid * WGM, gsz = (nM - fm) < WGM ? (nM - fm) : WGM;
        u.pm = fm + ((wgid % nig) % gsz); u.pn = (wgid % nig) / gsz; return true;
    }
    __device__ __forceinline__ void a_ready(const Unit&) const {}
    __device__ __forceinline__ void done(const Unit&) const {}
};

__device__ __forceinline__ unsigned cvt_pk_bf16(float lo, float hi) { unsigned r; asm volatile("v_cvt_pk_bf16_f32 %0, %1, %2" : "=v"(r) : "v"(lo), "v"(hi)); return r; }
typedef float f32x2 __attribute__((ext_vector_type(2)));
__device__ __forceinline__ float silu_f(float x) { return x * __builtin_amdgcn_rcpf(1.0f + __builtin_amdgcn_exp2f(-1.4426950408889634f * x)); }
__device__ __forceinline__ u32x4 pack8(const f32x4 a, const f32x4 b) { u32x4 w; w.x = cvt_pk_bf16(a[0], a[1]); w.y = cvt_pk_bf16(a[2], a[3]); w.z = cvt_pk_bf16(b[0], b[1]); w.w = cvt_pk_bf16(b[2], b[3]); return w; }

struct EpiResid {
    static constexpr bool PERM = false, AFTER_DRAIN = false;
    const float* base; float* out; const float* gate;
    __device__ __forceinline__ void operator()(const f32x4 (&acc)[2][2][4][2], const Unit& u, int wr, int wc, int fr, int fq) const {
        asm volatile("" : "+v"(fr), "+v"(fq));
        const int b = u.pm >> 5, col0 = u.pn * BM + wc * 32 + 4 * fq;
        const float* gp = gate + (size_t)b * 6144 + col0;
        f32x4 gv[2][2];
#pragma unroll
        for (int bj = 0; bj < 2; ++bj)
#pragma unroll
            for (int n = 0; n < 2; ++n) gv[bj][n] = *(const f32x4*)(gp + bj * HALF + n * 16);
#pragma unroll
        for (int ai = 0; ai < 2; ++ai)
#pragma unroll
            for (int m = 0; m < 4; ++m) { const size_t off = (size_t)(u.pm * BM + ai * HALF + wr * 64 + m * 16 + fr) * 1024 + col0;
#pragma unroll
                for (int bj = 0; bj < 2; ++bj)
#pragma unroll
                    for (int n = 0; n < 2; ++n) { const f32x4 bs = *(const f32x4*)(base + off + bj * HALF + n * 16); const f32x4 o = bs + gv[bj][n] * acc[ai][bj][m][n]; *(f32x4*)(out + off + bj * HALF + n * 16) = o; }
                if (m & 1) asm volatile("" ::: "memory"); }
    }
};

struct EpiSwiglu {
    static constexpr bool PERM = true, AFTER_DRAIN = false;
    bf16_t* O; int ldc;
    __device__ __forceinline__ void operator()(const f32x4 (&acc)[2][2][4][2], const Unit& u, int wr, int wc, int fr, int fq) const {
        asm volatile("" : "+v"(fr), "+v"(fq));
        const int row0 = u.pm * BM + wr * 64 + fr, col0 = u.pn * HALF + wc * 32 + 8 * fq;
#pragma unroll
        for (int ai = 0; ai < 2; ++ai)
#pragma unroll
            for (int m = 0; m < 4; ++m) { bf16_t* rowp = O + (size_t)(row0 + ai * HALF + m * 16) * ldc + col0;
                f32x4 r0, r1;
#pragma unroll
                for (int e = 0; e < 4; ++e) { r0[e] = silu_f(acc[ai][0][m][0][e]) * acc[ai][1][m][0][e]; r1[e] = silu_f(acc[ai][0][m][1][e]) * acc[ai][1][m][1][e]; }
                *(u32x4*)rowp = pack8(r0, r1); }
    }
};

struct EpiConvIn {
    static constexpr bool PERM = true, AFTER_DRAIN = false;
    bf16_t* BG; bf16_t* UU;
    __device__ __forceinline__ void operator()(const f32x4 (&acc)[2][2][4][2], const Unit& u, int wr, int wc, int fr, int fq) const {
        asm volatile("" : "+v"(fr), "+v"(fq));
        const int row0 = u.pm * BM + wr * 64 + fr;
        if (u.pn < 4) {
            const int col0 = u.pn * BM + wc * 32 + 8 * fq;
#pragma unroll
            for (int ai = 0; ai < 2; ++ai)
#pragma unroll
                for (int m = 0; m < 4; ++m) { bf16_t* rowp = BG + (size_t)(row0 + ai * HALF + m * 16) * 1024 + col0;
#pragma unroll
                    for (int bj = 0; bj < 2; ++bj) *(u32x4*)(rowp + bj * HALF) = pack8(acc[ai][bj][m][0], acc[ai][bj][m][1]); }
        } else {
            const int col0 = (u.pn - 4) * HALF + wc * 32 + 8 * fq;
#pragma unroll
            for (int ai = 0; ai < 2; ++ai)
#pragma unroll
                for (int m = 0; m < 4; ++m) { bf16_t* rowp = UU + (size_t)(row0 + ai * HALF + m * 16) * 1024 + col0;
                    *(u32x4*)rowp = pack8(acc[ai][0][m][0] * acc[ai][1][m][0], acc[ai][0][m][1] * acc[ai][1][m][1]); }
        }
    }
};

struct EpiQKV {
    static constexpr bool PERM = true, AFTER_DRAIN = false;
    bf16_t *Q, *K, *V; const float *qg, *kg; PG8_LAS float* ss; float qscale;
    __device__ __forceinline__ void operator()(const f32x4 (&acc)[2][2][4][2], const Unit& u, int wr, int wc, int fr, int fq) const {
        asm volatile("" : "+v"(fr), "+v"(fq));
        const int t = u.pn >> 2, colt = (u.pn & 3) * BM;
        const int row0 = u.pm * BM + wr * 64 + fr, col0 = colt + wc * 32 + 8 * fq;
        if (t == 2) {
#pragma unroll
            for (int ai = 0; ai < 2; ++ai)
#pragma unroll
                for (int m = 0; m < 4; ++m) { bf16_t* rowp = V + (size_t)(row0 + ai * HALF + m * 16) * 1024 + col0;
#pragma unroll
                    for (int bj = 0; bj < 2; ++bj) *(u32x4*)(rowp + bj * HALF) = pack8(acc[ai][bj][m][0], acc[ai][bj][m][1]); }
            return;
        }
#pragma unroll
        for (int ai = 0; ai < 2; ++ai)
#pragma unroll
            for (int m = 0; m < 4; ++m)
#pragma unroll
                for (int bj = 0; bj < 2; ++bj) { const f32x4 a = acc[ai][bj][m][0], b = acc[ai][bj][m][1];
                    float s = (a[0] * a[0] + a[1] * a[1]) + (a[2] * a[2] + a[3] * a[3]) + (b[0] * b[0] + b[1] * b[1]) + (b[2] * b[2] + b[3] * b[3]);
                    s += __shfl_xor(s, 16); s += __shfl_xor(s, 32);
                    if (fq == 0) ss[(ai * HALF + wr * 64 + m * 16 + fr) * 8 + bj * 4 + wc] = s; }
        asm volatile("s_waitcnt lgkmcnt(0)" ::: "memory"); __builtin_amdgcn_s_barrier(); asm volatile("" ::: "memory");
        const float* gain = (t == 0) ? qg : kg; const float sc = (t == 0) ? qscale : 1.0f;
        const f32x4 g0 = *(const f32x4*)(gain + wc * 32 + 8 * fq) * sc, g1 = *(const f32x4*)(gain + wc * 32 + 8 * fq + 4) * sc;
        bf16_t* base = (t == 0) ? Q : K;
#pragma unroll
        for (int ai = 0; ai < 2; ++ai)
#pragma unroll
            for (int m = 0; m < 4; ++m) { const int r = ai * HALF + wr * 64 + m * 16 + fr; bf16_t* rowp = base + (size_t)(u.pm * BM + r) * 1024 + col0;
#pragma unroll
                for (int bj = 0; bj < 2; ++bj) { const f32x4 p = *(const PG8_LAS f32x4*)(ss + r * 8 + bj * 4);
                    const float rstd = __builtin_amdgcn_rsqf(((p[0] + p[1]) + (p[2] + p[3])) * (1.0f / 128.0f) + 1e-6f);
                    const f32x4 v0 = acc[ai][bj][m][0] * rstd * g0, v1 = acc[ai][bj][m][1] * rstd * g1;
                    *(u32x4*)(rowp + bj * HALF) = pack8(v0, v1); }
                asm volatile("" ::: "memory"); }
    }
};

template <class Epi, class Sched, bool ALIGN_EPI = false, bool SP2 = false>
__device__ __forceinline__ void gemm_phase(PG8_LAS unsigned char* lds, const Gemm g, const Sched& S, const Epi& E) {
    const int tid = threadIdx.x, wid = __builtin_amdgcn_readfirstlane(tid >> 6), lane = tid & 63, wr = wid >> 2, wc = wid & 3, fr = lane & 15, fq = lane >> 4;
    const int K = g.K, nt = K / BK;
    unsigned voffA[2], voffB[2];
#pragma unroll
    for (int i = 0; i < 2; ++i) { int R, C; stage_rc(tid * 16 + i * 8192, R, C); const int Rb = Epi::PERM ? ((R & ~31) + perm32(R & 31)) : R;
        voffA[i] = (unsigned)(R * K + C) * 2u; voffB[i] = (unsigned)(Rb * K + C) * 2u; }
    const size_t kstep = (size_t)(BK * 2);
    const size_t hstep = (size_t)HALF * K * 2;
    const size_t tstep = 2 * hstep;
    const unsigned ldsw = (unsigned)wid * 1024u;
    const int aoff = lds_byte(wr * 64 + fr, fq * 8), boff = lds_byte(wc * 32 + fr, fq * 8);
#define PG8_SA(b, h) (((b) * 2 + (h)) * HTB)
#define PG8_SB(b, h) ((4 + (b) * 2 + (h)) * HTB)
#define PG8_STAGE(bufoff, gbase, voff) do { _Pragma("unroll") for (int _i = 0; _i < 2; ++_i) \
        __builtin_amdgcn_global_load_lds((const unsigned*)((const char*)(gbase) + (voff)[_i]), (PG8_LAS unsigned*)(lds + (bufoff) + ldsw + _i * 8192), 16, 0, 0); } while (0)
#define PG8_LDA(dst, b, h) do { _Pragma("unroll") for (int m = 0; m < 4; ++m) _Pragma("unroll") for (int k = 0; k < 2; ++k) dst[m][k] = *(const PG8_LAS bf16x8*)(lds + PG8_SA(b, h) + aoff + m * 2048 + k * 1024); } while (0)
#define PG8_LDB(dst, b, h) do { _Pragma("unroll") for (int n = 0; n < 2; ++n) _Pragma("unroll") for (int k = 0; k < 2; ++k) dst[n][k] = *(const PG8_LAS bf16x8*)(lds + PG8_SB(b, h) + boff + n * 2048 + k * 1024); } while (0)
#define PG8_MMA(ai, bj, At, Bt) do { __builtin_amdgcn_s_setprio(1); _Pragma("unroll") for (int m = 0; m < 4; ++m) _Pragma("unroll") for (int n = 0; n < 2; ++n) _Pragma("unroll") for (int k = 0; k < 2; ++k) \
        acc[ai][bj][m][n] = __builtin_amdgcn_mfma_f32_16x16x32_bf16(Bt[n][k], At[m][k], acc[ai][bj][m][n], 0, 0, 0); __builtin_amdgcn_s_setprio(0); } while (0)
#define PG8_WAIT_V(n) asm volatile("s_waitcnt vmcnt(" #n ")" ::: "memory")
#define PG8_WAIT_L(n) asm volatile("s_waitcnt lgkmcnt(" #n ")" ::: "memory")
#define PG8_BAR __builtin_amdgcn_s_barrier()
#define PG8_SCHED __builtin_amdgcn_sched_barrier(0)
    Unit cur, nxt; int ui = 0;
    if (!S.next(0, cur)) return;
    f32x4 acc[2][2][4][2];
#pragma unroll
    for (int a = 0; a < 2; ++a)
#pragma unroll
        for (int b = 0; b < 2; ++b)
#pragma unroll
            for (int m = 0; m < 4; ++m)
#pragma unroll
                for (int n = 0; n < 2; ++n) acc[a][b][m][n] = (f32x4){0.f, 0.f, 0.f, 0.f};
    bf16x8 At[4][2], B0[2][2], B1[2][2];
    const char* cA = (const char*)g.A + (size_t)cur.pm * tstep; const char* cB = (const char*)g.Bt + (size_t)cur.pn * tstep;
    S.a_ready(cur);
    if constexpr (SP2) {
        PG8_STAGE(PG8_SB(0, 0), cB, voffB); PG8_STAGE(PG8_SB(0, 1), cB + hstep, voffB); PG8_STAGE(PG8_SA(0, 0), cA, voffA); PG8_STAGE(PG8_SA(0, 1), cA + hstep, voffA);
        if (wr == 1) PG8_BAR;
        PG8_WAIT_V(2); PG8_BAR;
        PG8_STAGE(PG8_SB(1, 0), cB + kstep, voffB); PG8_STAGE(PG8_SA(1, 0), cA + kstep, voffA); PG8_STAGE(PG8_SB(1, 1), cB + hstep + kstep, voffB);
        PG8_WAIT_V(6); PG8_BAR;
    } else {
        PG8_STAGE(PG8_SB(0, 0), cB, voffB); PG8_STAGE(PG8_SA(0, 0), cA, voffA); PG8_STAGE(PG8_SB(0, 1), cB + hstep, voffB); PG8_STAGE(PG8_SA(0, 1), cA + hstep, voffA);
        if (wr == 1) PG8_BAR;
        PG8_WAIT_V(4); PG8_BAR;
        PG8_STAGE(PG8_SB(1, 0), cB + kstep, voffB); PG8_STAGE(PG8_SA(1, 0), cA + kstep, voffA); PG8_STAGE(PG8_SB(1, 1), cB + hstep + kstep, voffB);
        PG8_WAIT_V(6); PG8_BAR;
    }
    for (;;) {
        const bool has_next = S.next(ui + 1, nxt);
        const char* nA = has_next ? (const char*)g.A + (size_t)nxt.pm * tstep : cA; const char* nB = has_next ? (const char*)g.Bt + (size_t)nxt.pn * tstep : cB;
        for (int t = 0; t < nt; t += 2) {
            const bool last = (t == nt - 2);
            const char* a1 = cA + (size_t)(t + 1) * kstep;
            const char* a2 = last ? nA : cA + (size_t)(t + 2) * kstep; const char* b2 = last ? nB : cB + (size_t)(t + 2) * kstep;
            const char* a3 = a2 + kstep; const char* b3 = b2 + kstep;
            if (last && has_next) S.a_ready(nxt);
            if constexpr (SP2) {
            PG8_LDB(B0, 0, 0); PG8_LDB(B1, 0, 1); PG8_SCHED; PG8_LDA(At, 0, 0); PG8_STAGE(PG8_SA(1, 1), a1 + hstep, voffA);
            PG8_WAIT_V(8); PG8_WAIT_L(0); PG8_BAR; PG8_MMA(0, 0, At, B0); PG8_MMA(0, 1, At, B1); PG8_BAR; PG8_SCHED;
            PG8_LDA(At, 0, 1); PG8_STAGE(PG8_SB(0, 0), b2, voffB); PG8_STAGE(PG8_SB(0, 1), b2 + hstep, voffB); PG8_STAGE(PG8_SA(0, 0), a2, voffA);
            PG8_WAIT_V(8); PG8_WAIT_L(0); PG8_BAR; PG8_MMA(1, 0, At, B0); PG8_MMA(1, 1, At, B1); PG8_BAR; PG8_SCHED;
            PG8_LDB(B0, 1, 0); PG8_LDB(B1, 1, 1); PG8_SCHED; PG8_LDA(At, 1, 0); PG8_STAGE(PG8_SA(0, 1), a2 + hstep, voffA);
            PG8_WAIT_V(8); PG8_WAIT_L(0); PG8_BAR; PG8_MMA(0, 0, At, B0); PG8_MMA(0, 1, At, B1); PG8_BAR; PG8_SCHED;
            PG8_LDA(At, 1, 1); PG8_STAGE(PG8_SB(1, 0), b3, voffB); PG8_STAGE(PG8_SB(1, 1), b3 + hstep, voffB); PG8_STAGE(PG8_SA(1, 0), a3, voffA);
            PG8_WAIT_V(8); PG8_WAIT_L(0); PG8_BAR; PG8_MMA(1, 0, At, B0); PG8_MMA(1, 1, At, B1); PG8_BAR; PG8_SCHED;
            } else {
            PG8_LDB(B0, 0, 0); PG8_SCHED; PG8_LDA(At, 0, 0); PG8_STAGE(PG8_SA(1, 1), a1 + hstep, voffA);
            PG8_WAIT_L(8); PG8_BAR; PG8_WAIT_L(0); PG8_MMA(0, 0, At, B0); PG8_BAR; PG8_SCHED;
            PG8_LDB(B1, 0, 1); PG8_STAGE(PG8_SB(0, 0), b2, voffB);
            PG8_BAR; PG8_WAIT_L(0); PG8_MMA(0, 1, At, B1); PG8_BAR;
            PG8_LDA(At, 0, 1); PG8_STAGE(PG8_SA(0, 0), a2, voffA);
            PG8_BAR; PG8_WAIT_L(0); PG8_MMA(1, 0, At, B0); PG8_BAR; PG8_SCHED;
            PG8_STAGE(PG8_SB(0, 1), b2 + hstep, voffB);
            PG8_WAIT_V(6); PG8_BAR; PG8_MMA(1, 1, At, B1); PG8_BAR;
            PG8_LDB(B0, 1, 0); PG8_SCHED; PG8_LDA(At, 1, 0); PG8_STAGE(PG8_SA(0, 1), a2 + hstep, voffA);
            PG8_WAIT_L(8); PG8_BAR; PG8_WAIT_L(0); PG8_MMA(0, 0, At, B0); PG8_BAR; PG8_SCHED;
            PG8_LDB(B1, 1, 1); PG8_STAGE(PG8_SB(1, 0), b3, voffB);
            PG8_BAR; PG8_WAIT_L(0); PG8_MMA(0, 1, At, B1); PG8_BAR;
            PG8_LDA(At, 1, 1); PG8_STAGE(PG8_SA(1, 0), a3, voffA);
            PG8_BAR; PG8_WAIT_L(0); PG8_MMA(1, 0, At, B0); PG8_BAR; PG8_SCHED;
            PG8_STAGE(PG8_SB(1, 1), b3 + hstep, voffB);
            PG8_WAIT_V(6); PG8_BAR; PG8_MMA(1, 1, At, B1); PG8_BAR;
            }
        }
        if constexpr (ALIGN_EPI) { if (wr == 0) PG8_BAR; }
        if constexpr (!Epi::AFTER_DRAIN) { E(acc, cur, wr, wc, fr, fq); S.done(cur); }
        if (!has_next) break;
#pragma unroll
        for (int a = 0; a < 2; ++a)
#pragma unroll
            for (int b = 0; b < 2; ++b)
#pragma unroll
                for (int m = 0; m < 4; ++m)
#pragma unroll
                    for (int n = 0; n < 2; ++n) acc[a][b][m][n] = (f32x4){0.f, 0.f, 0.f, 0.f};
        cur = nxt; cA = nA; cB = nB; ++ui;
        if constexpr (ALIGN_EPI) { if (wr == 1) PG8_BAR; }
    }
    PG8_WAIT_V(0);
    if constexpr (!ALIGN_EPI) { if (wr == 0) PG8_BAR; }
    PG8_BAR;
    if constexpr (Epi::AFTER_DRAIN) { E.fused(acc, cur, wr, wc, fr, fq, lds, wid, lane); S.done(cur); }
#undef PG8_SA
#undef PG8_SB
#undef PG8_STAGE
#undef PG8_LDA
#undef PG8_LDB
#undef PG8_MMA
#undef PG8_WAIT_V
#undef PG8_WAIT_L
#undef PG8_BAR
#undef PG8_SCHED
}
}
#define GAS __attribute__((address_space(1)))
#define LAS __attribute__((address_space(3)))
typedef unsigned short bf16;
typedef unsigned v4u __attribute__((ext_vector_type(4)));
typedef float f32x4 __attribute__((ext_vector_type(4)));
typedef short bf16x8 __attribute__((ext_vector_type(8)));
typedef GAS unsigned gu32;
typedef GAS unsigned long long gu64;
#define RLX_AGENT __ATOMIC_RELAXED, __HIP_MEMORY_SCOPE_AGENT
#define LDS_WAIT() asm volatile("s_waitcnt lgkmcnt(0)" ::: "memory")
#define VM_WAIT() asm volatile("s_waitcnt vmcnt(0)" ::: "memory")
__device__ __forceinline__ unsigned long long rt() { return __builtin_amdgcn_s_memrealtime(); }
__device__ __forceinline__ unsigned f2bf(float f) { unsigned u = __builtin_bit_cast(unsigned, f); return (u + 0x7fffu + ((u >> 16) & 1u)) >> 16; }
__device__ __forceinline__ unsigned pk2(float lo, float hi) { return f2bf(lo) | (f2bf(hi) << 16); }

#define XB_TMO      128
#define XB_XCNT(j)  (256  + 64 * (j))
#define XB_XSUB(j)  (1280 + 64 * (j))
#define XB_XGEN(j)  (2304 + 64 * (j))
#define XB_TOP      3328
#define XB_TOPGEN   3392
#define XCD_BAR_WORDS 3456
#define XB_SPIN_CAP (1u << 18)

__device__ __forceinline__ unsigned xb_ld(unsigned* p)              { return __hip_atomic_load(p, __ATOMIC_RELAXED, __HIP_MEMORY_SCOPE_AGENT); }
__device__ __forceinline__ unsigned xb_add(unsigned* p, unsigned v) { return __hip_atomic_fetch_add(p, v, __ATOMIC_RELAXED, __HIP_MEMORY_SCOPE_AGENT); }
__device__ __forceinline__ unsigned xb_xcc_id() { return (unsigned)__builtin_amdgcn_s_getreg((3 << 11) | 20) & 0xFu; }
#define XB_SPIN(cond, bar) do { unsigned _sp = 0; while (cond) { __builtin_amdgcn_s_sleep(1); \
    if ((++_sp & 255u) == 0u) { if (xb_ld(&(bar)[XB_TMO])) break; if (_sp > XB_SPIN_CAP) { atomicAdd(&(bar)[XB_TMO], 1u); break; } } } } while (0)

struct XcdBarrier {
    unsigned* bar; unsigned x;
    volatile LAS unsigned* st;
};

__device__ __forceinline__ XcdBarrier xcd_barrier_post(unsigned* bar, volatile LAS unsigned* st) {
    XcdBarrier b; b.bar = bar; b.x = xb_xcc_id(); b.st = st;
    if (threadIdx.x == 0) (void)xb_add(&bar[XB_XCNT(b.x)], 1u);
    return b;
}
__device__ __forceinline__ void xcd_barrier_complete(unsigned* bar, unsigned x, unsigned& nloc, unsigned& nx) {
    const unsigned G = gridDim.x * gridDim.y * gridDim.z;
    unsigned sum, cnt, mine, sp = 0u;
    for (;;) {
        sum = 0u; cnt = 0u; mine = 0u;
#pragma unroll
        for (unsigned j = 0; j < 16; ++j) { const unsigned c = xb_ld(&bar[XB_XCNT(j)]); sum += c; cnt += (c > 0u) ? 1u : 0u; mine = (j == x) ? c : mine; }
        if (sum == G) break;
        __builtin_amdgcn_s_sleep(1);
        if ((++sp & 255u) == 0u) { if (xb_ld(&bar[XB_TMO])) break; if (sp > XB_SPIN_CAP) { atomicAdd(&bar[XB_TMO], 1u); break; } }
    }
    nloc = mine > 0u ? mine : 1u; nx = cnt > 0u ? cnt : 1u;
}

__device__ __forceinline__ void xcd_barrier(const XcdBarrier& b) {
    asm volatile("s_waitcnt vmcnt(0)" ::: "memory");
    __syncthreads();
    if (threadIdx.x == 0) {
        unsigned* bar = b.bar;
        __builtin_amdgcn_s_waitcnt(0);
        unsigned nloc = b.st[0], nx = b.st[1];
        if (nloc == 0u) { xcd_barrier_complete(bar, b.x, nloc, nx); b.st[0] = nloc; b.st[1] = nx; }
        const unsigned old = xb_add(&bar[XB_XSUB(b.x)], 1u);
        const unsigned gen = old / nloc;
        if (old + 1u == (gen + 1u) * nloc) {
            __builtin_amdgcn_fence(__ATOMIC_RELEASE, "agent");
            asm volatile("s_waitcnt vmcnt(0)" ::: "memory");
            const unsigned og = xb_add(&bar[XB_TOP], 1u);
            const unsigned tg = og / nx;
            if (og + 1u == (tg + 1u) * nx) xb_add(&bar[XB_TOPGEN], 1u);
            else XB_SPIN(xb_ld(&bar[XB_TOPGEN]) == tg, bar);
            __builtin_amdgcn_fence(__ATOMIC_ACQUIRE, "agent");
            xb_add(&bar[XB_XGEN(b.x)], 1u);
            asm volatile("s_waitcnt vmcnt(0)" ::: "memory");
        } else {
            XB_SPIN(xb_ld(&bar[XB_XGEN(b.x)]) == gen, bar);
            __builtin_amdgcn_fence(__ATOMIC_ACQUIRE, "agent");
            asm volatile("s_waitcnt vmcnt(0)" ::: "memory");
        }
    }
    __syncthreads();
}

constexpr int NBATCH = 4, SEQ = 8192, DM = 1024, NH = 8, HD = 128, M = NBATCH * SEQ, FF = 2816, NBLK = 32;
constexpr int NWAVES = 8, NT = NWAVES * 64;
constexpr int MODW = 6 * DM;
constexpr float QSCALE = 0.08838834764831845f * 1.4426950408889634f;
constexpr int LCAP = 8192;

constexpr size_t MiB = 1u << 20;
constexpr size_t WS_CTL = 0, CTL_ZERO_BYTES = 64 * 1024;
constexpr size_t WS_MOD = 1 * MiB;
constexpr size_t WS_KMEAN = 1 * MiB + 512 * 1024;
constexpr size_t WS_WQKV = 2 * MiB, WS_WO = 8 * MiB, WS_WIN = 10 * MiB, WS_WOUT = 16 * MiB, WS_WGU0 = 18 * MiB, WS_WGU1 = 29 * MiB, WS_WDN0 = 40 * MiB, WS_WDN1 = 46 * MiB;
constexpr size_t WS_LSE = 52 * MiB;
constexpr size_t WS_H = 56 * MiB;
constexpr size_t WS_Q = 120 * MiB, WS_K = 184 * MiB, WS_V = 248 * MiB;
constexpr size_t WS_POB = 312 * MiB;
constexpr size_t WS_LIST = 440 * MiB;
constexpr size_t WS_END = 472 * MiB;
constexpr size_t WS_ACT = 120 * MiB;
constexpr size_t WS_BG = 120 * MiB, WS_UU = 184 * MiB, WS_Z = 248 * MiB;
constexpr int CW_QCTR = 64, CW_BAR = 4096, CW_LCNT = 8192;
static_assert((CW_LCNT + 1024) * 4 <= (int)CTL_ZERO_BYTES && CW_BAR + XCD_BAR_WORDS <= CW_LCNT, "CTL map");

constexpr int RING_BYTES = 131072, EPI_OFF = RING_BYTES, EPI_BYTES = 10240, MISC_OFF = EPI_OFF + EPI_BYTES, LDS_BYTES = 147456;

struct Ctx { LAS unsigned char* lds; volatile LAS unsigned* misc; int tid, lane, wave, vcu, G; };

__device__ __forceinline__ float wave_sum(float v) {
#pragma unroll
    for (int o = 1; o < 64; o <<= 1) v += __shfl_xor(v, o);
    return v;
}
__device__ __forceinline__ float bf_lo(unsigned u) { return __uint_as_float(u << 16); }
__device__ __forceinline__ float bf_hi(unsigned u) { return __uint_as_float(u & 0xffff0000u); }

__device__ __forceinline__ void transpose_item(const float* W, int K, int N, bf16* WT, int k0, int n0, int drow0, LAS float* scr, int lane) {
#pragma unroll 8
    for (int i = 0; i < 32; ++i) { const int kk = 2 * i + (lane >> 5); scr[kk * 33 + (lane & 31)] = W[(size_t)(k0 + kk) * N + n0 + (lane & 31)]; }
    LDS_WAIT(); asm volatile("" ::: "memory");
    const int c = lane & 7;
#pragma unroll
    for (int j = 0; j < 4; ++j) { const int n = (lane >> 3) + 8 * j; const LAS float* s = scr + (8 * c) * 33 + n;
        v4u o; o.x = pk2(s[0 * 33], s[1 * 33]); o.y = pk2(s[2 * 33], s[3 * 33]); o.z = pk2(s[4 * 33], s[5 * 33]); o.w = pk2(s[6 * 33], s[7 * 33]);
        *(GAS v4u*)(WT + (size_t)(drow0 + n) * K + k0 + 8 * c) = o; }
    LDS_WAIT(); asm volatile("" ::: "memory");
}
__device__ __forceinline__ int pair_row(int n, int seg) { return 256 * (n >> 7) + 128 * seg + (n & 127); }

__device__ __forceinline__ void p0_prologue(const Ctx& C, const float* const* in, unsigned char* ws) {
    LAS float* scr = (LAS float*)(C.lds + C.wave * 16384);
    if (C.wave == 0 && C.vcu < 192) {
        const float* cin = in[1]; const float* w_ada = in[2]; const float* b_ada = in[3]; float* mod = (float*)(ws + WS_MOD);
#pragma unroll
        for (int j = 0; j < 16; ++j) { const int k = C.lane + 64 * j;
#pragma unroll
            for (int b = 0; b < 4; ++b) { const float x = cin[b * DM + k]; scr[k * 4 + b] = x / (1.0f + __expf(-x)); } }
        LDS_WAIT(); asm volatile("" ::: "memory");
        const int l = C.vcu / 96, col = (C.vcu % 96) * 64 + C.lane;
        const float* W = w_ada + (size_t)l * DM * MODW + col;
        float a0 = 0.f, a1 = 0.f, a2 = 0.f, a3 = 0.f;
        for (int k0 = 0; k0 < DM; k0 += 16) {
            float w[16];
#pragma unroll
            for (int j = 0; j < 16; ++j) w[j] = W[(size_t)(k0 + j) * MODW];
#pragma unroll
            for (int j = 0; j < 16; ++j) { const f32x4 s = *(const LAS f32x4*)(scr + (k0 + j) * 4); a0 += s[0] * w[j]; a1 += s[1] * w[j]; a2 += s[2] * w[j]; a3 += s[3] * w[j]; }
        }
        const float bb = b_ada[l * MODW + col];
        mod[(size_t)(l * 4 + 0) * MODW + col] = a0 + bb; mod[(size_t)(l * 4 + 1) * MODW + col] = a1 + bb;
        mod[(size_t)(l * 4 + 2) * MODW + col] = a2 + bb; mod[(size_t)(l * 4 + 3) * MODW + col] = a3 + bb;
        LDS_WAIT(); asm volatile("" ::: "memory");
    }
    const int gw = C.vcu * NWAVES + C.wave, NGW = C.G * NWAVES;
    constexpr int I_QKV = 16 * 96, I_O = 16 * 32, I_IN = 16 * 96, I_OUT = 16 * 32, I_GU = 16 * 176, I_DN = 44 * 32;
    constexpr int NITEMS = I_QKV + I_O + I_IN + I_OUT + 2 * I_GU + 2 * I_DN;
    for (int it = gw; it < NITEMS; it += NGW) {
        int r = it;
        if (r < I_QKV) { const int kb = r / 96, nb = r % 96; transpose_item(in[6], DM, 3 * DM, (bf16*)(ws + WS_WQKV), 64 * kb, 32 * nb, 32 * nb, scr, C.lane); continue; } r -= I_QKV;
        if (r < I_O) { const int kb = r / 32, nb = r % 32; transpose_item(in[7], DM, DM, (bf16*)(ws + WS_WO), 64 * kb, 32 * nb, 32 * nb, scr, C.lane); continue; } r -= I_O;
        if (r < I_IN) { const int kb = r / 96, nb = r % 96, n0 = 32 * nb;
            const int drow = n0 < DM ? n0 : (n0 < 2 * DM ? DM + pair_row(n0 - DM, 0) : DM + pair_row(n0 - 2 * DM, 1));
            transpose_item(in[10], DM, 3 * DM, (bf16*)(ws + WS_WIN), 64 * kb, n0, drow, scr, C.lane); continue; } r -= I_IN;
        if (r < I_OUT) { const int kb = r / 32, nb = r % 32; transpose_item(in[12], DM, DM, (bf16*)(ws + WS_WOUT), 64 * kb, 32 * nb, 32 * nb, scr, C.lane); continue; } r -= I_OUT;
        if (r < 2 * I_GU) { const int l = r / I_GU; r -= l * I_GU; const int kb = r / 176, nb = r % 176, n0 = 32 * nb;
            const int drow = n0 < FF ? pair_row(n0, 0) : pair_row(n0 - FF, 1);
            transpose_item(in[13] + (size_t)l * DM * 2 * FF, DM, 2 * FF, (bf16*)(ws + (l ? WS_WGU1 : WS_WGU0)), 64 * kb, n0, drow, scr, C.lane); continue; } r -= 2 * I_GU;
        { const int l = r / I_DN; r -= l * I_DN; const int kb = r / 32, nb = r % 32;
            transpose_item(in[14] + (size_t)l * FF * DM, FF, DM, (bf16*)(ws + (l ? WS_WDN1 : WS_WDN0)), 64 * kb, 32 * nb, 32 * nb, scr, C.lane); }
    }
}

__device__ __forceinline__ void modulate_phase(const Ctx& C, const float* X, const float* gain, const float* modl, int sh_off, int sc_off, bf16* Hout) {
    const int gw = C.vcu * NWAVES + C.wave, NGW = C.G * NWAVES;
    for (int rg = gw; rg < M / 16; rg += NGW) {
        const int row0 = rg * 16, b = row0 >> 13;
        f32x4 Gv[4], Sv[4];
#pragma unroll
        for (int j = 0; j < 4; ++j) { const int col = 4 * C.lane + 256 * j;
            const f32x4 g = *(const f32x4*)(gain + col), sc = *(const f32x4*)(modl + (size_t)b * MODW + sc_off + col);
            Gv[j] = g * (sc + 1.0f); Sv[j] = *(const f32x4*)(modl + (size_t)b * MODW + sh_off + col); }
#pragma unroll 2
        for (int r = 0; r < 16; ++r) {
            const GAS f32x4* xr = (const GAS f32x4*)(X + (size_t)(row0 + r) * DM) + C.lane;
            f32x4 v[4]; float s = 0.f;
#pragma unroll
            for (int j = 0; j < 4; ++j) { v[j] = xr[64 * j]; s += (v[j].x * v[j].x + v[j].y * v[j].y) + (v[j].z * v[j].z + v[j].w * v[j].w); }
            const float rstd = __builtin_amdgcn_rsqf(wave_sum(s) * (1.0f / DM) + 1e-6f);
            GAS unsigned long long* o8 = (GAS unsigned long long*)(Hout + (size_t)(row0 + r) * DM) + C.lane;
#pragma unroll
            for (int j = 0; j < 4; ++j) { const f32x4 o = v[j] * rstd * Gv[j] + Sv[j];
                o8[64 * j] = (unsigned long long)pk2(o.x, o.y) | ((unsigned long long)pk2(o.z, o.w) << 32); }
        }
    }
}

__device__ __forceinline__ void kmean_phase(const Ctx& C, const bf16* Kb, float* kmean) {
    LAS float* part = (LAS float*)C.lds;
    const int ch = C.tid & 15, rg = C.tid >> 4;
    for (int u = C.vcu; u < 1024; u += C.G) {
        const int bh = u >> 5, j = u & 31, b = bh >> 3, h = bh & 7;
        const bf16* Kg = Kb + (size_t)(b * SEQ + j * 256 + rg * 8) * DM + h * HD + ch * 8;
        float a[8];
#pragma unroll
        for (int e = 0; e < 8; ++e) a[e] = 0.f;
#pragma unroll
        for (int r = 0; r < 8; ++r) { const v4u w = *(const v4u*)(Kg + (size_t)r * DM);
            a[0] += bf_lo(w.x); a[1] += bf_hi(w.x); a[2] += bf_lo(w.y); a[3] += bf_hi(w.y); a[4] += bf_lo(w.z); a[5] += bf_hi(w.z); a[6] += bf_lo(w.w); a[7] += bf_hi(w.w); }
        __syncthreads();
        *(LAS f32x4*)(part + rg * 128 + ch * 8) = (f32x4){a[0], a[1], a[2], a[3]}; *(LAS f32x4*)(part + rg * 128 + ch * 8 + 4) = (f32x4){a[4], a[5], a[6], a[7]};
        __syncthreads();
        if (C.tid < 128) { float s = 0.f;
#pragma unroll 8
            for (int g = 0; g < 32; ++g) s += part[g * 128 + C.tid];
            kmean[(size_t)(bh * 32 + j) * 128 + C.tid] = s * (1.0f / 256.0f); }
    }
}

__device__ __forceinline__ void route_phase(const Ctx& C, const bf16* Qb, const float* kmean, unsigned* lists, gu32* lcnt) {
    LAS float* kml = (LAS float*)C.lds;
    for (int u = C.vcu; u < 512; u += C.G) {
        const int bh = u >> 4, qc = u & 15, b = bh >> 3, h = bh & 7;
        const int s = qc * 512 + C.tid, nb = __builtin_amdgcn_readfirstlane(s >> 8);
        __syncthreads();
        for (int i = C.tid; i < 1024; i += NT) ((LAS f32x4*)kml)[i] = ((const f32x4*)(kmean + (size_t)bh * 4096))[i];
        __syncthreads();
        float q[128];
        { const v4u* qp = (const v4u*)(Qb + (size_t)(b * SEQ + s) * DM + h * HD);
#pragma unroll
            for (int i = 0; i < 16; ++i) { const v4u w = qp[i];
                q[8 * i + 0] = bf_lo(w.x); q[8 * i + 1] = bf_hi(w.x); q[8 * i + 2] = bf_lo(w.y); q[8 * i + 3] = bf_hi(w.y);
                q[8 * i + 4] = bf_lo(w.z); q[8 * i + 5] = bf_hi(w.z); q[8 * i + 6] = bf_lo(w.w); q[8 * i + 7] = bf_hi(w.w); } }
        const float NEG = -__builtin_inff();
        float v0 = NEG, v1 = NEG, v2 = NEG; int i0 = -1, i1 = -1, i2 = -1;
        for (int j = 0; j < nb; ++j) {
            const LAS f32x4* kr = (const LAS f32x4*)(kml + j * 128);
            float a0 = 0.f, a1 = 0.f, a2 = 0.f, a3 = 0.f;
#pragma unroll
            for (int d = 0; d < 32; ++d) { const f32x4 k = kr[d]; a0 += q[4 * d] * k[0]; a1 += q[4 * d + 1] * k[1]; a2 += q[4 * d + 2] * k[2]; a3 += q[4 * d + 3] * k[3]; }
            const float sc = (a0 + a1) + (a2 + a3);
            if (sc > v2) {
                if (sc > v1) { v2 = v1; i2 = i1; if (sc > v0) { v1 = v0; i1 = i0; v0 = sc; i0 = j; } else { v1 = sc; i1 = j; } }
                else { v2 = sc; i2 = j; }
            }
        }
        unsigned long long mymask = 0ull;
        for (int jj = 0; jj < nb; ++jj) { const bool hit = (i0 == jj) | (i1 == jj) | (i2 == jj); const unsigned long long mk = __ballot(hit); if (C.lane == jj) mymask = mk; }
        const int n = __popcll(mymask); unsigned base = 0u;
        if (C.lane < nb && n > 0) base = __hip_atomic_fetch_add(lcnt + bh * 32 + C.lane, (unsigned)n, __ATOMIC_RELAXED, __HIP_MEMORY_SCOPE_AGENT);
        const unsigned long long below = (1ull << C.lane) - 1ull;
#pragma unroll
        for (int t = 0; t < 3; ++t) { const int it = t == 0 ? i0 : (t == 1 ? i1 : i2); const int src = it < 0 ? 0 : it;
            const unsigned bs = __shfl(base, src); const unsigned mlo = __shfl((unsigned)mymask, src), mhi = __shfl((unsigned)(mymask >> 32), src);
            const unsigned long long mk = ((unsigned long long)mhi << 32) | mlo;
            const unsigned pos = bs + (unsigned)__popcll(mk & below);
            if (it >= 0 && pos < (unsigned)LCAP) lists[(size_t)(bh * 32 + it) * LCAP + pos] = ((unsigned)s << 2) | (unsigned)(t + 1); }
    }
}

namespace moba {
typedef float f32x16 __attribute__((ext_vector_type(16)));
typedef short s16x4 __attribute__((ext_vector_type(4)));
__device__ __forceinline__ int v_st(int k, int c) { return ((k >> 3) * 4 + (c >> 5)) * 512 + ((k & 7) * 32 + (c & 31)) * 2; }
__device__ __forceinline__ int v_rd_base(int lane) { return ((lane & 3) << 3) | (((lane >> 2) & 3) << 6) | (((lane >> 4) & 1) << 5) | (((lane >> 5) & 1) << 8); }
constexpr int v_rd_off(int d0, int ks, int half) { return d0 * 512 + ks * 4096 + half * 2048; }
template <int OFF> __device__ __forceinline__ s16x4 tr_read(int vb) { s16x4 r; asm volatile("ds_read_b64_tr_b16 %0, %1 offset:%2" : "=&v"(r) : "v"(vb), "i"(OFF) : "memory"); return r; }
__device__ __forceinline__ unsigned cvtpk(float lo, float hi) { unsigned r; asm volatile("v_cvt_pk_bf16_f32 %0, %1, %2" : "=v"(r) : "v"(lo), "v"(hi)); return r; }
template <int D0> __device__ __forceinline__ void pv_one(f32x16& od, int vb, bf16x8 pb0, bf16x8 pb1, bf16x8 pb2, bf16x8 pb3) {
    const s16x4 l0 = tr_read<v_rd_off(D0, 0, 0)>(vb), h0 = tr_read<v_rd_off(D0, 0, 1)>(vb), l1 = tr_read<v_rd_off(D0, 1, 0)>(vb), h1 = tr_read<v_rd_off(D0, 1, 1)>(vb);
    const s16x4 l2 = tr_read<v_rd_off(D0, 2, 0)>(vb), h2 = tr_read<v_rd_off(D0, 2, 1)>(vb), l3 = tr_read<v_rd_off(D0, 3, 0)>(vb), h3 = tr_read<v_rd_off(D0, 3, 1)>(vb);
    asm volatile("s_waitcnt lgkmcnt(0)" ::: "memory"); __builtin_amdgcn_sched_barrier(0);
#define MOBA_PK(L, H) (bf16x8){L[0], L[1], L[2], L[3], H[0], H[1], H[2], H[3]}
    od = __builtin_amdgcn_mfma_f32_32x32x16_bf16(MOBA_PK(l0, h0), pb0, od, 0, 0, 0);
    od = __builtin_amdgcn_mfma_f32_32x32x16_bf16(MOBA_PK(l1, h1), pb1, od, 0, 0, 0);
    od = __builtin_amdgcn_mfma_f32_32x32x16_bf16(MOBA_PK(l2, h2), pb2, od, 0, 0, 0);
    od = __builtin_amdgcn_mfma_f32_32x32x16_bf16(MOBA_PK(l3, h3), pb3, od, 0, 0, 0);
#undef MOBA_PK
}
__device__ __forceinline__ bf16x8 pack_p(const f32x16& p, int base) {
    v4u w; w.x = cvtpk(p[base + 0], p[base + 1]); w.y = cvtpk(p[base + 2], p[base + 3]); w.z = cvtpk(p[base + 4], p[base + 5]); w.w = cvtpk(p[base + 6], p[base + 7]);
    return __builtin_bit_cast(bf16x8, w);
}

__device__ __forceinline__ void attn_phase(const Ctx& C, const bf16* Qb, const bf16* Kb, const bf16* Vb, const unsigned* lists, const unsigned* lcnt, gu32* qctr,
                                           bf16* POa, bf16* POb, float* LSE) {
    LAS unsigned char* lds = C.lds;
    const int lane = C.lane, r32 = lane & 31, hi = lane >> 5;
    int koff[8];
#pragma unroll
    for (int d0 = 0; d0 < 8; ++d0) koff[d0] = r32 * 256 + ((d0 * 32 + hi * 16) ^ ((r32 & 7) << 4));
    const int vb0 = (int)(uintptr_t)(lds + 65536) + v_rd_base(lane);
    for (;;) {
        __syncthreads();
        if (C.tid == 0) { const unsigned u = __hip_atomic_fetch_add(qctr, 1u, __ATOMIC_RELAXED, __HIP_MEMORY_SCOPE_AGENT); C.misc[0] = u; C.misc[1] = 0u; }
        __syncthreads();
        const unsigned u = C.misc[0];
        if (u >= 1024u) break;
        const int j = (int)(u >> 5), bh = (int)(u & 31u), b = bh >> 3, h = bh & 7;
        int cnt = (int)lcnt[bh * 32 + j]; cnt = cnt > LCAP ? LCAP : cnt;
        { const bf16* Kg = Kb + (size_t)(b * SEQ + j * 256) * DM + h * HD; const bf16* Vg = Vb + (size_t)(b * SEQ + j * 256) * DM + h * HD;
#pragma unroll
            for (int i = 0; i < 8; ++i) { const int c = C.tid + i * NT, row = c >> 4, ch = c & 15;
                const v4u kv = *(const v4u*)(Kg + (size_t)row * DM + ch * 8); const v4u vv = *(const v4u*)(Vg + (size_t)row * DM + ch * 8);
                *(LAS v4u*)(lds + row * 256 + ((ch * 16) ^ ((row & 7) << 4))) = kv;
                *(LAS v4u*)(lds + 65536 + (row >> 6) * 16384 + v_st(row & 63, ch * 8)) = vv; } }
        __syncthreads();
        const int ntiles = 8 + ((cnt + 31) >> 5);
        for (;;) {
            int ti = 0;
            if (lane == 0) ti = (int)__hip_atomic_fetch_add((LAS unsigned*)(C.misc + 1), 1u, __ATOMIC_RELAXED, __HIP_MEMORY_SCOPE_WORKGROUP);
            ti = __builtin_amdgcn_readfirstlane(ti);
            if (ti >= ntiles) break;
            int sq, slot, nkt; bool causal, valid;
            if (ti < 8) { const int t = 7 - ti; sq = j * 256 + t * 32 + r32; slot = 0; nkt = (t >> 1) + 1; causal = true; valid = true; }
            else { const int e = (ti - 8) * 32 + r32; valid = e < cnt; const unsigned ent = lists[(size_t)(bh * 32 + j) * LCAP + (valid ? e : cnt - 1)];
                sq = (int)(ent >> 2); slot = (int)(ent & 3u); nkt = 4; causal = false; }
            const int qpos = sq & 255;
            bf16x8 qr[8];
            { const bf16* qp = Qb + (size_t)(b * SEQ + sq) * DM + h * HD + hi * 8;
#pragma unroll
                for (int d0 = 0; d0 < 8; ++d0) qr[d0] = *(const bf16x8*)(qp + d0 * 16); }
            float m = -1e30f, l = 0.f; f32x16 o[4];
#pragma unroll
            for (int d0 = 0; d0 < 4; ++d0) o[d0] = f32x16{};
            for (int kt = 0; kt < nkt; ++kt) {
                f32x16 p0 = f32x16{}, p1 = f32x16{};
                const LAS unsigned char* kl = lds + kt * 16384;
#pragma unroll
                for (int d0 = 0; d0 < 8; ++d0) { const bf16x8 a0 = *(const LAS bf16x8*)(kl + koff[d0]); const bf16x8 a1 = *(const LAS bf16x8*)(kl + koff[d0] + 8192);
                    p0 = __builtin_amdgcn_mfma_f32_32x32x16_bf16(a0, qr[d0], p0, 0, 0, 0);
                    p1 = __builtin_amdgcn_mfma_f32_32x32x16_bf16(a1, qr[d0], p1, 0, 0, 0); }
                if (causal && kt == nkt - 1) { const float NEG = -__builtin_inff(); const int kb = kt * 64 + 4 * hi;
#pragma unroll
                    for (int r = 0; r < 16; ++r) { const int kv = kb + (r & 3) + 8 * (r >> 2); if (kv > qpos) p0[r] = NEG; if (kv + 32 > qpos) p1[r] = NEG; } }
                float pm = fmaxf(p0[0], p1[0]);
#pragma unroll
                for (int r = 1; r < 16; ++r) pm = fmaxf(pm, fmaxf(p0[r], p1[r]));
                { auto rr = __builtin_amdgcn_permlane32_swap(__float_as_uint(pm), __float_as_uint(pm), false, false); pm = fmaxf(__uint_as_float(rr[0]), __uint_as_float(rr[1])); }
                const float mn = fmaxf(m, pm), alpha = __builtin_amdgcn_exp2f(m - mn); m = mn;
                float ps = 0.f;
#pragma unroll
                for (int r = 0; r < 16; ++r) { p0[r] = __builtin_amdgcn_exp2f(p0[r] - mn); p1[r] = __builtin_amdgcn_exp2f(p1[r] - mn); ps += p0[r] + p1[r]; }
                l = l * alpha + ps;
#pragma unroll
                for (int d0 = 0; d0 < 4; ++d0) o[d0] = o[d0] * alpha;
                const bf16x8 pb0 = pack_p(p0, 0), pb1 = pack_p(p0, 8), pb2 = pack_p(p1, 0), pb3 = pack_p(p1, 8);
                const int vb = vb0 + kt * 16384;
                pv_one<0>(o[0], vb, pb0, pb1, pb2, pb3); pv_one<1>(o[1], vb, pb0, pb1, pb2, pb3); pv_one<2>(o[2], vb, pb0, pb1, pb2, pb3); pv_one<3>(o[3], vb, pb0, pb1, pb2, pb3);
            }
            { auto rr = __builtin_amdgcn_permlane32_swap(__float_as_uint(l), __float_as_uint(l), false, false); l = __uint_as_float(rr[0]) + __uint_as_float(rr[1]); }
            const float inv = 1.0f / l, lse = m + __builtin_amdgcn_logf(l);
            if (valid) {
                bf16* dst = (slot < 2 ? POa : POb) + (((size_t)bh * SEQ + sq) * 2 + (slot & 1)) * HD + 4 * hi;
#pragma unroll
                for (int d0 = 0; d0 < 4; ++d0)
#pragma unroll
                    for (int g = 0; g < 4; ++g) { const unsigned long long w = (unsigned long long)cvtpk(o[d0][4 * g] * inv, o[d0][4 * g + 1] * inv) | ((unsigned long long)cvtpk(o[d0][4 * g + 2] * inv, o[d0][4 * g + 3] * inv) << 32);
                        *(unsigned long long*)(dst + 32 * d0 + 8 * g) = w; }
                if (hi == 0) LSE[((size_t)bh * SEQ + sq) * 4 + slot] = lse;
            }
        }
    }
}
}

__device__ __forceinline__ void combine_phase(const Ctx& C, const bf16* POa, const bf16* POb, const float* LSE, bf16* AO) {
    const int gw = C.vcu * NWAVES + C.wave, NGW = C.G * NWAVES, h = C.lane >> 3, dch = (C.lane & 7) * 16;
    for (int tg = gw; tg < M / 16; tg += NGW) {
#pragma unroll 2
        for (int r = 0; r < 16; ++r) {
            const int tok = tg * 16 + r, b = tok >> 13, s = tok & (SEQ - 1), nbk = s >> 8, nv = 1 + (nbk < 3 ? nbk : 3);
            const size_t bhs = (size_t)(b * NH + h) * SEQ + s;
            const f32x4 ls = *(const f32x4*)(LSE + bhs * 4);
            float mx = ls[0]; if (nv > 1) mx = fmaxf(mx, ls[1]); if (nv > 2) mx = fmaxf(mx, ls[2]); if (nv > 3) mx = fmaxf(mx, ls[3]);
            float w[4]; float wsum = 0.f;
#pragma unroll
            for (int i = 0; i < 4; ++i) { w[i] = i < nv ? __builtin_amdgcn_exp2f(ls[i] - mx) : 0.f; wsum += w[i]; }
            const float inv = 1.0f / wsum;
            float acc[16];
#pragma unroll
            for (int e = 0; e < 16; ++e) acc[e] = 0.f;
#pragma unroll
            for (int i = 0; i < 4; ++i) if (i < nv) {
                const bf16* src = (i < 2 ? POa : POb) + (bhs * 2 + (i & 1)) * HD + dch;
                const v4u a = *(const v4u*)src, c = *(const v4u*)(src + 8); const float wi = w[i] * inv;
                acc[0] += wi * bf_lo(a.x); acc[1] += wi * bf_hi(a.x); acc[2] += wi * bf_lo(a.y); acc[3] += wi * bf_hi(a.y);
                acc[4] += wi * bf_lo(a.z); acc[5] += wi * bf_hi(a.z); acc[6] += wi * bf_lo(a.w); acc[7] += wi * bf_hi(a.w);
                acc[8] += wi * bf_lo(c.x); acc[9] += wi * bf_hi(c.x); acc[10] += wi * bf_lo(c.y); acc[11] += wi * bf_hi(c.y);
                acc[12] += wi * bf_lo(c.z); acc[13] += wi * bf_hi(c.z); acc[14] += wi * bf_lo(c.w); acc[15] += wi * bf_hi(c.w); }
            v4u o0, o1; o0.x = pk2(acc[0], acc[1]); o0.y = pk2(acc[2], acc[3]); o0.z = pk2(acc[4], acc[5]); o0.w = pk2(acc[6], acc[7]);
            o1.x = pk2(acc[8], acc[9]); o1.y = pk2(acc[10], acc[11]); o1.z = pk2(acc[12], acc[13]); o1.w = pk2(acc[14], acc[15]);
            bf16* dst = AO + (size_t)tok * DM + h * HD + dch;
            *(v4u*)dst = o0; *(v4u*)(dst + 8) = o1;
        }
    }
}

__device__ __forceinline__ void conv_phase(const Ctx& C, const bf16* BG, const bf16* UU, const float* cw, bf16* Z) {
    const int gw = C.vcu * NWAVES + C.wave, NGW = C.G * NWAVES;
    for (int wu = gw; wu < (M / 16) * 2; wu += NGW) {
        const int rg = wu >> 1, c0 = (wu & 1) * 512 + C.lane * 8, row0 = rg * 16;
        float w0[8], w1[8], w2[8];
#pragma unroll
        for (int e = 0; e < 8; ++e) { w0[e] = cw[c0 + e]; w1[e] = cw[DM + c0 + e]; w2[e] = cw[2 * DM + c0 + e]; }
        float p2[8], p1[8];
        if ((row0 & (SEQ - 1)) == 0) {
#pragma unroll
            for (int e = 0; e < 8; ++e) { p2[e] = 0.f; p1[e] = 0.f; }
        } else {
            const v4u a = *(const v4u*)(UU + (size_t)(row0 - 2) * DM + c0), c = *(const v4u*)(UU + (size_t)(row0 - 1) * DM + c0);
            p2[0] = bf_lo(a.x); p2[1] = bf_hi(a.x); p2[2] = bf_lo(a.y); p2[3] = bf_hi(a.y); p2[4] = bf_lo(a.z); p2[5] = bf_hi(a.z); p2[6] = bf_lo(a.w); p2[7] = bf_hi(a.w);
            p1[0] = bf_lo(c.x); p1[1] = bf_hi(c.x); p1[2] = bf_lo(c.y); p1[3] = bf_hi(c.y); p1[4] = bf_lo(c.z); p1[5] = bf_hi(c.z); p1[6] = bf_lo(c.w); p1[7] = bf_hi(c.w);
        }
#pragma unroll 4
        for (int r = 0; r < 16; ++r) {
            const v4u a = *(const v4u*)(UU + (size_t)(row0 + r) * DM + c0), g = *(const v4u*)(BG + (size_t)(row0 + r) * DM + c0);
            float cu[8], bg[8], z[8];
            cu[0] = bf_lo(a.x); cu[1] = bf_hi(a.x); cu[2] = bf_lo(a.y); cu[3] = bf_hi(a.y); cu[4] = bf_lo(a.z); cu[5] = bf_hi(a.z); cu[6] = bf_lo(a.w); cu[7] = bf_hi(a.w);
            bg[0] = bf_lo(g.x); bg[1] = bf_hi(g.x); bg[2] = bf_lo(g.y); bg[3] = bf_hi(g.y); bg[4] = bf_lo(g.z); bg[5] = bf_hi(g.z); bg[6] = bf_lo(g.w); bg[7] = bf_hi(g.w);
#pragma unroll
            for (int e = 0; e < 8; ++e) { z[e] = bg[e] * (w0[e] * p2[e] + w1[e] * p1[e] + w2[e] * cu[e]); p2[e] = p1[e]; p1[e] = cu[e]; }
            v4u o; o.x = pk2(z[0], z[1]); o.y = pk2(z[2], z[3]); o.z = pk2(z[4], z[5]); o.w = pk2(z[6], z[7]);
            *(v4u*)(Z + (size_t)(row0 + r) * DM + c0) = o;
        }
    }
}

constexpr int N_PHASES = 18;
struct Args { const float* in[15]; float* out; unsigned char* ws; int ph_lo, ph_hi; };
static_assert(sizeof(Args) == 15 * 8 + 8 + 8 + 8, "Args has no padding");

__global__ void __launch_bounds__(NT, 2) moba_fwd(Args args) {
    extern __shared__ __attribute__((aligned(16))) unsigned char lds_raw[];
    Ctx C;
    C.lds = (LAS unsigned char*)lds_raw; C.misc = (volatile LAS unsigned*)(C.lds + MISC_OFF);
    C.tid = threadIdx.x; C.lane = C.tid & 63; C.wave = __builtin_amdgcn_readfirstlane(C.tid >> 6);
    C.G = gridDim.x; { const int bx = blockIdx.x; C.vcu = (C.G % 8 == 0) ? (bx % 8) * (C.G / 8) + bx / 8 : bx; }
    unsigned char* ws = args.ws;
    gu32* ctl = (gu32*)(ws + WS_CTL);
    if (C.tid < 32) C.misc[C.tid] = 0u;
    __syncthreads();
    const int lo = args.ph_lo, hi = args.ph_hi;
    XcdBarrier bar; bar.bar = (unsigned*)ctl + CW_BAR; bar.x = 0; bar.st = nullptr;
    if (hi - lo > 1) bar = xcd_barrier_post((unsigned*)ctl + CW_BAR, C.misc + 8);
#ifndef PHASE_MASK
#define PHASE_MASK 0x3ffff
#endif
#define IN(k) ((((PHASE_MASK) >> (k)) & 1) && lo <= (k) && (k) < hi)
#define SEAM(k) do { if (IN(k) && IN((k) + 1)) xcd_barrier(bar); } while (0)
    const float* x = args.in[0]; float* out = args.out;
    float* mod = (float*)(ws + WS_MOD); float* kmean = (float*)(ws + WS_KMEAN);
    bf16* HB = (bf16*)(ws + WS_H); bf16* QB = (bf16*)(ws + WS_Q); bf16* KB = (bf16*)(ws + WS_K); bf16* VB = (bf16*)(ws + WS_V);
    bf16* POa = (bf16*)out; bf16* POb = (bf16*)(ws + WS_POB); float* LSE = (float*)(ws + WS_LSE); unsigned* lists = (unsigned*)(ws + WS_LIST);
    bf16* ACT = (bf16*)(ws + WS_ACT); bf16* BG = (bf16*)(ws + WS_BG); bf16* UU = (bf16*)(ws + WS_UU); bf16* ZB = (bf16*)(ws + WS_Z);
    LAS unsigned char* ring = C.lds;

    if (IN(0)) { p0_prologue(C, args.in, ws); } SEAM(0);
    if (IN(1)) { modulate_phase(C, x, args.in[4], mod, 0, DM, HB); } SEAM(1);
    if (IN(2)) { pg8::Gemm g{HB, (const bf16*)(ws + WS_WQKV), M, 3 * DM, DM}; pg8::StaticOrder S; S.init(M, 3 * DM, C.G, (int)blockIdx.x);
        pg8::EpiQKV E{QB, KB, VB, args.in[8], args.in[9], (LAS float*)(C.lds + EPI_OFF), QSCALE};
        pg8::gemm_phase<pg8::EpiQKV, pg8::StaticOrder, true, true>(ring, g, S, E); } SEAM(2);
    if (IN(3)) { kmean_phase(C, KB, kmean); } SEAM(3);
    if (IN(4)) { route_phase(C, QB, kmean, lists, ctl + CW_LCNT); } SEAM(4);
    if (IN(5)) { moba::attn_phase(C, QB, KB, VB, lists, (const unsigned*)(ws + WS_CTL) + CW_LCNT, ctl + CW_QCTR, POa, POb, LSE); } SEAM(5);
    if (IN(6)) { combine_phase(C, POa, POb, LSE, HB); } SEAM(6);
    if (IN(7)) { pg8::Gemm g{HB, (const bf16*)(ws + WS_WO), M, DM, DM}; pg8::StaticOrder S; S.init(M, DM, C.G, (int)blockIdx.x);
        pg8::EpiResid E{x, out, mod + 2 * DM};
        pg8::gemm_phase<pg8::EpiResid, pg8::StaticOrder, true, true>(ring, g, S, E); } SEAM(7);
    if (IN(8)) { modulate_phase(C, out, args.in[5], mod, 3 * DM, 4 * DM, HB); } SEAM(8);
    if (IN(9)) { pg8::Gemm g{HB, (const bf16*)(ws + WS_WGU0), M, 2 * FF, DM}; pg8::StaticOrder S; S.init(M, 2 * FF, C.G, (int)blockIdx.x);
        pg8::EpiSwiglu E{ACT, FF};
        pg8::gemm_phase<pg8::EpiSwiglu, pg8::StaticOrder, true, true>(ring, g, S, E); } SEAM(9);
    if (IN(10)) { pg8::Gemm g{ACT, (const bf16*)(ws + WS_WDN0), M, DM, FF}; pg8::StaticOrder S; S.init(M, DM, C.G, (int)blockIdx.x);
        pg8::EpiResid E{out, out, mod + 5 * DM};
        pg8::gemm_phase<pg8::EpiResid, pg8::StaticOrder, true, true>(ring, g, S, E); } SEAM(10);
    const float* mod1 = mod + 4 * MODW;
    if (IN(11)) { modulate_phase(C, out, args.in[4] + DM, mod1, 0, DM, HB); } SEAM(11);
    if (IN(12)) { pg8::Gemm g{HB, (const bf16*)(ws + WS_WIN), M, 3 * DM, DM}; pg8::StaticOrder S; S.init(M, 3 * DM, C.G, (int)blockIdx.x);
        pg8::EpiConvIn E{BG, UU};
        pg8::gemm_phase<pg8::EpiConvIn, pg8::StaticOrder, true, true>(ring, g, S, E); } SEAM(12);
    if (IN(13)) { conv_phase(C, BG, UU, args.in[11], ZB); } SEAM(13);
    if (IN(14)) { pg8::Gemm g{ZB, (const bf16*)(ws + WS_WOUT), M, DM, DM}; pg8::StaticOrder S; S.init(M, DM, C.G, (int)blockIdx.x);
        pg8::EpiResid E{out, out, mod1 + 2 * DM};
        pg8::gemm_phase<pg8::EpiResid, pg8::StaticOrder, true, true>(ring, g, S, E); } SEAM(14);
    if (IN(15)) { modulate_phase(C, out, args.in[5] + DM, mod1, 3 * DM, 4 * DM, HB); } SEAM(15);
    if (IN(16)) { pg8::Gemm g{HB, (const bf16*)(ws + WS_WGU1), M, 2 * FF, DM}; pg8::StaticOrder S; S.init(M, 2 * FF, C.G, (int)blockIdx.x);
        pg8::EpiSwiglu E{ACT, FF};
        pg8::gemm_phase<pg8::EpiSwiglu, pg8::StaticOrder, true, true>(ring, g, S, E); } SEAM(16);
    if (IN(17)) { pg8::Gemm g{ACT, (const bf16*)(ws + WS_WDN1), M, DM, FF}; pg8::StaticOrder S; S.init(M, DM, C.G, (int)blockIdx.x);
        pg8::EpiResid E{out, out, mod1 + 5 * DM};
        pg8::gemm_phase<pg8::EpiResid, pg8::StaticOrder, true, true>(ring, g, S, E); }
#undef IN
#undef SEAM
}

#ifndef MK_N_LAUNCHES
#define MK_N_LAUNCHES 18
#endif
extern "C" void kernel_launch(void* const* d_in, const int* in_sizes, int n_in, void* d_out, int out_size, void* d_ws, size_t ws_size, hipStream_t stream) {
    static int grid = 0;
    if (grid == 0) {
        if (n_in != 15 || in_sizes[0] != M * DM || out_size != M * DM || ws_size < WS_END) {
            fprintf(stderr, "kernel_launch: built for 15 inputs, x/out of %d floats, >= %zu bytes of workspace; got n_in %d, in0 %d, out %d, ws %zu; nothing launched\n", M * DM, (size_t)WS_END, n_in, n_in > 0 ? in_sizes[0] : -1, out_size, ws_size);
            grid = -1; return; }
        int dev = 0, cus = 0, per_cu = 0;
        if (hipGetDevice(&dev) != hipSuccess || hipDeviceGetAttribute(&cus, hipDeviceAttributeMultiprocessorCount, dev) != hipSuccess) { fprintf(stderr, "kernel_launch: device query failed\n"); grid = -1; return; }
        if (hipFuncSetAttribute((const void*)moba_fwd, hipFuncAttributeMaxDynamicSharedMemorySize, LDS_BYTES) != hipSuccess) { fprintf(stderr, "kernel_launch: hipFuncSetAttribute failed\n"); grid = -1; return; }
        if (hipOccupancyMaxActiveBlocksPerMultiprocessor(&per_cu, (const void*)moba_fwd, NT, LDS_BYTES) != hipSuccess || per_cu < 1) { fprintf(stderr, "kernel_launch: occupancy query reports %d workgroups per CU\n", per_cu); per_cu = 1; }
        (void)hipGetLastError();
        grid = cus;
    }
    if (grid < 0) return;
    if (hipMemsetAsync((char*)d_ws + WS_CTL, 0, CTL_ZERO_BYTES, stream) != hipSuccess) { fprintf(stderr, "kernel_launch: memset failed\n"); return; }
    Args a{};
    for (int i = 0; i < 15; ++i) a.in[i] = (const float*)d_in[i];
    a.out = (float*)d_out; a.ws = (unsigned char*)d_ws;
    if (MK_N_LAUNCHES == 1) {
        a.ph_lo = 0; a.ph_hi = N_PHASES;
        hipLaunchKernelGGL(moba_fwd, dim3(grid), dim3(NT), LDS_BYTES, stream, a);
    } else {
        for (int p = 0; p < N_PHASES; ++p) { a.ph_lo = p; a.ph_hi = p + 1; hipLaunchKernelGGL(moba_fwd, dim3(grid), dim3(NT), LDS_BYTES, stream, a); }
    }
    const hipError_t le = hipPeekAtLastError();
    if (le != hipSuccess) fprintf(stderr, "kernel_launch: launch failed: %s\n", hipGetErrorName(le));
}
```

```cpp
#include <hip/hip_runtime.h>
#include <cstdio>
#include <cstdint>
#ifndef KN_WGM
#define KN_WGM 8
#endif
namespace pg8 {
#define PG8_LAS __attribute__((address_space(3)))
typedef unsigned short bf16_t;
typedef short bf16x8 __attribute__((ext_vector_type(8)));
typedef float f32x4 __attribute__((ext_vector_type(4)));
typedef unsigned u32x4 __attribute__((ext_vector_type(4)));
constexpr int BM = 256, BK = 64, HALF = 128, HTB = HALF * BK * 2  , STAGE_BYTES = 8 * HTB, NXCD = 8, WGM = KN_WGM;

__host__ __device__ __forceinline__ int lds_byte(int r, int c) { const int st = (r >> 4) * 2 + (c >> 5), rr = r & 15, cc = c & 31, ob = rr * 64 + cc * 2; return st * 1024 + (ob ^ (((ob >> 9) & 1) << 5)); }
__host__ __device__ __forceinline__ void stage_rc(int b, int& R, int& C) { const int st = b / 1024, sb = b % 1024, swz = sb ^ (((sb >> 9) & 1) << 5); R = (st >> 1) * 16 + swz / 64; C = (st & 1) * 32 + (swz % 64) / 2; }
__host__ __device__ __forceinline__ int perm32(int rho) { const int n = rho >> 4, i = rho & 15; return 8 * (i >> 2) + 4 * n + (i & 3); }

struct Unit { int pm, pn; };
struct Gemm { const bf16_t* A; const bf16_t* Bt; int M, N, K; size_t axtra = 0; int sa = 127, sb = 127; };

struct StaticOrder {
    int nM, nN, nwg, G, c, wgm;
    __host__ __device__ void init(int M, int N, int G_, int c_, int wgm_ = WGM) { nM = M / BM; nN = N / BM; nwg = nM * nN; G = G_; c = c_; wgm = wgm_; }
    __host__ __device__ bool next(int i, Unit& u) const {
        const long L = (long)i * G + c; if (L >= nwg) return false;
        int wgid = (int)L; { const int q = nwg / NXCD, r = nwg % NXCD, xcd = wgid % NXCD, off = wgid / NXCD; wgid = (xcd < r ? xcd * (q + 1) : r * (q + 1) + (xcd - r) * q) + off; }
        const int nig = wgm * nN, gid = wgid / nig, fm = gid * wgm, gsz = (nM - fm) < wgm ? (nM - fm) : wgm;
        u.pm = fm + ((wgid % nig) % gsz); u.pn = (wgid % nig) / gsz; return true;
    }
    __device__ __forceinline__ void a_ready(const Unit&) const {}
    __device__ __forceinline__ void done(const Unit&) const {}
};

__device__ __forceinline__ unsigned cvt_pk_bf16(float lo, float hi) { unsigned r; asm volatile("v_cvt_pk_bf16_f32 %0, %1, %2" : "=v"(r) : "v"(lo), "v"(hi)); return r; }
typedef float f32x2 __attribute__((ext_vector_type(2)));
__device__ __forceinline__ float silu_f(float x) { return x * __builtin_amdgcn_rcpf(1.0f + __builtin_amdgcn_exp2f(-1.4426950408889634f * x)); }
__device__ __forceinline__ u32x4 pack8(const f32x4 a, const f32x4 b) { u32x4 w; w.x = cvt_pk_bf16(a[0], a[1]); w.y = cvt_pk_bf16(a[2], a[3]); w.z = cvt_pk_bf16(b[0], b[1]); w.w = cvt_pk_bf16(b[2], b[3]); return w; }

struct EpiResid {
    static constexpr bool PERM = true, AFTER_DRAIN = false;
    const bf16_t* base; float* out; const float* gate; const bf16_t* Y; const float* gate2;
    __device__ __forceinline__ void operator()(const f32x4 (&acc)[2][2][4][2], const Unit& u, int wr, int wc, int fr, int fq) const {
        asm volatile("" : "+v"(fr), "+v"(fq));
        const int b = u.pm >> 5, col0 = u.pn * BM + wc * 32 + 8 * fq;
        const float* gp = gate + (size_t)b * 6144 + col0; const float* gp2 = gate2 + (size_t)b * 6144 + col0;
        f32x4 gv[2][2], g2[2][2];
#pragma unroll
        for (int bj = 0; bj < 2; ++bj)
#pragma unroll
            for (int n = 0; n < 2; ++n) { gv[bj][n] = *(const f32x4*)(gp + bj * HALF + 4 * n); g2[bj][n] = *(const f32x4*)(gp2 + bj * HALF + 4 * n); }
#pragma unroll
        for (int ai = 0; ai < 2; ++ai)
#pragma unroll
            for (int mh = 0; mh < 2; ++mh) {
                u32x4 bs[2][2], yv[2][2];
#pragma unroll
                for (int mm = 0; mm < 2; ++mm) { const size_t off = (size_t)(u.pm * BM + ai * HALF + wr * 64 + (2 * mh + mm) * 16 + fr) * 1024 + col0;
#pragma unroll
                    for (int bj = 0; bj < 2; ++bj) { bs[mm][bj] = *(const u32x4*)(base + off + bj * HALF); yv[mm][bj] = *(const u32x4*)(Y + off + bj * HALF); } }
#pragma unroll
                for (int mm = 0; mm < 2; ++mm) { const int m = 2 * mh + mm; const size_t off = (size_t)(u.pm * BM + ai * HALF + wr * 64 + m * 16 + fr) * 1024 + col0;
#pragma unroll
                    for (int bj = 0; bj < 2; ++bj) { const u32x4 y = yv[mm][bj], xw = bs[mm][bj];
                        const f32x4 x0 = (f32x4){__uint_as_float(xw.x << 16), __uint_as_float(xw.x & 0xffff0000u), __uint_as_float(xw.y << 16), __uint_as_float(xw.y & 0xffff0000u)};
                        const f32x4 x1 = (f32x4){__uint_as_float(xw.z << 16), __uint_as_float(xw.z & 0xffff0000u), __uint_as_float(xw.w << 16), __uint_as_float(xw.w & 0xffff0000u)};
                        const f32x4 y0 = (f32x4){__uint_as_float(y.x << 16), __uint_as_float(y.x & 0xffff0000u), __uint_as_float(y.y << 16), __uint_as_float(y.y & 0xffff0000u)};
                        const f32x4 y1 = (f32x4){__uint_as_float(y.z << 16), __uint_as_float(y.z & 0xffff0000u), __uint_as_float(y.w << 16), __uint_as_float(y.w & 0xffff0000u)};
                        *(f32x4*)(out + off + bj * HALF) = x0 + g2[bj][0] * y0 + gv[bj][0] * acc[ai][bj][m][0];
                        *(f32x4*)(out + off + bj * HALF + 4) = x1 + g2[bj][1] * y1 + gv[bj][1] * acc[ai][bj][m][1]; } }
                asm volatile("" ::: "memory");
            }
    }
};
struct EpiPlain {
    static constexpr bool PERM = true, AFTER_DRAIN = false;
    bf16_t* O;
    __device__ __forceinline__ void operator()(const f32x4 (&acc)[2][2][4][2], const Unit& u, int wr, int wc, int fr, int fq) const {
        asm volatile("" : "+v"(fr), "+v"(fq));
        const int row0 = u.pm * BM + wr * 64 + fr, col0 = u.pn * BM + wc * 32 + 8 * fq;
#pragma unroll
        for (int ai = 0; ai < 2; ++ai)
#pragma unroll
            for (int m = 0; m < 4; ++m) { bf16_t* rowp = O + (size_t)(row0 + ai * HALF + m * 16) * 1024 + col0;
#pragma unroll
                for (int bj = 0; bj < 2; ++bj) *(u32x4*)(rowp + bj * HALF) = pack8(acc[ai][bj][m][0], acc[ai][bj][m][1]); }
    }
};

struct EpiPlain8 {
    static constexpr bool PERM = true, AFTER_DRAIN = false;
    unsigned char* O; size_t xtra;
    __device__ __forceinline__ void operator()(const f32x4 (&acc)[2][2][4][2], const Unit& u, int wr, int wc, int fr, int fq) const {
        asm volatile("" : "+v"(fr), "+v"(fq));
        const int row0 = u.pm * BM + wr * 64 + fr, col0 = u.pn * BM + wc * 32 + 8 * fq;
#pragma unroll
        for (int ai = 0; ai < 2; ++ai)
#pragma unroll
            for (int m = 0; m < 4; ++m) { unsigned char* rowp = O + (size_t)(u.pm >> 4) * xtra + (size_t)(row0 + ai * HALF + m * 16) * 1024 + col0;
#pragma unroll
                for (int bj = 0; bj < 2; ++bj) { const f32x4 a = acc[ai][bj][m][0] * 16.0f, b = acc[ai][bj][m][1] * 16.0f; unsigned w0 = 0u, w1 = 0u;
                    w0 = __builtin_amdgcn_cvt_pk_fp8_f32(a[0], a[1], w0, false); w0 = __builtin_amdgcn_cvt_pk_fp8_f32(a[2], a[3], w0, true);
                    w1 = __builtin_amdgcn_cvt_pk_fp8_f32(b[0], b[1], w1, false); w1 = __builtin_amdgcn_cvt_pk_fp8_f32(b[2], b[3], w1, true);
                    *(unsigned long long*)(rowp + bj * HALF) = (unsigned long long)w0 | ((unsigned long long)w1 << 32); } }
    }
};

struct EpiSwiglu {
    static constexpr bool PERM = true, AFTER_DRAIN = false;
    bf16_t* O; int ldc; size_t xtra;
    __device__ __forceinline__ void operator()(const f32x4 (&acc)[2][2][4][2], const Unit& u, int wr, int wc, int fr, int fq) const {
        asm volatile("" : "+v"(fr), "+v"(fq));
        const int row0 = u.pm * BM + wr * 64 + fr, col0 = u.pn * HALF + wc * 32 + 8 * fq;
#pragma unroll
        for (int ai = 0; ai < 2; ++ai)
#pragma unroll
            for (int m = 0; m < 4; ++m) { bf16_t* rowp = O + (size_t)(u.pm >> 4) * xtra + (size_t)(row0 + ai * HALF + m * 16) * ldc + col0;
                f32x4 r0, r1;
#pragma unroll
                for (int e = 0; e < 4; ++e) { r0[e] = silu_f(acc[ai][0][m][0][e]) * acc[ai][1][m][0][e]; r1[e] = silu_f(acc[ai][0][m][1][e]) * acc[ai][1][m][1][e]; }
                *(u32x4*)rowp = pack8(r0, r1); }
    }
};

struct EpiSwiglu8 {
    static constexpr bool PERM = true, AFTER_DRAIN = false;
    unsigned char* O; int ldc; size_t xtra;
    __device__ __forceinline__ void operator()(const f32x4 (&acc)[2][2][4][2], const Unit& u, int wr, int wc, int fr, int fq) const {
        asm volatile("" : "+v"(fr), "+v"(fq));
        const int row0 = u.pm * BM + wr * 64 + fr, col0 = u.pn * HALF + wc * 32 + 8 * fq;
#pragma unroll
        for (int ai = 0; ai < 2; ++ai)
#pragma unroll
            for (int m = 0; m < 4; ++m) { unsigned char* rowp = O + (size_t)(u.pm >> 4) * xtra + (size_t)(row0 + ai * HALF + m * 16) * ldc + col0;
                f32x4 r0, r1;
#pragma unroll
                for (int e = 0; e < 4; ++e) { r0[e] = silu_f(acc[ai][0][m][0][e]) * acc[ai][1][m][0][e]; r1[e] = silu_f(acc[ai][0][m][1][e]) * acc[ai][1][m][1][e]; }
                unsigned w0 = 0u, w1 = 0u; w0 = __builtin_amdgcn_cvt_pk_fp8_f32(r0[0], r0[1], w0, false); w0 = __builtin_amdgcn_cvt_pk_fp8_f32(r0[2], r0[3], w0, true);
                w1 = __builtin_amdgcn_cvt_pk_fp8_f32(r1[0], r1[1], w1, false); w1 = __builtin_amdgcn_cvt_pk_fp8_f32(r1[2], r1[3], w1, true);
                *(unsigned long long*)rowp = (unsigned long long)w0 | ((unsigned long long)w1 << 32); }
    }
};

struct EpiConvIn {
    static constexpr bool PERM = true, AFTER_DRAIN = false;
    bf16_t* BG; bf16_t* UU;
    __device__ __forceinline__ void operator()(const f32x4 (&acc)[2][2][4][2], const Unit& u, int wr, int wc, int fr, int fq) const {
        asm volatile("" : "+v"(fr), "+v"(fq));
        const int row0 = u.pm * BM + wr * 64 + fr;
        if (u.pn < 4) {
            const int col0 = u.pn * BM + wc * 32 + 8 * fq;
#pragma unroll
            for (int ai = 0; ai < 2; ++ai)
#pragma unroll
                for (int m = 0; m < 4; ++m) { bf16_t* rowp = BG + (size_t)(row0 + ai * HALF + m * 16) * 1024 + col0;
#pragma unroll
                    for (int bj = 0; bj < 2; ++bj) *(u32x4*)(rowp + bj * HALF) = pack8(acc[ai][bj][m][0], acc[ai][bj][m][1]); }
        } else {
            const int col0 = (u.pn - 4) * HALF + wc * 32 + 8 * fq;
#pragma unroll
            for (int ai = 0; ai < 2; ++ai)
#pragma unroll
                for (int m = 0; m < 4; ++m) { bf16_t* rowp = UU + (size_t)(row0 + ai * HALF + m * 16) * 1024 + col0;
                    *(u32x4*)rowp = pack8(acc[ai][0][m][0] * acc[ai][1][m][0], acc[ai][0][m][1] * acc[ai][1][m][1]); }
        }
    }
};

struct EpiQKV {
    static constexpr bool PERM = true, AFTER_DRAIN = false;
    bf16_t *Q, *K, *V; const float *qg, *kg; PG8_LAS float* ss; float qscale; float* kmean; size_t vxtra; const float* cvec;
    __device__ __forceinline__ void operator()(const f32x4 (&acc)[2][2][4][2], const Unit& u, int wr, int wc, int fr, int fq) const {
        asm volatile("" : "+v"(fr), "+v"(fq));
        const int t = u.pn >> 2, colt = (u.pn & 3) * BM;
        const int row0 = u.pm * BM + wr * 64 + fr, col0 = colt + wc * 32 + 8 * fq;
        if (t == 2) {
#pragma unroll
            for (int ai = 0; ai < 2; ++ai)
#pragma unroll
                for (int m = 0; m < 4; ++m) { bf16_t* rowp = V + (size_t)(u.pm >> 4) * vxtra + (size_t)(row0 + ai * HALF + m * 16) * 1024 + col0;
#pragma unroll
                    for (int bj = 0; bj < 2; ++bj) *(u32x4*)(rowp + bj * HALF) = pack8(acc[ai][bj][m][0], acc[ai][bj][m][1]); }
            return;
        }
        const float* cp = cvec + (size_t)(u.pm >> 5) * 3072 + u.pn * BM + wc * 32 + 8 * fq;
#pragma unroll
        for (int bj = 0; bj < 2; ++bj) { asm volatile("" : "+v"(cp)); const f32x4 cb0 = *(const f32x4*)(cp + bj * HALF), cb1 = *(const f32x4*)(cp + bj * HALF + 4);
#pragma unroll
            for (int ai = 0; ai < 2; ++ai)
#pragma unroll
                for (int m = 0; m < 4; ++m) { const f32x4 a = acc[ai][bj][m][0] + cb0, b = acc[ai][bj][m][1] + cb1;
                    float s = (a[0] * a[0] + a[1] * a[1]) + (a[2] * a[2] + a[3] * a[3]) + (b[0] * b[0] + b[1] * b[1]) + (b[2] * b[2] + b[3] * b[3]);
                    s += __shfl_xor(s, 16); s += __shfl_xor(s, 32);
                    if (fq == 0) ss[(ai * HALF + wr * 64 + m * 16 + fr) * 8 + bj * 4 + wc] = s; } }
        asm volatile("s_waitcnt lgkmcnt(0)" ::: "memory"); __builtin_amdgcn_s_barrier(); asm volatile("" ::: "memory");
        const float* gain = (t == 0) ? qg : kg; const float sc = (t == 0) ? qscale : 1.0f;
        const f32x4 g0 = *(const f32x4*)(gain + wc * 32 + 8 * fq) * sc, g1 = *(const f32x4*)(gain + wc * 32 + 8 * fq + 4) * sc;
        bf16_t* base = (t == 0) ? Q : K;
#pragma unroll
        for (int bj = 0; bj < 2; ++bj) { asm volatile("" : "+v"(cp)); const f32x4 cb0 = *(const f32x4*)(cp + bj * HALF), cb1 = *(const f32x4*)(cp + bj * HALF + 4);
#pragma unroll
            for (int ai = 0; ai < 2; ++ai)
#pragma unroll
                for (int m = 0; m < 4; ++m) { const int r = ai * HALF + wr * 64 + m * 16 + fr; bf16_t* rowp = base + (size_t)(u.pm * BM + r) * 1024 + col0;
                    const f32x4 p = *(const PG8_LAS f32x4*)(ss + r * 8 + bj * 4);
                    const float rstd = __builtin_amdgcn_rsqf(((p[0] + p[1]) + (p[2] + p[3])) * (1.0f / 128.0f) + 1e-6f);
                    const f32x4 v0 = (acc[ai][bj][m][0] + cb0) * rstd * g0, v1 = (acc[ai][bj][m][1] + cb1) * rstd * g1;
                    *(u32x4*)(rowp + bj * HALF) = pack8(v0, v1);
                    asm volatile("" ::: "memory"); } }
        if (t == 1) {
            PG8_LAS float* km = ss + 2048;
#pragma unroll
            for (int bj = 0; bj < 2; ++bj) { f32x4 c0 = (f32x4){0.f, 0.f, 0.f, 0.f}, c1 = c0; asm volatile("" : "+v"(cp)); const f32x4 cb0 = *(const f32x4*)(cp + bj * HALF), cb1 = *(const f32x4*)(cp + bj * HALF + 4);
#pragma unroll
                for (int ai = 0; ai < 2; ++ai)
#pragma unroll
                    for (int m = 0; m < 4; ++m) { const f32x4 p = *(const PG8_LAS f32x4*)(ss + (ai * HALF + wr * 64 + m * 16 + fr) * 8 + bj * 4);
                        const float rstd = __builtin_amdgcn_rsqf(((p[0] + p[1]) + (p[2] + p[3])) * (1.0f / 128.0f) + 1e-6f);
                        c0 += (acc[ai][bj][m][0] + cb0) * rstd; c1 += (acc[ai][bj][m][1] + cb1) * rstd; }
                c0 = c0 * g0; c1 = c1 * g1;
#pragma unroll
                for (int e = 0; e < 4; ++e) { float a = c0[e], b = c1[e];
                    a += __shfl_xor(a, 1); b += __shfl_xor(b, 1); a += __shfl_xor(a, 2); b += __shfl_xor(b, 2); a += __shfl_xor(a, 4); b += __shfl_xor(b, 4); a += __shfl_xor(a, 8); b += __shfl_xor(b, 8);
                    if (fr == 0) { km[wr * 256 + bj * HALF + wc * 32 + 8 * fq + e] = a; km[wr * 256 + bj * HALF + wc * 32 + 8 * fq + 4 + e] = b; } }
                asm volatile("" ::: "memory"); }
            asm volatile("s_waitcnt lgkmcnt(0)" ::: "memory"); __builtin_amdgcn_s_barrier(); asm volatile("" ::: "memory");
            const int tid = (wr * 4 + wc) * 64 + fq * 16 + fr;
            if (tid < 256) { const float v = (km[tid] + km[256 + tid]) * (1.0f / 256.0f);
                const int h = (u.pn & 3) * 2 + (tid >> 7), b = u.pm >> 5, blk = u.pm & 31;
                kmean[(size_t)((b * 8 + h) * 32 + blk) * 128 + (tid & 127)] = v; }
        }
    }
};

template <class Epi, class Sched, bool ALIGN_EPI = false, bool SP2 = false, bool F8 = false>
__device__ __forceinline__ void gemm_phase(PG8_LAS unsigned char* lds, const Gemm g, const Sched& S, const Epi& E) {
    const int tid = threadIdx.x, wid = __builtin_amdgcn_readfirstlane(tid >> 6), lane = tid & 63, wr = wid >> 2, wc = wid & 3, fr = lane & 15, fq = lane >> 4;
    const int K = g.K, nt = K / BK;
    unsigned voffA[2], voffB[2];
#pragma unroll
    for (int i = 0; i < 2; ++i) { int R, C; stage_rc(tid * 16 + i * 8192, R, C); const int Rb = Epi::PERM ? ((R & ~31) + perm32(R & 31)) : R;
        voffA[i] = (unsigned)(R * K + C) * 2u; voffB[i] = (unsigned)(Rb * K + C) * 2u; }
    const size_t kstep = (size_t)(BK * 2);
    const size_t hstep = (size_t)HALF * K * 2;
    const size_t tstep = 2 * hstep;
    const unsigned ldsw = (unsigned)wid * 1024u;
    const int aoff = lds_byte(wr * 64 + fr, fq * 8), boff = lds_byte(wc * 32 + fr, fq * 8);
#define PG8_SA(b, h) (((b) * 2 + (h)) * HTB)
#define PG8_SB(b, h) ((4 + (b) * 2 + (h)) * HTB)
#define PG8_STAGE(bufoff, gbase, voff) do { _Pragma("unroll") for (int _i = 0; _i < 2; ++_i) \
        __builtin_amdgcn_global_load_lds((const unsigned*)((const char*)(gbase) + (voff)[_i]), (PG8_LAS unsigned*)(lds + (bufoff) + ldsw + _i * 8192), 16, 0, 0); } while (0)
#define PG8_LD16(off) (*(const PG8_LAS i32x4_*)(lds + (off)))
#define PG8_LDA(dst, b, h) do { _Pragma("unroll") for (int m = 0; m < 4; ++m) { \
        if constexpr (F8) dst##8[m] = __builtin_shufflevector(PG8_LD16(PG8_SA(b, h) + aoff + m * 2048), PG8_LD16(PG8_SA(b, h) + aoff + m * 2048 + 1024), 0, 1, 2, 3, 4, 5, 6, 7); \
        else { _Pragma("unroll") for (int k = 0; k < 2; ++k) dst[m][k] = *(const PG8_LAS bf16x8*)(lds + PG8_SA(b, h) + aoff + m * 2048 + k * 1024); } } } while (0)
#define PG8_LDB(dst, b, h) do { _Pragma("unroll") for (int n = 0; n < 2; ++n) { \
        if constexpr (F8) dst##8[n] = __builtin_shufflevector(PG8_LD16(PG8_SB(b, h) + boff + n * 2048), PG8_LD16(PG8_SB(b, h) + boff + n * 2048 + 1024), 0, 1, 2, 3, 4, 5, 6, 7); \
        else { _Pragma("unroll") for (int k = 0; k < 2; ++k) dst[n][k] = *(const PG8_LAS bf16x8*)(lds + PG8_SB(b, h) + boff + n * 2048 + k * 1024); } } } while (0)
#define PG8_MMA(ai, bj, At, Bt) do { __builtin_amdgcn_s_setprio(1); _Pragma("unroll") for (int m = 0; m < 4; ++m) _Pragma("unroll") for (int n = 0; n < 2; ++n) { \
        if constexpr (F8) asm volatile("v_mfma_scale_f32_16x16x128_f8f6f4 %0, %1, %2, %0, %3, %4 op_sel_hi:[0,0,0]" : "+v"(acc[ai][bj][m][n]) : "v"(Bt##8[n]), "v"(At##8[m]), "v"(f8sa), "v"(f8sb)); \
        else { _Pragma("unroll") for (int k = 0; k < 2; ++k) acc[ai][bj][m][n] = __builtin_amdgcn_mfma_f32_16x16x32_bf16(Bt[n][k], At[m][k], acc[ai][bj][m][n], 0, 0, 0); } } \
        __builtin_amdgcn_s_setprio(0); } while (0)
#define PG8_WAIT_V(n) asm volatile("s_waitcnt vmcnt(" #n ")" ::: "memory")
#define PG8_WAIT_L(n) asm volatile("s_waitcnt lgkmcnt(" #n ")" ::: "memory")
#define PG8_BAR __builtin_amdgcn_s_barrier()
#define PG8_SCHED __builtin_amdgcn_sched_barrier(0)
    Unit cur, nxt; int ui = 0;
    if (!S.next(0, cur)) return;
    f32x4 acc[2][2][4][2];
#pragma unroll
    for (int a = 0; a < 2; ++a)
#pragma unroll
        for (int b = 0; b < 2; ++b)
#pragma unroll
            for (int m = 0; m < 4; ++m)
#pragma unroll
                for (int n = 0; n < 2; ++n) acc[a][b][m][n] = (f32x4){0.f, 0.f, 0.f, 0.f};
    bf16x8 At[4][2], B0[2][2], B1[2][2];
    typedef int i32x4_ __attribute__((ext_vector_type(4))); typedef int i32x8_ __attribute__((ext_vector_type(8)));
    const int f8sa = g.sa, f8sb = g.sb;
    i32x8_ At8[4], B08[2], B18[2];
    const char* cA = (const char*)g.A + (size_t)cur.pm * tstep + (size_t)(cur.pm >> 4) * g.axtra; const char* cB = (const char*)g.Bt + (size_t)cur.pn * tstep;
    S.a_ready(cur);
    if constexpr (SP2) {
        PG8_STAGE(PG8_SB(0, 0), cB, voffB); PG8_STAGE(PG8_SB(0, 1), cB + hstep, voffB); PG8_STAGE(PG8_SA(0, 0), cA, voffA); PG8_STAGE(PG8_SA(0, 1), cA + hstep, voffA);
        if (wr == 1) PG8_BAR;
        PG8_WAIT_V(2); PG8_BAR;
        PG8_STAGE(PG8_SB(1, 0), cB + kstep, voffB); PG8_STAGE(PG8_SA(1, 0), cA + kstep, voffA); PG8_STAGE(PG8_SB(1, 1), cB + hstep + kstep, voffB);
        PG8_WAIT_V(6); PG8_BAR;
    } else {
        PG8_STAGE(PG8_SB(0, 0), cB, voffB); PG8_STAGE(PG8_SA(0, 0), cA, voffA); PG8_STAGE(PG8_SB(0, 1), cB + hstep, voffB); PG8_STAGE(PG8_SA(0, 1), cA + hstep, voffA);
        if (wr == 1) PG8_BAR;
        PG8_WAIT_V(4); PG8_BAR;
        PG8_STAGE(PG8_SB(1, 0), cB + kstep, voffB); PG8_STAGE(PG8_SA(1, 0), cA + kstep, voffA); PG8_STAGE(PG8_SB(1, 1), cB + hstep + kstep, voffB);
        PG8_WAIT_V(6); PG8_BAR;
    }
    for (;;) {
        const bool has_next = S.next(ui + 1, nxt);
        const char* nA = has_next ? (const char*)g.A + (size_t)nxt.pm * tstep + (size_t)(nxt.pm >> 4) * g.axtra : cA; const char* nB = has_next ? (const char*)g.Bt + (size_t)nxt.pn * tstep : cB;
        for (int t = 0; t < nt; t += 2) {
            const bool last = (t == nt - 2);
            const char* a1 = cA + (size_t)(t + 1) * kstep;
            const char* a2 = last ? nA : cA + (size_t)(t + 2) * kstep; const char* b2 = last ? nB : cB + (size_t)(t + 2) * kstep;
            const char* a3 = a2 + kstep; const char* b3 = b2 + kstep;
            if (last && has_next) S.a_ready(nxt);
            if constexpr (SP2) {
            PG8_LDB(B0, 0, 0); PG8_LDB(B1, 0, 1); PG8_SCHED; PG8_LDA(At, 0, 0); PG8_STAGE(PG8_SA(1, 1), a1 + hstep, voffA);
            PG8_WAIT_V(8); PG8_WAIT_L(0); PG8_BAR; PG8_MMA(0, 0, At, B0); PG8_MMA(0, 1, At, B1); PG8_BAR; PG8_SCHED;
            PG8_LDA(At, 0, 1); PG8_STAGE(PG8_SB(0, 0), b2, voffB); PG8_STAGE(PG8_SB(0, 1), b2 + hstep, voffB); PG8_STAGE(PG8_SA(0, 0), a2, voffA);
            PG8_WAIT_V(8); PG8_WAIT_L(0); PG8_BAR; PG8_MMA(1, 0, At, B0); PG8_MMA(1, 1, At, B1); PG8_BAR; PG8_SCHED;
            PG8_LDB(B0, 1, 0); PG8_LDB(B1, 1, 1); PG8_SCHED; PG8_LDA(At, 1, 0); PG8_STAGE(PG8_SA(0, 1), a2 + hstep, voffA);
            PG8_WAIT_V(8); PG8_WAIT_L(0); PG8_BAR; PG8_MMA(0, 0, At, B0); PG8_MMA(0, 1, At, B1); PG8_BAR; PG8_SCHED;
            PG8_LDA(At, 1, 1); PG8_STAGE(PG8_SB(1, 0), b3, voffB); PG8_STAGE(PG8_SB(1, 1), b3 + hstep, voffB); PG8_STAGE(PG8_SA(1, 0), a3, voffA);
            PG8_WAIT_V(8); PG8_WAIT_L(0); PG8_BAR; PG8_MMA(1, 0, At, B0); PG8_MMA(1, 1, At, B1); PG8_BAR; PG8_SCHED;
            } else {
            PG8_LDB(B0, 0, 0); PG8_SCHED; PG8_LDA(At, 0, 0); PG8_STAGE(PG8_SA(1, 1), a1 + hstep, voffA);
            PG8_WAIT_L(8); PG8_BAR; PG8_WAIT_L(0); PG8_MMA(0, 0, At, B0); PG8_BAR; PG8_SCHED;
            PG8_LDB(B1, 0, 1); PG8_STAGE(PG8_SB(0, 0), b2, voffB);
            PG8_BAR; PG8_WAIT_L(0); PG8_MMA(0, 1, At, B1); PG8_BAR;
            PG8_LDA(At, 0, 1); PG8_STAGE(PG8_SA(0, 0), a2, voffA);
            PG8_BAR; PG8_WAIT_L(0); PG8_MMA(1, 0, At, B0); PG8_BAR; PG8_SCHED;
            PG8_STAGE(PG8_SB(0, 1), b2 + hstep, voffB);
            PG8_WAIT_V(6); PG8_BAR; PG8_MMA(1, 1, At, B1); PG8_BAR;
            PG8_LDB(B0, 1, 0); PG8_SCHED; PG8_LDA(At, 1, 0); PG8_STAGE(PG8_SA(0, 1), a2 + hstep, voffA);
            PG8_WAIT_L(8); PG8_BAR; PG8_WAIT_L(0); PG8_MMA(0, 0, At, B0); PG8_BAR; PG8_SCHED;
            PG8_LDB(B1, 1, 1); PG8_STAGE(PG8_SB(1, 0), b3, voffB);
            PG8_BAR; PG8_WAIT_L(0); PG8_MMA(0, 1, At, B1); PG8_BAR;
            PG8_LDA(At, 1, 1); PG8_STAGE(PG8_SA(1, 0), a3, voffA);
            PG8_BAR; PG8_WAIT_L(0); PG8_MMA(1, 0, At, B0); PG8_BAR; PG8_SCHED;
            PG8_STAGE(PG8_SB(1, 1), b3 + hstep, voffB);
            PG8_WAIT_V(6); PG8_BAR; PG8_MMA(1, 1, At, B1); PG8_BAR;
            }
        }
        if constexpr (ALIGN_EPI) { if (wr == 0) PG8_BAR; }
        if constexpr (F8) asm volatile("s_nop 15\n\ts_nop 15" ::: "memory");
        if constexpr (!Epi::AFTER_DRAIN) { E(acc, cur, wr, wc, fr, fq); S.done(cur); }
        if (!has_next) break;
#pragma unroll
        for (int a = 0; a < 2; ++a)
#pragma unroll
            for (int b = 0; b < 2; ++b)
#pragma unroll
                for (int m = 0; m < 4; ++m)
#pragma unroll
                    for (int n = 0; n < 2; ++n) acc[a][b][m][n] = (f32x4){0.f, 0.f, 0.f, 0.f};
        cur = nxt; cA = nA; cB = nB; ++ui;
        if constexpr (ALIGN_EPI) { if (wr == 1) PG8_BAR; }
    }
    PG8_WAIT_V(0);
    if constexpr (!ALIGN_EPI) { if (wr == 0) PG8_BAR; }
    PG8_BAR;
    if constexpr (Epi::AFTER_DRAIN) { E.fused(acc, cur, wr, wc, fr, fq, lds, wid, lane); S.done(cur); }
#undef PG8_SA
#undef PG8_SB
#undef PG8_STAGE
#undef PG8_LDA
#undef PG8_LDB
#undef PG8_MMA
#undef PG8_WAIT_V
#undef PG8_WAIT_L
#undef PG8_BAR
#undef PG8_SCHED
}
}
#define GAS __attribute__((address_space(1)))
#define LAS __attribute__((address_space(3)))
typedef unsigned short bf16;
typedef unsigned v4u __attribute__((ext_vector_type(4)));
typedef float f32x4 __attribute__((ext_vector_type(4)));
typedef short bf16x8 __attribute__((ext_vector_type(8)));
typedef GAS unsigned gu32;
typedef GAS unsigned long long gu64;
#define RLX_AGENT __ATOMIC_RELAXED, __HIP_MEMORY_SCOPE_AGENT
#define LDS_WAIT() asm volatile("s_waitcnt lgkmcnt(0)" ::: "memory")
#define VM_WAIT() asm volatile("s_waitcnt vmcnt(0)" ::: "memory")
__device__ __forceinline__ unsigned long long rt() { return __builtin_amdgcn_s_memrealtime(); }
__device__ __forceinline__ unsigned f2bf(float f) { unsigned u = __builtin_bit_cast(unsigned, f); return (u + 0x7fffu + ((u >> 16) & 1u)) >> 16; }
__device__ __forceinline__ unsigned pk2(float lo, float hi) { return f2bf(lo) | (f2bf(hi) << 16); }

#define XB_TMO      128
#define XB_XCNT(j)  (256  + 64 * (j))
#define XB_XSUB(j)  (1280 + 64 * (j))
#define XB_XGEN(j)  (2304 + 64 * (j))
#define XB_TOP      3328
#define XB_TOPGEN   3392
#define XCD_BAR_WORDS 3456
#define XB_SPIN_CAP (1u << 18)

__device__ __forceinline__ unsigned xb_ld(unsigned* p)              { return __hip_atomic_load(p, __ATOMIC_RELAXED, __HIP_MEMORY_SCOPE_AGENT); }
__device__ __forceinline__ unsigned xb_add(unsigned* p, unsigned v) { return __hip_atomic_fetch_add(p, v, __ATOMIC_RELAXED, __HIP_MEMORY_SCOPE_AGENT); }
__device__ __forceinline__ unsigned xb_xcc_id() { return (unsigned)__builtin_amdgcn_s_getreg((3 << 11) | 20) & 0xFu; }
#define XB_SPIN(cond, bar) do { unsigned _sp = 0; while (cond) { __builtin_amdgcn_s_sleep(1); \
    if ((++_sp & 255u) == 0u) { if (xb_ld(&(bar)[XB_TMO])) break; if (_sp > XB_SPIN_CAP) { atomicAdd(&(bar)[XB_TMO], 1u); break; } } } } while (0)

struct XcdBarrier {
    unsigned* bar; unsigned x;
    volatile LAS unsigned* st;
};

__device__ __forceinline__ XcdBarrier xcd_barrier_post(unsigned* bar, volatile LAS unsigned* st) {
    XcdBarrier b; b.bar = bar; b.x = xb_xcc_id(); b.st = st;
    if (threadIdx.x == 0) (void)xb_add(&bar[XB_XCNT(b.x)], 1u);
    return b;
}
__device__ __forceinline__ void xcd_barrier_complete(unsigned* bar, unsigned x, unsigned& nloc, unsigned& nx) {
    const unsigned G = gridDim.x * gridDim.y * gridDim.z;
    unsigned sum, cnt, mine, sp = 0u;
    for (;;) {
        sum = 0u; cnt = 0u; mine = 0u;
#pragma unroll
        for (unsigned j = 0; j < 16; ++j) { const unsigned c = xb_ld(&bar[XB_XCNT(j)]); sum += c; cnt += (c > 0u) ? 1u : 0u; mine = (j == x) ? c : mine; }
        if (sum == G) break;
        __builtin_amdgcn_s_sleep(1);
        if ((++sp & 255u) == 0u) { if (xb_ld(&bar[XB_TMO])) break; if (sp > XB_SPIN_CAP) { atomicAdd(&bar[XB_TMO], 1u); break; } }
    }
    nloc = mine > 0u ? mine : 1u; nx = cnt > 0u ? cnt : 1u;
}

__device__ __forceinline__ void xcd_barrier(const XcdBarrier& b) {
    asm volatile("s_waitcnt vmcnt(0)" ::: "memory");
    __syncthreads();
    if (threadIdx.x == 0) {
        unsigned* bar = b.bar;
        __builtin_amdgcn_s_waitcnt(0);
        unsigned nloc = b.st[0], nx = b.st[1];
        if (nloc == 0u) { xcd_barrier_complete(bar, b.x, nloc, nx); b.st[0] = nloc; b.st[1] = nx; }
        const unsigned old = xb_add(&bar[XB_XSUB(b.x)], 1u);
        const unsigned gen = old / nloc;
        if (old + 1u == (gen + 1u) * nloc) {
            __builtin_amdgcn_fence(__ATOMIC_RELEASE, "agent");
            asm volatile("s_waitcnt vmcnt(0)" ::: "memory");
            const unsigned og = xb_add(&bar[XB_TOP], 1u);
            const unsigned tg = og / nx;
            if (og + 1u == (tg + 1u) * nx) xb_add(&bar[XB_TOPGEN], 1u);
            else XB_SPIN(xb_ld(&bar[XB_TOPGEN]) == tg, bar);
            __builtin_amdgcn_fence(__ATOMIC_ACQUIRE, "agent");
            xb_add(&bar[XB_XGEN(b.x)], 1u);
            asm volatile("s_waitcnt vmcnt(0)" ::: "memory");
        } else {
            XB_SPIN(xb_ld(&bar[XB_XGEN(b.x)]) == gen, bar);
            __builtin_amdgcn_fence(__ATOMIC_ACQUIRE, "agent");
            asm volatile("s_waitcnt vmcnt(0)" ::: "memory");
        }
    }
    __syncthreads();
}

constexpr int NBATCH = 4, SEQ = 8192, DM = 1024, NH = 8, HD = 128, M = NBATCH * SEQ, FF = 2816, NBLK = 32;
constexpr int NWAVES = 8, NT = NWAVES * 64;
constexpr int MODW = 6 * DM;
constexpr float QSCALE = 0.08838834764831845f * 1.4426950408889634f;
constexpr int LCAP = 8192;

constexpr size_t MiB = 1u << 20;
constexpr size_t WS_CTL = 0, CTL_ZERO_BYTES = 64 * 1024;
constexpr size_t WS_MOD = 1 * MiB;
constexpr size_t WS_C0 = 1 * MiB + 256 * 1024, WS_D0 = 1 * MiB + 320 * 1024;
constexpr size_t WS_KMEAN = 1 * MiB + 512 * 1024;
constexpr size_t WS_WQKV = 2 * MiB, WS_WO = 8 * MiB, WS_WIN = 10 * MiB, WS_WOUT = 16 * MiB, WS_WGU0 = 18 * MiB, WS_WGU1 = 29 * MiB, WS_WDN0 = 40 * MiB, WS_WDN1 = 46 * MiB;
constexpr size_t WS_LSE = 52 * MiB;
constexpr size_t WS_XB = 56 * MiB;
constexpr size_t WS_H = 120 * MiB;
constexpr size_t WS_LIST = WS_H;
constexpr size_t WS_Z = WS_H;
constexpr size_t WS_Q = 184 * MiB;
constexpr size_t WS_YB = WS_Q, WS_BG = WS_Q;
constexpr size_t WS_K = 248 * MiB;
constexpr size_t WS_FB = WS_K, WS_UU = WS_K;
constexpr size_t WS_R = 312 * MiB, XCHUNK = 25 * MiB;
constexpr size_t WS_V = WS_R, WS_ACT = WS_R, WS_POB = WS_R + 8 * MiB;
constexpr size_t VXTRA = (XCHUNK - 8 * MiB) / 2, AXTRA = (XCHUNK - 22 * MiB) / 2;
constexpr size_t WS_END = 512 * MiB;
constexpr size_t F8_XS = 8 * MiB;
constexpr size_t PO_XS_A = 16 * MiB, PO_XS_B = XCHUNK, PO_SL = 8 * MiB;
__device__ __forceinline__ size_t po_off(int sl, int tok) { return (size_t)(tok >> 12) * (sl < 2 ? PO_XS_A : PO_XS_B) + (size_t)(sl & 1) * PO_SL + (size_t)(tok & 4095) * 1024; }
__device__ __forceinline__ size_t psc_off(int tok, int h) { return (size_t)(tok >> 12) * (16 * MiB / 4) + (4 * MiB / 4) + (size_t)((tok & 4095) * 8 + h) * 4; }
__device__ __forceinline__ size_t list_off(int bh, int j) { return (size_t)(bh >> 3) * (16 * MiB / 4) + (size_t)((bh & 7) * 32 + j) * 8192; }
constexpr int CW_QCTR = 64, CW_RANK = 2048, CW_PAIR = 3072, CW_LATE = 3584, CW_C0 = 3648, CW_D0 = 3712, CW_BAR = 4096, CW_LCNT = 8192;
static_assert((CW_LCNT + 1024) * 4 <= (int)CTL_ZERO_BYTES && CW_BAR + XCD_BAR_WORDS <= CW_LCNT, "CTL map");

constexpr int RING_BYTES = 131072, EPI_OFF = RING_BYTES, EPI_BYTES = 10240, MISC_OFF = EPI_OFF + EPI_BYTES, LDS_BYTES = 147456;

struct Ctx { LAS unsigned char* lds; volatile LAS unsigned* misc; int tid, lane, wave, vcu, G, local; };

__device__ __forceinline__ float wave_sum(float v) {
#pragma unroll
    for (int o = 1; o < 64; o <<= 1) v += __shfl_xor(v, o);
    return v;
}
__device__ __forceinline__ float bf_lo(unsigned u) { return __uint_as_float(u << 16); }
__device__ __forceinline__ float bf_hi(unsigned u) { return __uint_as_float(u & 0xffff0000u); }

__device__ __forceinline__ void transpose_item(const float* W, int K, int N, bf16* WT, int k0, int n0, int drow0, LAS float* scr, int lane) {
    float v[32];
#pragma unroll
    for (int i = 0; i < 32; ++i) { const int kk = 2 * i + (lane >> 5); v[i] = W[(size_t)(k0 + kk) * N + n0 + (lane & 31)]; }
#pragma unroll
    for (int i = 0; i < 32; ++i) { const int kk = 2 * i + (lane >> 5); scr[kk * 33 + (lane & 31)] = v[i]; }
    LDS_WAIT(); asm volatile("" ::: "memory");
    const int c = lane & 7;
#pragma unroll
    for (int j = 0; j < 4; ++j) { const int n = (lane >> 3) + 8 * j; const LAS float* s = scr + (8 * c) * 33 + n;
        v4u o; o.x = pk2(s[0 * 33], s[1 * 33]); o.y = pk2(s[2 * 33], s[3 * 33]); o.z = pk2(s[4 * 33], s[5 * 33]); o.w = pk2(s[6 * 33], s[7 * 33]);
        *(GAS v4u*)(WT + (size_t)(drow0 + n) * K + k0 + 8 * c) = o; }
    LDS_WAIT(); asm volatile("" ::: "memory");
}
__device__ __forceinline__ int pair_row(int n, int seg) { return 256 * (n >> 7) + 128 * seg + (n & 127); }

__device__ __forceinline__ void p0_prologue(const Ctx& C, const float* const* in, unsigned char* ws, int which, int wcu, int ncu) {
    LAS float* scr = (LAS float*)(C.lds + C.wave * 16384);
    if (which == 0) for (int mu = wcu; mu < 192; mu += ncu) {
        const float* cin = in[1]; const float* w_ada = in[2]; const float* b_ada = in[3]; float* mod = (float*)(ws + WS_MOD);
        LAS float* tab = (LAS float*)C.lds; LAS float* part = (LAS float*)(C.lds + 16384);
#pragma unroll
        for (int kk = 0; kk < 2; ++kk) { const int k = C.tid + NT * kk;
#pragma unroll
            for (int b = 0; b < 4; ++b) { const float x = cin[b * DM + k]; tab[k * 4 + b] = x / (1.0f + __expf(-x)); } }
        __syncthreads();
        const int l = mu / 96, col = (mu % 96) * 64 + C.lane, kw = C.wave * 128;
        const float* W = w_ada + (size_t)l * DM * MODW + (size_t)kw * MODW + col;
        float a0 = 0.f, a1 = 0.f, a2 = 0.f, a3 = 0.f;
#pragma unroll 2
        for (int k0 = 0; k0 < 128; k0 += 16) {
            float w[16];
#pragma unroll
            for (int jj = 0; jj < 16; ++jj) w[jj] = W[(size_t)(k0 + jj) * MODW];
#pragma unroll
            for (int jj = 0; jj < 16; ++jj) { const f32x4 sv = *(const LAS f32x4*)(tab + (kw + k0 + jj) * 4); a0 += sv[0] * w[jj]; a1 += sv[1] * w[jj]; a2 += sv[2] * w[jj]; a3 += sv[3] * w[jj]; }
        }
        part[(C.wave * 4 + 0) * 64 + C.lane] = a0; part[(C.wave * 4 + 1) * 64 + C.lane] = a1; part[(C.wave * 4 + 2) * 64 + C.lane] = a2; part[(C.wave * 4 + 3) * 64 + C.lane] = a3;
        __syncthreads();
        if (C.wave < 4) { float sacc = 0.f;
#pragma unroll
            for (int w8 = 0; w8 < 8; ++w8) sacc += part[(w8 * 4 + C.wave) * 64 + C.lane];
            mod[(size_t)(l * 4 + C.wave) * MODW + col] = sacc + b_ada[l * MODW + col]; }
        __syncthreads();
    }
    const int NGW = ncu * NWAVES;
    constexpr int I_QKV = 16 * 96, I_O = 16 * 32, I_IN = 16 * 96, I_OUT = 16 * 32, I_GU = 16 * 176, I_DN = 44 * 32;
    constexpr int NITEMS = I_QKV + I_O + I_IN + I_OUT + 2 * I_GU + 2 * I_DN;
    struct TItem { const float* W; bf16* WT; int K, N, k0, n0, drow, f8; };
#define P0_DESC(D, IT) do { int r = (IT); \
        if (r < I_QKV) { D = TItem{in[6], (bf16*)(ws + WS_WQKV), DM, 3 * DM, 64 * (r / 96), 32 * (r % 96), 32 * (r % 96), 1}; break; } r -= I_QKV; \
        if (r < I_O) { D = TItem{in[7], (bf16*)(ws + WS_WO), DM, DM, 64 * (r / 32), 32 * (r % 32), 32 * (r % 32), 1}; break; } r -= I_O; \
        if (r < I_IN) { const int n0_ = 32 * (r % 96); D = TItem{in[10], (bf16*)(ws + WS_WIN), DM, 3 * DM, 64 * (r / 96), n0_, n0_ < DM ? n0_ : (n0_ < 2 * DM ? DM + pair_row(n0_ - DM, 0) : DM + pair_row(n0_ - 2 * DM, 1)), 0}; break; } r -= I_IN; \
        if (r < I_OUT) { D = TItem{in[12], (bf16*)(ws + WS_WOUT), DM, DM, 64 * (r / 32), 32 * (r % 32), 32 * (r % 32), 0}; break; } r -= I_OUT; \
        if (r < 2 * I_GU) { const int l_ = r / I_GU; r -= l_ * I_GU; const int n0_ = 32 * (r % 176); \
            D = TItem{in[13] + (size_t)l_ * DM * 2 * FF, (bf16*)(ws + (l_ ? WS_WGU1 : WS_WGU0)), DM, 2 * FF, 64 * (r / 176), n0_, n0_ < FF ? pair_row(n0_, 0) : pair_row(n0_ - FF, 1), 0}; break; } r -= 2 * I_GU; \
        { const int l_ = r / I_DN; r -= l_ * I_DN; D = TItem{in[14] + (size_t)l_ * FF * DM, (bf16*)(ws + (l_ ? WS_WDN1 : WS_WDN0)), FF, DM, 64 * (r / 32), 32 * (r % 32), 32 * (r % 32), l_}; } } while (0)
#define P0_LOAD(V, D) do { const float* wp_ = (D).W + (size_t)((D).k0 + (C.lane >> 5)) * (D).N + (D).n0 + (C.lane & 31); _Pragma("unroll") for (int i = 0; i < 32; ++i) V[i] = wp_[(size_t)(2 * i) * (D).N]; } while (0)
    const int gw = (which ? I_QKV : 0) + wcu * NWAVES + C.wave, IEND = which ? NITEMS : I_QKV;
    if (gw < IEND) {
        TItem cur, nx1; float v[32], v1[32];
        P0_DESC(cur, gw); P0_LOAD(v, cur); nx1 = cur;
        if (gw + NGW < IEND) { P0_DESC(nx1, gw + NGW); P0_LOAD(v1, nx1); }
        for (int it = gw; it < IEND; it += NGW) {
            TItem nx2 = nx1; float v2[32]; const bool has1 = it + NGW < IEND, has2 = it + 2 * NGW < IEND;
            if (has2) { P0_DESC(nx2, it + 2 * NGW); P0_LOAD(v2, nx2); }
#pragma unroll
            for (int i = 0; i < 32; ++i) scr[(2 * i + (C.lane >> 5)) * 33 + (C.lane & 31)] = v[i];
            LDS_WAIT(); asm volatile("" ::: "memory");
            const int c = C.lane & 7;
#pragma unroll
            for (int j = 0; j < 4; ++j) { const int n = (C.lane >> 3) + 8 * j; const LAS float* s = scr + (8 * c) * 33 + n;
                if (cur.f8) { unsigned w0 = 0u, w1 = 0u;
                    w0 = __builtin_amdgcn_cvt_pk_fp8_f32(32.f * s[0 * 33], 32.f * s[1 * 33], w0, false); w0 = __builtin_amdgcn_cvt_pk_fp8_f32(32.f * s[2 * 33], 32.f * s[3 * 33], w0, true);
                    w1 = __builtin_amdgcn_cvt_pk_fp8_f32(32.f * s[4 * 33], 32.f * s[5 * 33], w1, false); w1 = __builtin_amdgcn_cvt_pk_fp8_f32(32.f * s[6 * 33], 32.f * s[7 * 33], w1, true);
                    *(GAS unsigned long long*)((GAS unsigned char*)cur.WT + (size_t)(cur.drow + n) * cur.K + cur.k0 + 8 * c) = (unsigned long long)w0 | ((unsigned long long)w1 << 32); }
                else { v4u o; o.x = pk2(s[0 * 33], s[1 * 33]); o.y = pk2(s[2 * 33], s[3 * 33]); o.z = pk2(s[4 * 33], s[5 * 33]); o.w = pk2(s[6 * 33], s[7 * 33]);
                    *(GAS v4u*)(cur.WT + (size_t)(cur.drow + n) * cur.K + cur.k0 + 8 * c) = o; } }
            LDS_WAIT(); asm volatile("" ::: "memory");
            if (has1) { cur = nx1; nx1 = nx2;
#pragma unroll
                for (int i = 0; i < 32; ++i) { v[i] = v1[i]; v1[i] = v2[i]; } }
        }
    }
#undef P0_DESC
#undef P0_LOAD
}


__device__ __forceinline__ void gemv4_phase(const Ctx& C, const float* __restrict__ W, int ldw, int ncols, const float* __restrict__ svec, int sstride, float* __restrict__ out, int ostride, int wcu) {
    if (wcu * 16 >= ncols) return;
    LAS float* tab = (LAS float*)C.lds; LAS float* part = (LAS float*)(C.lds + 16384);
#pragma unroll
    for (int kk = 0; kk < 2; ++kk) { const int k = C.tid + NT * kk;
#pragma unroll
        for (int b = 0; b < 4; ++b) tab[k * 4 + b] = svec[(size_t)b * sstride + k]; }
    __syncthreads();
    const int cc = C.lane & 15, ks = C.lane >> 4, k0 = C.wave * 128 + ks * 32;
    const float* wp = W + (size_t)k0 * ldw + wcu * 16 + cc;
    float a0 = 0.f, a1 = 0.f, a2 = 0.f, a3 = 0.f;
#pragma unroll 2
    for (int k = 0; k < 32; k += 16) { float w[16];
#pragma unroll
        for (int jj = 0; jj < 16; ++jj) w[jj] = wp[(size_t)(k + jj) * ldw];
#pragma unroll
        for (int jj = 0; jj < 16; ++jj) { const f32x4 sv = *(const LAS f32x4*)(tab + (k0 + k + jj) * 4); a0 += sv[0] * w[jj]; a1 += sv[1] * w[jj]; a2 += sv[2] * w[jj]; a3 += sv[3] * w[jj]; } }
    a0 += __shfl_xor(a0, 16); a1 += __shfl_xor(a1, 16); a2 += __shfl_xor(a2, 16); a3 += __shfl_xor(a3, 16);
    a0 += __shfl_xor(a0, 32); a1 += __shfl_xor(a1, 32); a2 += __shfl_xor(a2, 32); a3 += __shfl_xor(a3, 32);
    if (C.lane < 16) *(LAS f32x4*)(part + (C.wave * 16 + cc) * 4) = (f32x4){a0, a1, a2, a3};
    __syncthreads();
    if (C.tid < 64) { const int col = C.tid & 15, b = C.tid >> 4; float s = 0.f;
#pragma unroll
        for (int w8 = 0; w8 < 8; ++w8) s += part[(w8 * 16 + col) * 4 + b];
        out[(size_t)b * ostride + wcu * 16 + col] = s; }
    __syncthreads();
}

template <bool XB, bool HY, bool HY2, bool HXO, bool H8 = false, bool HD0 = false, bool Y8 = false>
__device__ __forceinline__ void modulate_phase(const Ctx& C, const void* __restrict__ Xv, const float* __restrict__ gain, const float* __restrict__ modl, int sh_off, int sc_off, bf16* __restrict__ Hout,
                                               const bf16* __restrict__ Y = nullptr, int g_off = 0, const bf16* __restrict__ Y2 = nullptr, int g2_off = 0, bf16* Xout = nullptr, const float* __restrict__ d0 = nullptr) {
    const int gw = C.vcu * NWAVES + C.wave, NGW = C.G * NWAVES;
    for (int rg = gw; rg < M / 16; rg += NGW) {
        const int row0 = rg * 16, b = row0 >> 13;
        f32x4 Gv[4], Sv[4], Yg[4], Yg2[4], Yd[4];
#pragma unroll
        for (int j = 0; j < 4; ++j) { const int col = 4 * C.lane + 256 * j;
            const f32x4 g = *(const f32x4*)(gain + col), sc = *(const f32x4*)(modl + (size_t)b * MODW + sc_off + col);
            Gv[j] = g * (sc + 1.0f); Sv[j] = *(const f32x4*)(modl + (size_t)b * MODW + sh_off + col);
            if constexpr (HY) Yg[j] = *(const f32x4*)(modl + (size_t)b * MODW + g_off + col);
            if constexpr (HD0) Yd[j] = Yg[j] * *(const f32x4*)(d0 + (size_t)b * DM + col);
            if constexpr (Y8) Yg[j] = Yg[j] * 0.0625f;
            if constexpr (HY2) Yg2[j] = *(const f32x4*)(modl + (size_t)b * MODW + g2_off + col); }
        struct Buf { f32x4 v[2][4]; unsigned long long xb[2][4], y[2][4], y2[2][4]; };
        auto load = [&](Buf& B, int r) __attribute__((always_inline)) {
#pragma unroll
            for (int q = 0; q < 2; ++q) { const size_t ro = (size_t)(row0 + r + q) * DM;
                if constexpr (XB) { const GAS unsigned long long* xr = (const GAS unsigned long long*)((const bf16*)Xv + ro) + C.lane;
#pragma unroll
                    for (int j = 0; j < 4; ++j) B.xb[q][j] = xr[64 * j]; }
                else { const GAS f32x4* xr = (const GAS f32x4*)((const float*)Xv + ro) + C.lane;
#pragma unroll
                    for (int j = 0; j < 4; ++j) B.v[q][j] = xr[64 * j]; }
                if constexpr (HY && Y8) { const GAS unsigned* yr = (const GAS unsigned*)((const GAS unsigned char*)Y + (size_t)((row0 + r + q) >> 12) * F8_XS + (size_t)((row0 + r + q) & 4095) * DM) + C.lane;
#pragma unroll
                    for (int j = 0; j < 4; ++j) B.y[q][j] = yr[64 * j]; }
                if constexpr (HY && !Y8) { const GAS unsigned long long* yr = (const GAS unsigned long long*)(Y + ro) + C.lane;
#pragma unroll
                    for (int j = 0; j < 4; ++j) B.y[q][j] = yr[64 * j]; }
                if constexpr (HY2) { const GAS unsigned long long* yr = (const GAS unsigned long long*)(Y2 + ro) + C.lane;
#pragma unroll
                    for (int j = 0; j < 4; ++j) B.y2[q][j] = yr[64 * j]; } }
        };
        auto comp = [&](Buf& B, int r) __attribute__((always_inline)) {
#pragma unroll
            for (int q = 0; q < 2; ++q) { const size_t ro = (size_t)(row0 + r + q) * DM; float s = 0.f;
#pragma unroll
                for (int j = 0; j < 4; ++j) {
                    if constexpr (XB) { const unsigned lo = (unsigned)B.xb[q][j], hi = (unsigned)(B.xb[q][j] >> 32); B.v[q][j] = (f32x4){bf_lo(lo), bf_hi(lo), bf_lo(hi), bf_hi(hi)}; }
                    if constexpr (HY && Y8) { const unsigned w = (unsigned)B.y[q][j]; B.v[q][j] = B.v[q][j] + Yg[j] * (f32x4){__builtin_amdgcn_cvt_f32_fp8(w, 0), __builtin_amdgcn_cvt_f32_fp8(w, 1), __builtin_amdgcn_cvt_f32_fp8(w, 2), __builtin_amdgcn_cvt_f32_fp8(w, 3)}; }
                    if constexpr (HY && !Y8) { const unsigned lo = (unsigned)B.y[q][j], hi = (unsigned)(B.y[q][j] >> 32); B.v[q][j] = B.v[q][j] + Yg[j] * (f32x4){bf_lo(lo), bf_hi(lo), bf_lo(hi), bf_hi(hi)}; }
                    if constexpr (HD0) B.v[q][j] = B.v[q][j] + Yd[j];
                    if constexpr (HY2) { const unsigned lo = (unsigned)B.y2[q][j], hi = (unsigned)(B.y2[q][j] >> 32); B.v[q][j] = B.v[q][j] + Yg2[j] * (f32x4){bf_lo(lo), bf_hi(lo), bf_lo(hi), bf_hi(hi)}; }
                    s += (B.v[q][j].x * B.v[q][j].x + B.v[q][j].y * B.v[q][j].y) + (B.v[q][j].z * B.v[q][j].z + B.v[q][j].w * B.v[q][j].w); }
                if constexpr (HXO) { GAS unsigned long long* xo = (GAS unsigned long long*)(Xout + ro) + C.lane;
#pragma unroll
                    for (int j = 0; j < 4; ++j) xo[64 * j] = (unsigned long long)pk2(B.v[q][j].x, B.v[q][j].y) | ((unsigned long long)pk2(B.v[q][j].z, B.v[q][j].w) << 32); }
                const float rstd = __builtin_amdgcn_rsqf(wave_sum(s) * (1.0f / DM) + 1e-6f);
                if constexpr (H8) {
                    GAS unsigned* o4 = (GAS unsigned*)((GAS unsigned char*)Hout + (size_t)((row0 + r + q) >> 12) * F8_XS + (size_t)((row0 + r + q) & 4095) * DM) + C.lane;
#pragma unroll
                    for (int j = 0; j < 4; ++j) { const f32x4 o = B.v[q][j] * rstd * Gv[j];
                        unsigned w = 0u; w = __builtin_amdgcn_cvt_pk_fp8_f32(o.x, o.y, w, false); w = __builtin_amdgcn_cvt_pk_fp8_f32(o.z, o.w, w, true); o4[64 * j] = w; }
                } else {
                GAS unsigned long long* o8 = (GAS unsigned long long*)(Hout + ro) + C.lane;
#pragma unroll
                for (int j = 0; j < 4; ++j) { const f32x4 o = B.v[q][j] * rstd * Gv[j] + Sv[j];
                    o8[64 * j] = (unsigned long long)pk2(o.x, o.y) | ((unsigned long long)pk2(o.z, o.w) << 32); } } }
        };
        Buf A, Bb;
        load(A, 0);
        for (int r = 0; r < 12; r += 4) { load(Bb, r + 2); comp(A, r); load(A, r + 4); comp(Bb, r + 2); }
        load(Bb, 14); comp(A, 12); comp(Bb, 14);
    }
}

__device__ __forceinline__ void kmean_phase(const Ctx& C, const bf16* Kb, float* kmean) {
    LAS float* part = (LAS float*)C.lds;
    const int ch = C.tid & 15, rg = C.tid >> 4;
    for (int u = C.vcu; u < 1024; u += C.G) {
        const int bh = u >> 5, j = u & 31, b = bh >> 3, h = bh & 7;
        const bf16* Kg = Kb + (size_t)(b * SEQ + j * 256 + rg * 8) * DM + h * HD + ch * 8;
        float a[8];
#pragma unroll
        for (int e = 0; e < 8; ++e) a[e] = 0.f;
#pragma unroll
        for (int r = 0; r < 8; ++r) { const v4u w = *(const v4u*)(Kg + (size_t)r * DM);
            a[0] += bf_lo(w.x); a[1] += bf_hi(w.x); a[2] += bf_lo(w.y); a[3] += bf_hi(w.y); a[4] += bf_lo(w.z); a[5] += bf_hi(w.z); a[6] += bf_lo(w.w); a[7] += bf_hi(w.w); }
        __syncthreads();
        *(LAS f32x4*)(part + rg * 128 + ch * 8) = (f32x4){a[0], a[1], a[2], a[3]}; *(LAS f32x4*)(part + rg * 128 + ch * 8 + 4) = (f32x4){a[4], a[5], a[6], a[7]};
        __syncthreads();
        if (C.tid < 128) { float s = 0.f;
#pragma unroll 8
            for (int g = 0; g < 32; ++g) s += part[g * 128 + C.tid];
            kmean[(size_t)(bh * 32 + j) * 128 + C.tid] = s * (1.0f / 256.0f); }
    }
}

typedef float f32x16r __attribute__((ext_vector_type(16)));
#define ROUTE_INS(SC, JJ) { const float sc_ = (SC); const int jj_ = (JJ); if (sc_ > v2) { if (sc_ > v1) { v2 = v1; i2 = i1; if (sc_ > v0) { v1 = v0; i1 = i0; v0 = sc_; i0 = jj_; } else { v1 = sc_; i1 = jj_; } } else { v2 = sc_; i2 = jj_; } } }
__device__ __forceinline__ void route_phase(const Ctx& C, const bf16* Qb, const float* kmean, unsigned* lists, gu32* lcnt) {
    const int r32 = C.lane & 31, hi = C.lane >> 5;
    for (int u = C.vcu; u < 512; u += C.G) {
        int bh = u >> 4, qc = (u & 256) ? 15 - (u & 15) : (u & 15);
        if (C.local) { const int w = C.vcu & 63, k = u >> 8; bh = 8 * (C.vcu >> 6) + 4 * k + (w >> 4); qc = k ? 15 - (w & 15) : (w & 15); }
        const int b = bh >> 3, h = bh & 7;
        const int s = qc * 512 + C.tid, nb = __builtin_amdgcn_readfirstlane(s >> 8);
        bf16x8 kh[8], kl[8];
        { const float* kp = kmean + (size_t)bh * 4096 + r32 * 128 + 8 * hi;
#pragma unroll
            for (int t = 0; t < 8; ++t) { const f32x4 a = *(const f32x4*)(kp + 16 * t), c = *(const f32x4*)(kp + 16 * t + 4);
                pg8::u32x4 wh, wl;
                wh.x = pg8::cvt_pk_bf16(a[0], a[1]); wh.y = pg8::cvt_pk_bf16(a[2], a[3]); wh.z = pg8::cvt_pk_bf16(c[0], c[1]); wh.w = pg8::cvt_pk_bf16(c[2], c[3]);
                wl.x = pg8::cvt_pk_bf16(a[0] - bf_lo(wh.x), a[1] - bf_hi(wh.x)); wl.y = pg8::cvt_pk_bf16(a[2] - bf_lo(wh.y), a[3] - bf_hi(wh.y));
                wl.z = pg8::cvt_pk_bf16(c[0] - bf_lo(wh.z), c[1] - bf_hi(wh.z)); wl.w = pg8::cvt_pk_bf16(c[2] - bf_lo(wh.w), c[3] - bf_hi(wh.w));
                kh[t] = __builtin_bit_cast(bf16x8, wh); kl[t] = __builtin_bit_cast(bf16x8, wl); } }
        const float NEG = -__builtin_inff();
        int i0 = -1, i1 = -1, i2 = -1;
#pragma unroll
        for (int tl = 0; tl < 2; ++tl) {
            const bf16* qp = Qb + (size_t)(b * SEQ + qc * 512 + C.wave * 64 + tl * 32 + r32) * DM + h * HD + 8 * hi;
            bf16x8 qf[8];
#pragma unroll
            for (int t = 0; t < 8; ++t) qf[t] = *(const bf16x8*)(qp + 16 * t);
            f32x16r acc;
#pragma unroll
            for (int r = 0; r < 16; ++r) acc[r] = 0.f;
#pragma unroll
            for (int t = 0; t < 8; ++t) { acc = __builtin_amdgcn_mfma_f32_32x32x16_bf16(kh[t], qf[t], acc, 0, 0, 0); acc = __builtin_amdgcn_mfma_f32_32x32x16_bf16(kl[t], qf[t], acc, 0, 0, 0); }
            float v0 = NEG, v1 = NEG, v2 = NEG; int j0 = -1, j1 = -1, j2 = -1;
            { int i0 = -1, i1 = -1, i2 = -1;
#pragma unroll
                for (int r = 0; r < 16; ++r) { const int j = (r & 3) + 8 * (r >> 2) + 4 * hi; if (j < nb) ROUTE_INS(acc[r], j) }
                const auto a0 = __builtin_amdgcn_permlane32_swap(__float_as_uint(v0), __float_as_uint(v0), false, false), a1 = __builtin_amdgcn_permlane32_swap(__float_as_uint(v1), __float_as_uint(v1), false, false),
                           a2 = __builtin_amdgcn_permlane32_swap(__float_as_uint(v2), __float_as_uint(v2), false, false);
                const auto b0 = __builtin_amdgcn_permlane32_swap((unsigned)i0, (unsigned)i0, false, false), b1 = __builtin_amdgcn_permlane32_swap((unsigned)i1, (unsigned)i1, false, false),
                           b2 = __builtin_amdgcn_permlane32_swap((unsigned)i2, (unsigned)i2, false, false);
                v0 = NEG; v1 = NEG; v2 = NEG; i0 = -1; i1 = -1; i2 = -1;
                ROUTE_INS(__uint_as_float(a0[0]), (int)b0[0]) ROUTE_INS(__uint_as_float(a1[0]), (int)b1[0]) ROUTE_INS(__uint_as_float(a2[0]), (int)b2[0])
                ROUTE_INS(__uint_as_float(a0[1]), (int)b0[1]) ROUTE_INS(__uint_as_float(a1[1]), (int)b1[1]) ROUTE_INS(__uint_as_float(a2[1]), (int)b2[1])
                j0 = i0; j1 = i1; j2 = i2; }
            if (hi == tl) { i0 = j0; i1 = j1; i2 = j2; }
        }
        unsigned long long mymask = 0ull;
        for (int jj = 0; jj < nb; ++jj) { const bool hit = (i0 == jj) | (i1 == jj) | (i2 == jj); const unsigned long long mk = __ballot(hit); if (C.lane == jj) mymask = mk; }
        const int n = __popcll(mymask); unsigned base = 0u;
        if (C.lane < nb && n > 0) base = __hip_atomic_fetch_add(lcnt + bh * 32 + C.lane, (unsigned)n, __ATOMIC_RELAXED, __HIP_MEMORY_SCOPE_AGENT);
        const unsigned long long below = (1ull << C.lane) - 1ull;
#pragma unroll
        for (int t = 0; t < 3; ++t) { const int it = t == 0 ? i0 : (t == 1 ? i1 : i2); const int src = it < 0 ? 0 : it;
            const unsigned bs = __shfl(base, src); const unsigned mlo = __shfl((unsigned)mymask, src), mhi = __shfl((unsigned)(mymask >> 32), src);
            const unsigned long long mk = ((unsigned long long)mhi << 32) | mlo;
            const unsigned pos = bs + (unsigned)__popcll(mk & below);
            if (it >= 0 && pos < (unsigned)LCAP) lists[list_off(bh, it) + pos] = ((unsigned)s << 2) | (unsigned)(t + 1); }
    }
}

namespace moba {
__device__ const unsigned short ATT_SCHED_PAIR[64 * 8] = {
    0, 135, 192, 65535, 65535, 65535, 65535, 65535,
    1, 134, 193, 65535, 65535, 65535, 65535, 65535,
    2, 133, 194, 65535, 65535, 65535, 65535, 65535,
    3, 132, 195, 65535, 65535, 65535, 65535, 65535,
    4, 131, 196, 65535, 65535, 65535, 65535, 65535,
    5, 130, 197, 65535, 65535, 65535, 65535, 65535,
    6, 129, 198, 65535, 65535, 65535, 65535, 65535,
    7, 128, 199, 65535, 65535, 65535, 65535, 65535,
    8, 143, 184, 240, 65535, 65535, 65535, 65535,
    9, 142, 185, 241, 65535, 65535, 65535, 65535,
    10, 141, 186, 242, 65535, 65535, 65535, 65535,
    11, 140, 187, 243, 65535, 65535, 65535, 65535,
    12, 139, 188, 244, 65535, 65535, 65535, 65535,
    13, 138, 189, 245, 65535, 65535, 65535, 65535,
    14, 137, 190, 246, 65535, 65535, 65535, 65535,
    15, 136, 191, 247, 65535, 65535, 65535, 65535,
    16, 104, 183, 232, 65535, 65535, 65535, 65535,
    17, 105, 182, 233, 65535, 65535, 65535, 65535,
    18, 106, 181, 234, 65535, 65535, 65535, 65535,
    19, 107, 180, 235, 65535, 65535, 65535, 65535,
    20, 108, 179, 236, 65535, 65535, 65535, 65535,
    21, 109, 178, 237, 65535, 65535, 65535, 65535,
    22, 110, 177, 238, 65535, 65535, 65535, 65535,
    23, 111, 176, 239, 65535, 65535, 65535, 65535,
    24, 95, 160, 224, 65535, 65535, 65535, 65535,
    25, 94, 161, 225, 65535, 65535, 65535, 65535,
    26, 93, 162, 226, 65535, 65535, 65535, 65535,
    27, 92, 163, 227, 65535, 65535, 65535, 65535,
    28, 91, 164, 228, 65535, 65535, 65535, 65535,
    29, 90, 165, 229, 65535, 65535, 65535, 65535,
    30, 89, 166, 230, 65535, 65535, 65535, 65535,
    31, 88, 167, 231, 65535, 65535, 65535, 65535,
    32, 103, 127, 208, 65535, 65535, 65535, 65535,
    33, 102, 126, 209, 65535, 65535, 65535, 65535,
    34, 101, 125, 210, 65535, 65535, 65535, 65535,
    35, 100, 124, 211, 65535, 65535, 65535, 65535,
    36, 99, 123, 212, 65535, 65535, 65535, 65535,
    37, 98, 122, 213, 65535, 65535, 65535, 65535,
    38, 97, 121, 214, 65535, 65535, 65535, 65535,
    39, 96, 120, 215, 65535, 65535, 65535, 65535,
    40, 80, 144, 175, 65535, 65535, 65535, 65535,
    41, 81, 145, 174, 65535, 65535, 65535, 65535,
    42, 82, 146, 173, 65535, 65535, 65535, 65535,
    43, 83, 147, 172, 65535, 65535, 65535, 65535,
    44, 84, 148, 171, 65535, 65535, 65535, 65535,
    45, 85, 149, 170, 65535, 65535, 65535, 65535,
    46, 86, 150, 169, 65535, 65535, 65535, 65535,
    47, 87, 151, 168, 65535, 65535, 65535, 65535,
    48, 72, 112, 200, 65535, 65535, 65535, 65535,
    49, 73, 113, 201, 65535, 65535, 65535, 65535,
    50, 74, 114, 202, 65535, 65535, 65535, 65535,
    51, 75, 115, 203, 65535, 65535, 65535, 65535,
    52, 76, 116, 204, 65535, 65535, 65535, 65535,
    53, 77, 117, 205, 65535, 65535, 65535, 65535,
    54, 78, 118, 206, 65535, 65535, 65535, 65535,
    55, 79, 119, 207, 65535, 65535, 65535, 65535,
    56, 64, 159, 216, 248, 65535, 65535, 65535,
    57, 65, 158, 217, 249, 65535, 65535, 65535,
    58, 66, 157, 218, 250, 65535, 65535, 65535,
    59, 67, 156, 219, 251, 65535, 65535, 65535,
    60, 68, 155, 220, 252, 65535, 65535, 65535,
    61, 69, 154, 221, 253, 65535, 65535, 65535,
    62, 70, 153, 222, 254, 65535, 65535, 65535,
    63, 71, 152, 223, 255, 65535, 65535, 65535,
};
__device__ const unsigned short ATT_SCHED[256 * 8] = {
    0, 552, 545, 65535, 65535, 65535, 65535, 65535,
    1, 556, 565, 65535, 65535, 65535, 65535, 65535,
    2, 560, 564, 65535, 65535, 65535, 65535, 65535,
    3, 513, 588, 65535, 65535, 65535, 65535, 65535,
    4, 480, 612, 65535, 65535, 65535, 65535, 65535,
    5, 524, 589, 65535, 65535, 65535, 65535, 65535,
    6, 498, 611, 65535, 65535, 65535, 65535, 65535,
    7, 457, 664, 65535, 65535, 65535, 65535, 65535,
    8, 458, 663, 65535, 65535, 65535, 65535, 65535,
    9, 459, 656, 65535, 65535, 65535, 65535, 65535,
    10, 460, 655, 65535, 65535, 65535, 65535, 65535,
    11, 491, 620, 65535, 65535, 65535, 65535, 65535,
    12, 492, 630, 65535, 65535, 65535, 65535, 65535,
    13, 493, 623, 65535, 65535, 65535, 65535, 65535,
    14, 530, 601, 65535, 65535, 65535, 65535, 65535,
    15, 531, 603, 65535, 65535, 65535, 65535, 65535,
    16, 523, 605, 65535, 65535, 65535, 65535, 65535,
    17, 522, 607, 65535, 65535, 65535, 65535, 65535,
    18, 537, 591, 65535, 65535, 65535, 65535, 65535,
    19, 534, 594, 65535, 65535, 65535, 65535, 65535,
    20, 536, 593, 65535, 65535, 65535, 65535, 65535,
    21, 535, 596, 65535, 65535, 65535, 65535, 65535,
    22, 539, 595, 65535, 65535, 65535, 65535, 65535,
    23, 466, 651, 65535, 65535, 65535, 65535, 65535,
    24, 386, 784, 65535, 65535, 65535, 65535, 65535,
    25, 387, 782, 65535, 65535, 65535, 65535, 65535,
    26, 388, 799, 65535, 65535, 65535, 65535, 65535,
    27, 389, 798, 65535, 65535, 65535, 65535, 65535,
    28, 390, 797, 65535, 65535, 65535, 65535, 65535,
    29, 391, 796, 65535, 65535, 65535, 65535, 65535,
    30, 352, 842, 65535, 65535, 65535, 65535, 65535,
    31, 456, 644, 65535, 65535, 65535, 65535, 65535,
    32, 540, 786, 1019, 65535, 65535, 65535, 65535,
    33, 504, 915, 946, 65535, 65535, 65535, 65535,
    34, 428, 964, 1017, 65535, 65535, 65535, 65535,
    35, 427, 991, 1009, 65535, 65535, 65535, 65535,
    36, 426, 990, 997, 65535, 65535, 65535, 65535,
    37, 425, 965, 996, 65535, 65535, 65535, 65535,
    38, 424, 966, 995, 65535, 65535, 65535, 65535,
    39, 461, 951, 986, 65535, 65535, 65535, 65535,
    40, 547, 792, 968, 65535, 65535, 65535, 65535,
    41, 561, 791, 969, 65535, 65535, 65535, 65535,
    42, 515, 790, 992, 65535, 65535, 65535, 65535,
    43, 558, 789, 971, 65535, 65535, 65535, 65535,
    44, 518, 885, 903, 65535, 65535, 65535, 65535,
    45, 519, 854, 931, 65535, 65535, 65535, 65535,
    46, 568, 809, 911, 65535, 65535, 65535, 65535,
    47, 566, 736, 1011, 65535, 65535, 65535, 65535,
    48, 567, 737, 1020, 65535, 65535, 65535, 65535,
    49, 600, 714, 977, 65535, 65535, 65535, 65535,
    50, 514, 881, 904, 65535, 65535, 65535, 65535,
    51, 602, 716, 979, 65535, 65535, 65535, 65535,
    52, 541, 893, 920, 65535, 65535, 65535, 65535,
    53, 604, 712, 981, 65535, 65535, 65535, 65535,
    54, 528, 872, 919, 65535, 65535, 65535, 65535,
    55, 606, 715, 983, 65535, 65535, 65535, 65535,
    56, 538, 892, 906, 65535, 65535, 65535, 65535,
    57, 520, 864, 896, 65535, 65535, 65535, 65535,
    58, 521, 880, 898, 65535, 65535, 65535, 65535,
    59, 526, 877, 899, 65535, 65535, 65535, 65535,
    60, 529, 866, 927, 65535, 65535, 65535, 65535,
    61, 577, 725, 970, 65535, 65535, 65535, 65535,
    62, 576, 728, 976, 65535, 65535, 65535, 65535,
    63, 497, 913, 942, 65535, 65535, 65535, 65535,
    64, 416, 693, 999, 65535, 65535, 65535, 65535,
    65, 417, 673, 998, 65535, 65535, 65535, 65535,
    66, 418, 765, 940, 65535, 65535, 65535, 65535,
    67, 419, 709, 973, 65535, 65535, 65535, 65535,
    68, 420, 695, 1010, 65535, 65535, 65535, 65535,
    69, 421, 724, 972, 65535, 65535, 65535, 65535,
    70, 422, 723, 980, 65535, 65535, 65535, 65535,
    71, 423, 726, 967, 65535, 65535, 65535, 65535,
    72, 490, 680, 889, 65535, 65535, 65535, 65535,
    73, 489, 681, 890, 65535, 65535, 65535, 65535,
    74, 488, 682, 887, 65535, 65535, 65535, 65535,
    75, 487, 683, 888, 65535, 65535, 65535, 65535,
    76, 507, 694, 878, 65535, 65535, 65535, 65535,
    77, 429, 722, 962, 65535, 65535, 65535, 65535,
    78, 430, 731, 982, 65535, 65535, 65535, 65535,
    79, 431, 743, 943, 65535, 65535, 65535, 65535,
    80, 432, 745, 944, 65535, 65535, 65535, 65535,
    81, 433, 747, 945, 65535, 65535, 65535, 65535,
    82, 434, 732, 984, 65535, 65535, 65535, 65535,
    83, 435, 721, 985, 65535, 65535, 65535, 65535,
    84, 436, 734, 961, 65535, 65535, 65535, 65535,
    85, 437, 748, 949, 65535, 65535, 65535, 65535,
    86, 438, 751, 950, 65535, 65535, 65535, 65535,
    87, 439, 767, 907, 65535, 65535, 65535, 65535,
    88, 440, 696, 1023, 65535, 65535, 65535, 65535,
    89, 465, 697, 953, 65535, 65535, 65535, 65535,
    90, 455, 698, 954, 65535, 65535, 65535, 65535,
    91, 454, 699, 955, 65535, 65535, 65535, 65535,
    92, 453, 700, 956, 65535, 65535, 65535, 65535,
    93, 452, 701, 957, 65535, 65535, 65535, 65535,
    94, 451, 702, 958, 65535, 65535, 65535, 65535,
    95, 450, 703, 959, 65535, 65535, 65535, 65535,
    96, 502, 640, 657, 65535, 65535, 65535, 65535,
    97, 501, 641, 658, 65535, 65535, 65535, 65535,
    98, 500, 642, 659, 65535, 65535, 65535, 65535,
    99, 499, 643, 660, 65535, 65535, 65535, 65535,
    100, 525, 609, 661, 65535, 65535, 65535, 65535,
    101, 469, 646, 727, 65535, 65535, 65535, 65535,
    102, 463, 636, 757, 65535, 65535, 65535, 65535,
    103, 462, 647, 730, 65535, 65535, 65535, 65535,
    104, 464, 648, 705, 65535, 65535, 65535, 65535,
    105, 393, 689, 768, 65535, 65535, 65535, 65535,
    106, 394, 688, 769, 65535, 65535, 65535, 65535,
    107, 395, 704, 754, 65535, 65535, 65535, 65535,
    108, 396, 583, 909, 65535, 65535, 65535, 65535,
    109, 397, 581, 910, 65535, 65535, 65535, 65535,
    110, 398, 582, 921, 65535, 65535, 65535, 65535,
    111, 399, 586, 922, 65535, 65535, 65535, 65535,
    112, 400, 590, 912, 65535, 65535, 65535, 65535,
    113, 401, 690, 776, 65535, 65535, 65535, 65535,
    114, 402, 686, 778, 65535, 65535, 65535, 65535,
    115, 403, 685, 780, 65535, 65535, 65535, 65535,
    116, 404, 707, 750, 65535, 65535, 65535, 65535,
    117, 405, 706, 749, 65535, 65535, 65535, 65535,
    118, 392, 621, 874, 65535, 65535, 65535, 65535,
    119, 407, 599, 925, 65535, 65535, 65535, 65535,
    120, 408, 580, 926, 65535, 65535, 65535, 65535,
    121, 409, 613, 884, 65535, 65535, 65535, 65535,
    122, 410, 666, 831, 65535, 65535, 65535, 65535,
    123, 411, 639, 873, 65535, 65535, 65535, 65535,
    124, 412, 638, 894, 65535, 65535, 65535, 65535,
    125, 353, 674, 853, 65535, 65535, 65535, 65535,
    126, 414, 670, 800, 65535, 65535, 65535, 65535,
    127, 415, 671, 830, 65535, 65535, 65535, 65535,
    128, 406, 448, 908, 65535, 65535, 65535, 65535,
    174, 285, 592, 840, 65535, 65535, 65535, 65535,
    130, 304, 672, 807, 65535, 65535, 65535, 65535,
    131, 301, 760, 739, 65535, 65535, 65535, 65535,
    132, 284, 720, 841, 65535, 65535, 65535, 65535,
    133, 281, 756, 812, 65535, 65535, 65535, 65535,
    134, 282, 753, 828, 65535, 65535, 65535, 65535,
    135, 279, 755, 826, 65535, 65535, 65535, 65535,
    136, 280, 735, 851, 65535, 65535, 65535, 65535,
    137, 277, 777, 771, 65535, 65535, 65535, 65535,
    138, 316, 758, 738, 65535, 65535, 65535, 65535,
    139, 317, 710, 766, 65535, 65535, 65535, 65535,
    140, 276, 744, 823, 65535, 65535, 65535, 65535,
    141, 273, 729, 857, 65535, 65535, 65535, 65535,
    142, 274, 691, 923, 65535, 65535, 65535, 65535,
    143, 271, 692, 924, 65535, 65535, 65535, 65535,
    144, 272, 742, 808, 65535, 65535, 65535, 65535,
    145, 269, 746, 802, 65535, 65535, 65535, 65535,
    146, 270, 752, 801, 65535, 65535, 65535, 65535,
    147, 267, 770, 787, 65535, 65535, 65535, 65535,
    148, 268, 773, 788, 65535, 65535, 65535, 65535,
    149, 265, 772, 779, 65535, 65535, 65535, 65535,
    150, 266, 775, 783, 65535, 65535, 65535, 65535,
    151, 263, 774, 781, 65535, 65535, 65535, 65535,
    182, 319, 449, 974, 65535, 65535, 65535, 65535,
    180, 318, 485, 914, 65535, 65535, 65535, 65535,
    181, 275, 484, 993, 65535, 65535, 65535, 65535,
    178, 278, 483, 994, 65535, 65535, 65535, 65535,
    179, 315, 482, 917, 65535, 65535, 65535, 65535,
    176, 314, 481, 918, 65535, 65535, 65535, 65535,
    177, 313, 543, 843, 65535, 65535, 65535, 65535,
    159, 256, 717, 855, 65535, 65535, 65535, 65535,
    160, 320, 546, 713, 65535, 65535, 65535, 65535,
    161, 376, 527, 708, 65535, 65535, 65535, 65535,
    162, 322, 563, 718, 65535, 65535, 65535, 65535,
    163, 323, 562, 719, 65535, 65535, 65535, 65535,
    164, 324, 517, 795, 65535, 65535, 65535, 65535,
    165, 325, 512, 794, 65535, 65535, 65535, 65535,
    166, 326, 494, 814, 65535, 65535, 65535, 65535,
    167, 327, 495, 852, 65535, 65535, 65535, 65535,
    168, 328, 447, 938, 65535, 65535, 65535, 65535,
    169, 329, 446, 937, 65535, 65535, 65535, 65535,
    170, 330, 445, 939, 65535, 65535, 65535, 65535,
    171, 331, 444, 934, 65535, 65535, 65535, 65535,
    172, 332, 443, 930, 65535, 65535, 65535, 65535,
    173, 333, 442, 933, 65535, 65535, 65535, 65535,
    129, 365, 503, 901, 65535, 65535, 65535, 65535,
    175, 335, 441, 932, 65535, 65535, 65535, 65535,
    157, 336, 675, 711, 65535, 65535, 65535, 65535,
    158, 337, 597, 839, 65535, 65535, 65535, 65535,
    155, 338, 544, 895, 65535, 65535, 65535, 65535,
    156, 339, 548, 886, 65535, 65535, 65535, 65535,
    153, 340, 549, 883, 65535, 65535, 65535, 65535,
    154, 341, 550, 879, 65535, 65535, 65535, 65535,
    152, 342, 551, 875, 65535, 65535, 65535, 65535,
    183, 343, 516, 793, 65535, 65535, 65535, 65535,
    184, 344, 542, 785, 65535, 65535, 65535, 65535,
    185, 345, 505, 803, 65535, 65535, 65535, 65535,
    186, 346, 506, 824, 65535, 65535, 65535, 65535,
    187, 347, 486, 820, 65535, 65535, 65535, 65535,
    188, 289, 508, 905, 65535, 65535, 65535, 65535,
    189, 349, 509, 821, 65535, 65535, 65535, 65535,
    190, 350, 510, 818, 65535, 65535, 65535, 65535,
    191, 351, 511, 822, 65535, 65535, 65535, 65535,
    192, 288, 385, 935, 65535, 65535, 65535, 65535,
    193, 348, 496, 687, 65535, 65535, 65535, 65535,
    194, 290, 384, 941, 65535, 65535, 65535, 65535,
    195, 291, 479, 859, 65535, 65535, 65535, 65535,
    196, 292, 478, 863, 65535, 65535, 65535, 65535,
    197, 293, 477, 862, 65535, 65535, 65535, 65535,
    198, 294, 476, 861, 65535, 65535, 65535, 65535,
    199, 295, 475, 834, 65535, 65535, 65535, 65535,
    200, 296, 474, 860, 65535, 65535, 65535, 65535,
    201, 297, 473, 849, 65535, 65535, 65535, 65535,
    202, 298, 472, 850, 65535, 65535, 65535, 65535,
    203, 299, 471, 847, 65535, 65535, 65535, 65535,
    204, 300, 470, 848, 65535, 65535, 65535, 65535,
    205, 283, 669, 665, 65535, 65535, 65535, 65535,
    206, 302, 468, 845, 65535, 65535, 65535, 65535,
    207, 303, 467, 846, 65535, 65535, 65535, 65535,
    208, 286, 587, 733, 65535, 65535, 65535, 65535,
    209, 305, 578, 645, 65535, 65535, 65535, 65535,
    210, 306, 579, 662, 65535, 65535, 65535, 65535,
    211, 307, 553, 679, 65535, 65535, 65535, 65535,
    212, 308, 555, 678, 65535, 65535, 65535, 65535,
    213, 309, 557, 677, 65535, 65535, 65535, 65535,
    214, 310, 559, 676, 65535, 65535, 65535, 65535,
    243, 311, 533, 633, 65535, 65535, 65535, 65535,
    242, 312, 532, 632, 65535, 65535, 65535, 65535,
    217, 258, 569, 759, 65535, 65535, 65535, 65535,
    218, 257, 570, 741, 65535, 65535, 65535, 65535,
    219, 260, 571, 740, 65535, 65535, 65535, 65535,
    220, 259, 572, 764, 65535, 65535, 65535, 65535,
    221, 262, 573, 762, 65535, 65535, 65535, 65535,
    222, 261, 574, 761, 65535, 65535, 65535, 65535,
    223, 264, 575, 763, 65535, 65535, 65535, 65535,
    224, 383, 668, 876, 897, 65535, 65535, 65535,
    225, 381, 667, 856, 936, 65535, 65535, 65535,
    226, 382, 598, 900, 952, 65535, 65535, 65535,
    227, 379, 637, 833, 987, 65535, 65535, 65535,
    228, 380, 634, 836, 988, 65535, 65535, 65535,
    229, 377, 635, 835, 989, 65535, 65535, 65535,
    230, 378, 649, 838, 929, 65535, 65535, 65535,
    231, 375, 650, 837, 928, 65535, 65535, 65535,
    232, 321, 653, 858, 1000, 65535, 65535, 65535,
    233, 373, 631, 829, 1001, 65535, 65535, 65535,
    234, 374, 628, 817, 1002, 65535, 65535, 65535,
    235, 371, 629, 816, 1003, 65535, 65535, 65535,
    236, 372, 626, 815, 1004, 65535, 65535, 65535,
    237, 369, 627, 827, 1005, 65535, 65535, 65535,
    238, 370, 624, 819, 1006, 65535, 65535, 65535,
    239, 367, 625, 813, 1007, 65535, 65535, 65535,
    240, 368, 622, 825, 1008, 65535, 65535, 65535,
    241, 334, 652, 844, 1022, 65535, 65535, 65535,
    216, 366, 654, 916, 1021, 65535, 65535, 65535,
    215, 363, 684, 871, 975, 65535, 65535, 65535,
    244, 364, 618, 811, 1012, 65535, 65535, 65535,
    245, 361, 619, 806, 1013, 65535, 65535, 65535,
    246, 362, 616, 810, 1014, 65535, 65535, 65535,
    247, 359, 617, 805, 1015, 65535, 65535, 65535,
    248, 360, 614, 804, 1016, 65535, 65535, 65535,
    249, 357, 615, 870, 948, 65535, 65535, 65535,
    250, 358, 585, 867, 1018, 65535, 65535, 65535,
    251, 355, 584, 868, 960, 65535, 65535, 65535,
    252, 356, 610, 865, 947, 65535, 65535, 65535,
    253, 413, 554, 882, 978, 65535, 65535, 65535,
    254, 354, 608, 832, 963, 65535, 65535, 65535,
    255, 287, 891, 869, 902, 65535, 65535, 65535
};
typedef float f32x16 __attribute__((ext_vector_type(16)));
typedef short s16x4 __attribute__((ext_vector_type(4)));
__device__ __forceinline__ int v_st(int k, int c) { return ((k >> 3) * 4 + (c >> 5)) * 512 + ((k & 7) * 32 + (c & 31)) * 2; }
__device__ __forceinline__ int v_rd_base(int lane) { return ((lane & 3) << 3) | (((lane >> 2) & 3) << 6) | (((lane >> 4) & 1) << 5) | (((lane >> 5) & 1) << 8); }
constexpr int v_rd_off(int d0, int ks, int half) { return d0 * 512 + ks * 4096 + half * 2048; }
template <int OFF> __device__ __forceinline__ s16x4 tr_read(int vb) { s16x4 r; asm volatile("ds_read_b64_tr_b16 %0, %1 offset:%2" : "=&v"(r) : "v"(vb), "i"(OFF) : "memory"); return r; }
__device__ __forceinline__ unsigned cvtpk(float lo, float hi) { unsigned r; asm volatile("v_cvt_pk_bf16_f32 %0, %1, %2" : "=v"(r) : "v"(lo), "v"(hi)); return r; }
#define MOBA_RD8(S, D0) if (abl & 64) { S##l0 = fk; S##h0 = fk; S##l1 = fk; S##h1 = fk; S##l2 = fk; S##h2 = fk; S##l3 = fk; S##h3 = fk; } else { S##l0 = tr_read<v_rd_off(D0, 0, 0)>(vb); S##h0 = tr_read<v_rd_off(D0, 0, 1)>(vb); S##l1 = tr_read<v_rd_off(D0, 1, 0)>(vb); S##h1 = tr_read<v_rd_off(D0, 1, 1)>(vb); \
                        S##l2 = tr_read<v_rd_off(D0, 2, 0)>(vb); S##h2 = tr_read<v_rd_off(D0, 2, 1)>(vb); S##l3 = tr_read<v_rd_off(D0, 3, 0)>(vb); S##h3 = tr_read<v_rd_off(D0, 3, 1)>(vb); }
#define MOBA_PK(L, H) (bf16x8){L[0], L[1], L[2], L[3], H[0], H[1], H[2], H[3]}
#define MOBA_MM(S, OD) OD = __builtin_amdgcn_mfma_f32_32x32x16_bf16(MOBA_PK(S##l0, S##h0), pb0, OD, 0, 0, 0); OD = __builtin_amdgcn_mfma_f32_32x32x16_bf16(MOBA_PK(S##l1, S##h1), pb1, OD, 0, 0, 0); \
                       OD = __builtin_amdgcn_mfma_f32_32x32x16_bf16(MOBA_PK(S##l2, S##h2), pb2, OD, 0, 0, 0); OD = __builtin_amdgcn_mfma_f32_32x32x16_bf16(MOBA_PK(S##l3, S##h3), pb3, OD, 0, 0, 0)
#define MOBA_WAIT(N) asm volatile("s_waitcnt lgkmcnt(" #N ")" ::: "memory"); __builtin_amdgcn_sched_barrier(0)
__device__ __forceinline__ void pv_all(f32x16 (&o)[4], int vb, bf16x8 pb0, bf16x8 pb1, bf16x8 pb2, bf16x8 pb3, int abl = 0) {
    const s16x4 fk = {pb0[0], pb0[1], pb0[2], pb0[3]};
    s16x4 Al0, Ah0, Al1, Ah1, Al2, Ah2, Al3, Ah3, Bl0, Bh0, Bl1, Bh1, Bl2, Bh2, Bl3, Bh3;
#define MOBA_MM2(OA, OB) OA = __builtin_amdgcn_mfma_f32_32x32x16_bf16(MOBA_PK(Al0, Ah0), pb0, OA, 0, 0, 0); OB = __builtin_amdgcn_mfma_f32_32x32x16_bf16(MOBA_PK(Bl0, Bh0), pb0, OB, 0, 0, 0); \
                         OA = __builtin_amdgcn_mfma_f32_32x32x16_bf16(MOBA_PK(Al1, Ah1), pb1, OA, 0, 0, 0); OB = __builtin_amdgcn_mfma_f32_32x32x16_bf16(MOBA_PK(Bl1, Bh1), pb1, OB, 0, 0, 0); \
                         OA = __builtin_amdgcn_mfma_f32_32x32x16_bf16(MOBA_PK(Al2, Ah2), pb2, OA, 0, 0, 0); OB = __builtin_amdgcn_mfma_f32_32x32x16_bf16(MOBA_PK(Bl2, Bh2), pb2, OB, 0, 0, 0); \
                         OA = __builtin_amdgcn_mfma_f32_32x32x16_bf16(MOBA_PK(Al3, Ah3), pb3, OA, 0, 0, 0); OB = __builtin_amdgcn_mfma_f32_32x32x16_bf16(MOBA_PK(Bl3, Bh3), pb3, OB, 0, 0, 0)
    MOBA_RD8(A, 0); MOBA_RD8(B, 1);
    MOBA_WAIT(0); MOBA_MM2(o[0], o[1]); __builtin_amdgcn_sched_barrier(0);
    MOBA_RD8(A, 2); MOBA_RD8(B, 3);
    MOBA_WAIT(0); MOBA_MM2(o[2], o[3]);
#undef MOBA_MM2
}
#undef MOBA_RD8
#undef MOBA_PK
#undef MOBA_MM
#undef MOBA_WAIT
__device__ __forceinline__ float max3f(float a, float b, float c) { float r; asm("v_max3_f32 %0, %1, %2, %3" : "=v"(r) : "v"(a), "v"(b), "v"(c)); return r; }
__device__ __forceinline__ bf16x8 pack_p(const f32x16& p, int base) {
    v4u w; w.x = cvtpk(p[base + 0], p[base + 1]); w.y = cvtpk(p[base + 2], p[base + 3]); w.z = cvtpk(p[base + 4], p[base + 5]); w.w = cvtpk(p[base + 6], p[base + 7]);
    return __builtin_bit_cast(bf16x8, w);
}

__device__ __forceinline__ void attn_phase(const Ctx& C, const bf16* Qb, const bf16* Kb, const bf16* Vb, const unsigned* lists, const unsigned* lcnt, gu32* qctr,
                                           bf16* POa, bf16* POb, float* LSE, const float* q_gain, const float* k_gain, int abl = 0) {
    LAS unsigned char* lds = C.lds;
    const int lane = C.lane, r32 = lane & 31, hi = lane >> 5;
    int koff[8];
#pragma unroll
    for (int d0 = 0; d0 < 8; ++d0) koff[d0] = r32 * 256 + ((d0 * 32 + hi * 16) ^ ((r32 & 15) << 4));
    const int vb0 = (int)(uintptr_t)(lds + 65536) + v_rd_base(lane);
    bool bounded;
    { float gq = 0.f, gk = 0.f;
#pragma unroll
        for (int i = 0; i < 2; ++i) { gq = fmaxf(gq, fabsf(q_gain[lane + 64 * i])); gk = fmaxf(gk, fabsf(k_gain[lane + 64 * i])); }
#pragma unroll
        for (int o_ = 1; o_ < 64; o_ <<= 1) { gq = fmaxf(gq, __shfl_xor(gq, o_)); gk = fmaxf(gk, __shfl_xor(gk, o_)); }
        bounded = (gq * gk * 11.313708499f * 1.4426950408889634f * 1.02f) <= 40.0f; }
#ifdef ATTN_PROBE
    unsigned long long pr_step = 0, pr_nstep = 0, pr_stage = 0, pr_nunit = 0, pr_tile = 0, pr_ntile = 0, pr_ta = 0, pr_tb = 0, pr_tc = 0; const unsigned long long pr_t0 = clock64();
#define PR_T() clock64()
#endif
    const bool tab = (C.G == 256); const unsigned short* sched = C.local ? ATT_SCHED_PAIR + (C.vcu & 63) * 8 : ATT_SCHED + (blockIdx.x & 255) * 8;
    const unsigned bh0 = 8u * (unsigned)(C.vcu >> 6);
#define MOBA_SCHED(K) ((K) < 8 ? (C.local ? (sched[K] == 0xFFFFu ? 0xFFFFu : ((unsigned)(sched[K] >> 3) << 5) + bh0 + (unsigned)(sched[K] & 7)) : (unsigned)sched[K]) : 0xFFFFu)
    unsigned u = tab ? MOBA_SCHED(0) : (unsigned)blockIdx.x;
    for (int k = 0; u < 1024u; ++k) {
        const int j = (int)(u >> 5), bh = (int)(u & 31u), b = bh >> 3, h = bh & 7;
#ifdef ATTN_PROBE
        const unsigned long long pr_s0 = PR_T();
#endif
        v4u kreg[8], vreg[8];
        int tidv = C.tid; asm volatile("" : "+v"(tidv));
        { const bf16* Kg = Kb + (size_t)(b * SEQ + j * 256) * DM + h * HD; const bf16* Vg = Vb + (size_t)((b * SEQ + j * 256) >> 12) * VXTRA + (size_t)(b * SEQ + j * 256) * DM + h * HD;
#pragma unroll
            for (int i = 0; i < 8; ++i) { const int c = tidv + i * NT, row = c >> 4, ch = c & 15;
                kreg[i] = *(const v4u*)(Kg + (size_t)row * DM + ch * 8); vreg[i] = *(const v4u*)(Vg + (size_t)row * DM + ch * 8); } }
        int cnt = (int)lcnt[bh * 32 + j]; cnt = cnt > LCAP ? LCAP : cnt;
        const unsigned* lst = lists + list_off(bh, j);
        const int G = (cnt + 31) >> 5, ntiles = G + 8;
        int r32l = r32; asm volatile("" : "+v"(r32l));
#define MOBA_ENTRY(E, T) do { if ((T) >= G) E = ((unsigned)(j * 256 + (7 - ((T) - G)) * 32 + r32l) << 2); else E = lst[(T) * 32 + r32l]; } while (0)
#define MOBA_LOADQ(QV, E) do { const bf16* qp_ = Qb + (size_t)(b * SEQ + ((abl & 2) ? r32 : (int)(((E) >> 2) & 8191u))) * DM + h * HD + hi * 8; _Pragma("unroll") for (int d0 = 0; d0 < 8; ++d0) QV[d0] = *(const bf16x8*)(qp_ + d0 * 16); } while (0)
#define MOBA_FETCH(T) do { int t_ = 0; if (lane == 0) t_ = (int)__hip_atomic_fetch_add((LAS unsigned*)(C.misc + 1), 1u, __ATOMIC_RELAXED, __HIP_MEMORY_SCOPE_WORKGROUP); T = __builtin_amdgcn_readfirstlane(t_); } while (0)
        int t0 = C.wave, t1 = C.wave + 8; unsigned e0 = 0u, e1 = 0u;
        if (t0 < ntiles) MOBA_ENTRY(e0, t0);
        if (t1 < ntiles) MOBA_ENTRY(e1, t1);
#ifdef ATTN_PROBE
        asm volatile("s_waitcnt vmcnt(0) lgkmcnt(0)" ::: "memory"); const unsigned long long pr_s1 = PR_T();
#endif
        __syncthreads();
#ifdef ATTN_PROBE
        const unsigned long long pr_s2 = PR_T();
#endif
        if (C.tid == 0) C.misc[1] = 16u;
        bf16x8 qr[8];
        MOBA_LOADQ(qr, e0);
#pragma unroll
        for (int i = 0; i < 8; ++i) { const int c = tidv + i * NT, row = c >> 4, ch = c & 15;
            *(LAS v4u*)(lds + row * 256 + ((ch * 16) ^ ((row & 15) << 4))) = kreg[i];
            *(LAS v4u*)(lds + 65536 + (row >> 6) * 16384 + v_st(row & 63, ch * 8)) = vreg[i]; }
        __syncthreads();
#ifdef ATTN_PROBE
        { const unsigned long long pr_s3 = PR_T(); pr_stage += pr_s3 - pr_s0; pr_nunit += 1; pr_ta += pr_s1 - pr_s0; pr_tb += pr_s2 - pr_s1; pr_tc += pr_s3 - pr_s2; }
#endif
        unsigned opk[16]; unsigned oent = 0u; float olse = 0.f, oscl = 0.f; bool ovalid = false;
#define MOBA_FLUSH() do { if (ovalid) { const int sq_ = (int)((oent >> 2) & 8191u), sl_ = (int)(oent & 3u); \
            unsigned char* dst_ = (unsigned char*)(sl_ < 2 ? POa : POb) + po_off(sl_, b * SEQ + sq_) + h * HD + 16 * hi; \
            _Pragma("unroll") for (int i_ = 0; i_ < 4; ++i_) { v4u w_; w_.x = opk[4 * i_]; w_.y = opk[4 * i_ + 1]; w_.z = opk[4 * i_ + 2]; w_.w = opk[4 * i_ + 3]; *(v4u*)(dst_ + 32 * i_) = w_; } \
            if (hi == 0) ((float*)POa)[psc_off(b * SEQ + sq_, h) + sl_] = oscl; \
            if (hi == 0) LSE[((size_t)bh * SEQ + sq_) * 4 + sl_] = olse; } } while (0)
        if ((abl & 128) && C.wave >= 4) t0 = ntiles;
        while (t0 < ntiles) {
            bf16x8 qn[8];
            MOBA_LOADQ(qn, e1);
            int t2; unsigned e2 = 0u; MOBA_FETCH(t2); if (t2 < ntiles) MOBA_ENTRY(e2, t2);
            if (!(abl & 1)) MOBA_FLUSH();
            const int sq = (int)((e0 >> 2) & 8191u);
            const bool causal = t0 >= G; const int nkt = (abl & 4) ? 1 : (causal ? (((7 - (t0 - G)) >> 1) + 1) : 4);
            const bool valid = causal || (t0 * 32 + r32 < cnt);
#ifdef ATTN_PROBE
            const unsigned long long pr_a = PR_T();
#endif
            const int qpos = sq & 255;
            float m = bounded ? 0.0f : -1e30f, l = 0.f; f32x16 o[4];
#pragma unroll
            for (int d0 = 0; d0 < 4; ++d0) o[d0] = f32x16{};
#ifdef ATTN_PROBE
            const unsigned long long pr_b = PR_T();
#endif
            for (int kt = 0; kt < nkt; ++kt) {
                f32x16 p0 = f32x16{}, p1 = f32x16{};
#define MOBA_KRD(DST, D0, HALF) do { if (abl & 32) DST = qr[D0]; else asm volatile("ds_read_b128 %0, %1 offset:%2" : "=&v"(DST) : "v"(kbase + koff[D0]), "i"((HALF) * 8192) : "memory"); } while (0)
#define MOBA_KWAIT(N) asm volatile("s_waitcnt lgkmcnt(" #N ")" ::: "memory"); __builtin_amdgcn_sched_barrier(0)
#define MOBA_QK4(KA0, KB0, KA1, KB1, D0) p0 = __builtin_amdgcn_mfma_f32_32x32x16_bf16(KA0, qr[D0], p0, 0, 0, 0); p1 = __builtin_amdgcn_mfma_f32_32x32x16_bf16(KB0, qr[D0], p1, 0, 0, 0); \
                p0 = __builtin_amdgcn_mfma_f32_32x32x16_bf16(KA1, qr[(D0) + 1], p0, 0, 0, 0); p1 = __builtin_amdgcn_mfma_f32_32x32x16_bf16(KB1, qr[(D0) + 1], p1, 0, 0, 0); __builtin_amdgcn_sched_barrier(0)
                { const int kbase = (int)(uintptr_t)lds + kt * 16384;
                    bf16x8 ka0, kb0, ka1, kb1, ka2, kb2, ka3, kb3;
                    MOBA_KRD(ka0, 0, 0); MOBA_KRD(kb0, 0, 1); MOBA_KRD(ka1, 1, 0); MOBA_KRD(kb1, 1, 1);
                    MOBA_KRD(ka2, 2, 0); MOBA_KRD(kb2, 2, 1); MOBA_KRD(ka3, 3, 0); MOBA_KRD(kb3, 3, 1);
                    MOBA_KWAIT(4); MOBA_QK4(ka0, kb0, ka1, kb1, 0);
                    MOBA_KRD(ka0, 4, 0); MOBA_KRD(kb0, 4, 1); MOBA_KRD(ka1, 5, 0); MOBA_KRD(kb1, 5, 1);
                    MOBA_KWAIT(4); MOBA_QK4(ka2, kb2, ka3, kb3, 2);
                    MOBA_KRD(ka2, 6, 0); MOBA_KRD(kb2, 6, 1); MOBA_KRD(ka3, 7, 0); MOBA_KRD(kb3, 7, 1);
                    MOBA_KWAIT(4); MOBA_QK4(ka0, kb0, ka1, kb1, 4);
                    MOBA_KWAIT(0); MOBA_QK4(ka2, kb2, ka3, kb3, 6); }
#undef MOBA_KRD
#undef MOBA_KWAIT
#undef MOBA_QK4
                if (causal && kt == nkt - 1) { const float NEG = -__builtin_inff(); const int kb = kt * 64 + 4 * hi;
#pragma unroll
                    for (int r = 0; r < 16; ++r) { const int kv = kb + (r & 3) + 8 * (r >> 2); if (kv > qpos) p0[r] = NEG; if (kv + 32 > qpos) p1[r] = NEG; } }
                if (!(abl & 8)) {
                float ps = 0.f;
                if (bounded) {
#pragma unroll
                    for (int r = 0; r < 16; ++r) { p0[r] = __builtin_amdgcn_exp2f(p0[r]); p1[r] = __builtin_amdgcn_exp2f(p1[r]); ps += p0[r] + p1[r]; }
                } else {
                float pm = max3f(p0[0], p1[0], p0[1]), pm2 = max3f(p1[1], p0[2], p1[2]);
#pragma unroll
                for (int r = 3; r < 15; r += 3) { pm = max3f(pm, p0[r], p1[r]); pm2 = max3f(pm2, p0[r + 1], p1[r + 1]); pm = max3f(pm, p0[r + 2], p1[r + 2]); }
                pm = max3f(pm, pm2, p0[15]); pm = max3f(pm, p1[15], m);
                { auto rr = __builtin_amdgcn_permlane32_swap(__float_as_uint(pm), __float_as_uint(pm), false, false); pm = max3f(__uint_as_float(rr[0]), __uint_as_float(rr[1]), m); }
                if (kt == 0) m = pm;
                else if (__any(pm > m + 8.0f)) { const float mn = pm > m + 8.0f ? pm : m, alpha = __builtin_amdgcn_exp2f(m - mn); m = mn; l = l * alpha;
#pragma unroll
                    for (int d0 = 0; d0 < 4; ++d0) o[d0] = o[d0] * alpha; }
#pragma unroll
                for (int r = 0; r < 16; ++r) { p0[r] = __builtin_amdgcn_exp2f(p0[r] - m); p1[r] = __builtin_amdgcn_exp2f(p1[r] - m); ps += p0[r] + p1[r]; }
                }
                l += ps;
                }
                const bf16x8 pb0 = pack_p(p0, 0), pb1 = pack_p(p0, 8), pb2 = pack_p(p1, 0), pb3 = pack_p(p1, 8);
                const int vb = vb0 + kt * 16384;
                if (!(abl & 16)) pv_all(o, vb, pb0, pb1, pb2, pb3, abl);
                else { asm volatile("" :: "v"(pb0), "v"(pb1), "v"(pb2), "v"(pb3)); }
            }
#ifdef ATTN_PROBE
            pr_step += PR_T() - pr_b; pr_nstep += nkt;
#endif
            { auto rr = __builtin_amdgcn_permlane32_swap(__float_as_uint(l), __float_as_uint(l), false, false); l = __uint_as_float(rr[0]) + __uint_as_float(rr[1]); }
            const float inv = 1.0f / l, lse = m + __builtin_amdgcn_logf(l);
            float amax = 0.f;
#pragma unroll
            for (int d0 = 0; d0 < 4; ++d0)
#pragma unroll
                for (int r = 0; r < 16; r += 2) amax = fmaxf(amax, fmaxf(fabsf(o[d0][r]), fabsf(o[d0][r + 1])));
            { auto rr = __builtin_amdgcn_permlane32_swap(__float_as_uint(amax), __float_as_uint(amax), false, false); amax = fmaxf(__uint_as_float(rr[0]), __uint_as_float(rr[1])); }
            amax = fmaxf(amax, 1e-30f);
            const float qinv = 127.0f / amax, oscale = amax * inv * (1.0f / 127.0f);
#pragma unroll
            for (int d0 = 0; d0 < 4; ++d0) {
                unsigned wg[4];
#pragma unroll
                for (int g = 0; g < 4; ++g) { unsigned w = 0u;
#pragma unroll
                    for (int e4 = 0; e4 < 4; ++e4) w = __builtin_amdgcn_cvt_pk_u8_f32(__builtin_rintf(__builtin_fmaf(o[d0][4 * g + e4], qinv, 128.0f)), (unsigned)e4, w);
                    wg[g] = w; }
                const auto r02 = __builtin_amdgcn_permlane32_swap(wg[0], wg[2], false, false), r13 = __builtin_amdgcn_permlane32_swap(wg[1], wg[3], false, false);
                opk[4 * d0] = r02[0]; opk[4 * d0 + 1] = r02[1]; opk[4 * d0 + 2] = r13[0]; opk[4 * d0 + 3] = r13[1]; }
            oscl = oscale;
            oent = e0; olse = lse; ovalid = valid;
            t0 = t1; e0 = e1; t1 = t2; e1 = e2;
#pragma unroll
            for (int d0 = 0; d0 < 8; ++d0) qr[d0] = qn[d0];
#ifdef ATTN_PROBE
            pr_tile += PR_T() - pr_a; pr_ntile += 1;
#endif
        }
        if (!(abl & 1)) MOBA_FLUSH();
#undef MOBA_FLUSH
#undef MOBA_FETCH
#undef MOBA_ENTRY
#undef MOBA_LOADQ
        u = tab ? MOBA_SCHED(k + 1) : u + (unsigned)C.G;
    }
#ifdef ATTN_PROBE
    if (lane == 0) { unsigned long long* pc = (unsigned long long*)((unsigned*)qctr + 512);
        atomicAdd(pc + 0, pr_step); atomicAdd(pc + 1, pr_nstep); atomicAdd(pc + 2, pr_stage); atomicAdd(pc + 3, pr_nunit); atomicAdd(pc + 4, pr_tile); atomicAdd(pc + 5, pr_ntile); atomicAdd(pc + 6, clock64() - pr_t0); atomicAdd(pc + 7, 1ull); atomicAdd(pc + 8, pr_ta); atomicAdd(pc + 9, pr_tb); atomicAdd(pc + 10, pr_tc); }
#endif
}
}

__device__ __forceinline__ void combine_phase(const Ctx& C, const bf16* __restrict__ POa, const bf16* __restrict__ POb, const float* __restrict__ LSE, bf16* __restrict__ AO) {
    const int gw = C.vcu * NWAVES + C.wave, NGW = C.G * NWAVES, h = C.lane >> 3, dch = (C.lane & 7) * 16;
    for (int tg = gw; tg < M / 16; tg += NGW) {
        const int tok0 = tg * 16, b = tok0 >> 13, nbk = (tok0 & (SEQ - 1)) >> 8, nv = 1 + (nbk < 3 ? nbk : 3);
#pragma unroll 4
        for (int r = 0; r < 16; ++r) {
            const int tok = tok0 + r, s = tok & (SEQ - 1);
            const size_t bhs = (size_t)(b * NH + h) * SEQ + s;
            const f32x4 ls = *(const f32x4*)(LSE + bhs * 4);
            v4u pa[4];
#pragma unroll
            for (int i = 0; i < 4; ++i) pa[i] = *(const v4u*)((const unsigned char*)(i < 2 ? POa : POb) + po_off(i, tok) + h * HD + dch);
            const f32x4 sc4 = *(const f32x4*)((const float*)POa + psc_off(tok, h));
            float mx = ls[0]; if (nv > 1) mx = fmaxf(mx, ls[1]); if (nv > 2) mx = fmaxf(mx, ls[2]); if (nv > 3) mx = fmaxf(mx, ls[3]);
            float w[4]; float wsum = 0.f;
#pragma unroll
            for (int i = 0; i < 4; ++i) { w[i] = i < nv ? __builtin_amdgcn_exp2f(ls[i] - mx) : 0.f; wsum += w[i]; }
            const float inv = 1.0f / wsum;
            float acc[16]; float wtot = 0.f;
#pragma unroll
            for (int e = 0; e < 16; ++e) acc[e] = 0.f;
#pragma unroll
            for (int i = 0; i < 4; ++i) {
                const float wi = i < nv ? w[i] * inv * sc4[i] : 0.f;
                wtot += wi;
                const unsigned q4[4] = {pa[i].x, pa[i].y, pa[i].z, pa[i].w};
#pragma unroll
                for (int k = 0; k < 4; ++k) { acc[4 * k] += wi * (float)(q4[k] & 255u); acc[4 * k + 1] += wi * (float)((q4[k] >> 8) & 255u); acc[4 * k + 2] += wi * (float)((q4[k] >> 16) & 255u); acc[4 * k + 3] += wi * (float)(q4[k] >> 24); } }
#pragma unroll
            for (int e = 0; e < 16; ++e) acc[e] -= 128.0f * wtot;
            v4u o0;
            o0.x = __builtin_amdgcn_cvt_pk_fp8_f32(16.f * acc[2], 16.f * acc[3], __builtin_amdgcn_cvt_pk_fp8_f32(16.f * acc[0], 16.f * acc[1], 0u, false), true);
            o0.y = __builtin_amdgcn_cvt_pk_fp8_f32(16.f * acc[6], 16.f * acc[7], __builtin_amdgcn_cvt_pk_fp8_f32(16.f * acc[4], 16.f * acc[5], 0u, false), true);
            o0.z = __builtin_amdgcn_cvt_pk_fp8_f32(16.f * acc[10], 16.f * acc[11], __builtin_amdgcn_cvt_pk_fp8_f32(16.f * acc[8], 16.f * acc[9], 0u, false), true);
            o0.w = __builtin_amdgcn_cvt_pk_fp8_f32(16.f * acc[14], 16.f * acc[15], __builtin_amdgcn_cvt_pk_fp8_f32(16.f * acc[12], 16.f * acc[13], 0u, false), true);
            *(v4u*)((unsigned char*)AO + (size_t)(tok >> 12) * F8_XS + (size_t)(tok & 4095) * DM + h * HD + dch) = o0;
        }
    }
}

#ifdef ATTN_SELFCHECK
__device__ __forceinline__ void check_phase(const Ctx& C, const bf16* Qb, const bf16* Kb, const bf16* Vb, const float* kmean, const bf16* AO, gu32* bad, gu32* skipped) {
    const int gw = C.vcu * NWAVES + C.wave, lane = C.lane;
    for (int rep = 0; rep < 4; ++rep) {
    const unsigned i = (unsigned)gw + 2048u * (unsigned)rep;
    const int b = i & 3, h = (i >> 2) & 7;
    int s;
    if (i < 512u) { const int k = i >> 5; const int offs[4] = {0, 1, 254, 255}; s = (k & 3) * 256 + offs[(k >> 2) & 3]; }
    else s = (int)((i * 2654435761u) >> 12) & (SEQ - 1);
    const int nb = s >> 8, bh = b * 8 + h;
    const bf16* qp = Qb + (size_t)(b * SEQ + s) * DM + h * HD;
    const unsigned qw = *(const unsigned*)(qp + 2 * lane); const float q0 = bf_lo(qw), q1 = bf_hi(qw);
    const float NEG = -__builtin_inff();
    float v0 = NEG, v1 = NEG, v2 = NEG, v3 = NEG; int i0 = -1, i1 = -1, i2 = -1;
    for (int j = 0; j < nb; ++j) { const float* km = kmean + (size_t)(bh * 32 + j) * 128; const float sc = wave_sum(q0 * km[2 * lane] + q1 * km[2 * lane + 1]);
        if (sc > v3) v3 = sc;
        if (sc > v2) { v3 = v2; if (sc > v1) { v2 = v1; i2 = i1; if (sc > v0) { v1 = v0; i1 = i0; v0 = sc; i0 = j; } else { v1 = sc; i1 = j; } } else { v2 = sc; i2 = j; } } }
    if (nb > 3 && (v2 - v3) < 2e-3f * (fabsf(v2) + fabsf(v3)) + 1e-6f) { if (lane == 0) atomicAdd((unsigned*)skipped, 1u); continue; }
    float m = -1e30f, l = 0.f, o0 = 0.f, o1 = 0.f;
    for (int t = 0; t < 4; ++t) { const int blk = t == 0 ? nb : (t == 1 ? i0 : (t == 2 ? i1 : i2)); if (blk < 0) continue;
        const int nk = t == 0 ? (s & 255) + 1 : 256;
        for (int k = 0; k < nk; ++k) { const size_t row = (size_t)(b * SEQ + blk * 256 + k) * DM + h * HD + 2 * lane;
            const unsigned kw = *(const unsigned*)(Kb + row), vw = *(const unsigned*)(Vb + (size_t)((b * SEQ + blk * 256 + k) >> 12) * VXTRA + row);
            const float sc = wave_sum(q0 * bf_lo(kw) + q1 * bf_hi(kw));
            const float mn = fmaxf(m, sc), al = __builtin_amdgcn_exp2f(m - mn), p = __builtin_amdgcn_exp2f(sc - mn); m = mn;
            l = l * al + p; o0 = o0 * al + p * bf_lo(vw); o1 = o1 * al + p * bf_hi(vw); } }
    const unsigned aw = *(const unsigned*)(AO + (size_t)(b * SEQ + s) * DM + h * HD + 2 * lane);
    const float r0 = o0 / l, r1 = o1 / l, e0 = fabsf(r0 - bf_lo(aw)), e1 = fabsf(r1 - bf_hi(aw));
    const bool wrong = !(e0 <= 2.5e-3f + 0.01f * fabsf(r0)) || !(e1 <= 2.5e-3f + 0.01f * fabsf(r1));
    if (__any(wrong)) { if (lane == 0) atomicAdd((unsigned*)bad, 1u); }
    }
}
#endif

__device__ __forceinline__ void conv_phase(const Ctx& C, const bf16* __restrict__ BG, const bf16* __restrict__ UU, const float* __restrict__ cw, bf16* __restrict__ Z) {
    const int gw = C.vcu * NWAVES + C.wave, NGW = C.G * NWAVES;
    for (int wu = gw * 2; wu < (M / 16) * 2; wu += ((wu & 1) ? NGW * 2 - 1 : 1)) {
        const int rg = wu >> 1, c0 = (wu & 1) * 512 + C.lane * 8, row0 = rg * 16;
        float w0[8], w1[8], w2[8];
#pragma unroll
        for (int e = 0; e < 8; ++e) { w0[e] = cw[c0 + e]; w1[e] = cw[DM + c0 + e]; w2[e] = cw[2 * DM + c0 + e]; }
        float p2[8], p1[8];
        if ((row0 & (SEQ - 1)) == 0) {
#pragma unroll
            for (int e = 0; e < 8; ++e) { p2[e] = 0.f; p1[e] = 0.f; }
        } else {
            const v4u a = *(const v4u*)(UU + (size_t)(row0 - 2) * DM + c0), c = *(const v4u*)(UU + (size_t)(row0 - 1) * DM + c0);
            p2[0] = bf_lo(a.x); p2[1] = bf_hi(a.x); p2[2] = bf_lo(a.y); p2[3] = bf_hi(a.y); p2[4] = bf_lo(a.z); p2[5] = bf_hi(a.z); p2[6] = bf_lo(a.w); p2[7] = bf_hi(a.w);
            p1[0] = bf_lo(c.x); p1[1] = bf_hi(c.x); p1[2] = bf_lo(c.y); p1[3] = bf_hi(c.y); p1[4] = bf_lo(c.z); p1[5] = bf_hi(c.z); p1[6] = bf_lo(c.w); p1[7] = bf_hi(c.w);
        }
#pragma unroll 4
        for (int r = 0; r < 16; ++r) {
            const v4u a = *(const v4u*)(UU + (size_t)(row0 + r) * DM + c0), g = *(const v4u*)(BG + (size_t)(row0 + r) * DM + c0);
            float cu[8], bg[8], z[8];
            cu[0] = bf_lo(a.x); cu[1] = bf_hi(a.x); cu[2] = bf_lo(a.y); cu[3] = bf_hi(a.y); cu[4] = bf_lo(a.z); cu[5] = bf_hi(a.z); cu[6] = bf_lo(a.w); cu[7] = bf_hi(a.w);
            bg[0] = bf_lo(g.x); bg[1] = bf_hi(g.x); bg[2] = bf_lo(g.y); bg[3] = bf_hi(g.y); bg[4] = bf_lo(g.z); bg[5] = bf_hi(g.z); bg[6] = bf_lo(g.w); bg[7] = bf_hi(g.w);
#pragma unroll
            for (int e = 0; e < 8; ++e) { z[e] = bg[e] * (w0[e] * p2[e] + w1[e] * p1[e] + w2[e] * cu[e]); p2[e] = p1[e]; p1[e] = cu[e]; }
            v4u o; o.x = pk2(z[0], z[1]); o.y = pk2(z[2], z[3]); o.z = pk2(z[4], z[5]); o.w = pk2(z[6], z[7]);
            *(v4u*)(Z + (size_t)(row0 + r) * DM + c0) = o;
        }
    }
}

__device__ __forceinline__ void xcd_local_barrier(const XcdBarrier& b) {
    asm volatile("s_waitcnt vmcnt(0)" ::: "memory");
    __syncthreads();
    if (threadIdx.x == 0) {
        unsigned* bar = b.bar;
        __builtin_amdgcn_s_waitcnt(0);
        const unsigned nloc = b.st[0];
        const unsigned old = xb_add(&bar[XB_XSUB(b.x)], 1u);
        const unsigned gen = old / nloc;
        if (old + 1u == (gen + 1u) * nloc) xb_add(&bar[XB_XGEN(b.x)], 1u);
        else XB_SPIN(xb_ld(&bar[XB_XGEN(b.x)]) == gen, bar);
        __builtin_amdgcn_fence(__ATOMIC_ACQUIRE, "agent");
        asm volatile("s_waitcnt vmcnt(0)" ::: "memory");
    }
    __syncthreads();
}

__device__ __forceinline__ void xcd_pair_barrier(const XcdBarrier& b, unsigned* ptop) {
    asm volatile("s_waitcnt vmcnt(0)" ::: "memory");
    __syncthreads();
    if (threadIdx.x == 0) {
        unsigned* bar = b.bar;
        __builtin_amdgcn_s_waitcnt(0);
        const unsigned nloc = b.st[0];
        const unsigned old = xb_add(&bar[XB_XSUB(b.x)], 1u);
        const unsigned gen = old / nloc;
        if (old + 1u == (gen + 1u) * nloc) {
            __builtin_amdgcn_fence(__ATOMIC_RELEASE, "agent");
            asm volatile("s_waitcnt vmcnt(0)" ::: "memory");
            const unsigned og = xb_add(ptop, 1u);
            const unsigned tg = og / 2u;
            if (og + 1u == (tg + 1u) * 2u) xb_add(ptop + 64, 1u);
            else XB_SPIN(xb_ld(ptop + 64) == tg, bar);
            __builtin_amdgcn_fence(__ATOMIC_ACQUIRE, "agent");
            xb_add(&bar[XB_XGEN(b.x)], 1u);
            asm volatile("s_waitcnt vmcnt(0)" ::: "memory");
        } else {
            XB_SPIN(xb_ld(&bar[XB_XGEN(b.x)]) == gen, bar);
            __builtin_amdgcn_fence(__ATOMIC_ACQUIRE, "agent");
            asm volatile("s_waitcnt vmcnt(0)" ::: "memory");
        }
    }
    __syncthreads();
}

#ifndef KN_WGM_QKV
#define KN_WGM_QKV 4
#endif
#ifndef KN_WGM_GU
#define KN_WGM_GU 4
#endif
#ifndef KN_WGM_RES
#define KN_WGM_RES 4
#endif
#ifndef ATTN_ABL
#define ATTN_ABL 0
#endif
#ifndef KN_SP2
#define KN_SP2 true
#endif
#ifndef KN_ALIGN_RES
#define KN_ALIGN_RES true
#endif
#ifndef KN_ALIGN_FFN
#define KN_ALIGN_FFN true
#endif
constexpr int N_PHASES = 17;
struct Args { const float* in[15]; float* out; unsigned char* ws; int ph_lo, ph_hi; };
static_assert(sizeof(Args) == 15 * 8 + 8 + 8 + 8, "Args has no padding");

__global__ void __launch_bounds__(NT, 2) moba_fwd(Args args) {
    extern __shared__ __attribute__((aligned(16))) unsigned char lds_raw[];
    Ctx C;
    C.lds = (LAS unsigned char*)lds_raw; C.misc = (volatile LAS unsigned*)(C.lds + MISC_OFF);
    C.tid = threadIdx.x; C.lane = C.tid & 63; C.wave = __builtin_amdgcn_readfirstlane(C.tid >> 6);
    C.local = 0; C.G = gridDim.x; { const int bx = blockIdx.x; C.vcu = (C.G % 8 == 0) ? (bx % 8) * (C.G / 8) + bx / 8 : bx; }
    unsigned char* ws = args.ws;
    gu32* ctl = (gu32*)(ws + WS_CTL);
    if (C.tid < 32) C.misc[C.tid] = 0u;
    __syncthreads();
    const int lo = args.ph_lo, hi = args.ph_hi;
    XcdBarrier bar; bar.bar = (unsigned*)ctl + CW_BAR; bar.x = 0; bar.st = nullptr;
    if (hi - lo > 1) { bar = xcd_barrier_post((unsigned*)ctl + CW_BAR, C.misc + 8);
        if (C.tid == 0) C.misc[12] = __hip_atomic_fetch_add(ctl + CW_RANK + 64 * bar.x, 1u, __ATOMIC_RELAXED, __HIP_MEMORY_SCOPE_AGENT); }
    bool local = false; int cvb = (int)blockIdx.x;
#ifndef PHASE_MASK
#define PHASE_MASK 0x1ffff
#endif
#define IN(k) ((((PHASE_MASK) >> (k)) & 1) && lo <= (k) && (k) < hi)
#ifndef REPEAT_MASK
#define REPEAT_MASK 0
#endif
#define REP(k) (((REPEAT_MASK) >> (k)) & 1)
#define SEAM(k) do { if (IN(k) && IN((k) + 1)) xcd_barrier(bar); } while (0)
    const float* x = args.in[0]; float* out = args.out;
    float* mod = (float*)(ws + WS_MOD); float* kmean = (float*)(ws + WS_KMEAN);
    bf16* HB = (bf16*)(ws + WS_H); bf16* QB = (bf16*)(ws + WS_Q); bf16* KB = (bf16*)(ws + WS_K); bf16* VB = (bf16*)(ws + WS_V);
    bf16* POa = (bf16*)out; bf16* POb = (bf16*)(ws + WS_POB); float* LSE = (float*)(ws + WS_LSE); unsigned* lists = (unsigned*)(ws + WS_LIST);
    bf16* FB = (bf16*)(ws + WS_FB); bf16* YB = (bf16*)(ws + WS_YB);
    bf16* ACT = (bf16*)(ws + WS_ACT); bf16* BG = (bf16*)(ws + WS_BG); bf16* UU = (bf16*)(ws + WS_UU); bf16* ZB = (bf16*)(ws + WS_Z);
    bf16* XR = (bf16*)(ws + WS_XB);
    LAS unsigned char* ring = C.lds;

    if (IN(0)) p0_prologue(C, args.in, ws, 0, C.vcu, C.G); SEAM(0);
    if (lo == 0 && hi == N_PHASES && IN(0)) {
        if (C.tid == 0) { unsigned nz = 0, below = 0; bool ok = C.G == 256;
            for (unsigned j = 0; j < 16; ++j) { const unsigned c = xb_ld(bar.bar + XB_XCNT(j)); if (c) { ok = ok && c == 32u; ++nz; if (j < bar.x) ++below; } }
            ok = ok && nz == 8u && C.misc[12] < 32u;
#ifdef FORCE_NO_LOCAL
            ok = false;
#endif
            C.misc[13] = ok ? (0x80000000u | (below * 32u + C.misc[12])) : 0u; }
        __syncthreads();
        const unsigned w = C.misc[13];
        if (w >> 31) { local = true; C.local = 1; C.vcu = (int)(w & 255u); cvb = (C.vcu & 31) * 8 + (C.vcu >> 5); }
#ifdef STAGGER_TICKS
        if (local && C.vcu >= 128) { const unsigned long long t0_ = __builtin_amdgcn_s_memrealtime(); while (__builtin_amdgcn_s_memrealtime() - t0_ < (unsigned long long)(STAGGER_TICKS)) __builtin_amdgcn_s_sleep(8); }
#endif
    }
    if (IN(0)) {
        const bool do_late = !local || C.vcu >= 128;
        if (do_late) p0_prologue(C, args.in, ws, 1, local ? C.vcu - 128 : C.vcu, local ? 128 : C.G);
        if (local) { if (do_late) { asm volatile("s_waitcnt vmcnt(0)" ::: "memory"); __syncthreads();
                         if (C.tid == 0) { __builtin_amdgcn_fence(__ATOMIC_RELEASE, "agent"); asm volatile("s_waitcnt vmcnt(0)" ::: "memory"); (void)xb_add((unsigned*)ctl + CW_LATE, 1u); } } }
        else if (IN(1) && hi - lo > 1) xcd_barrier(bar);
    }
    float* C0 = (float*)(ws + WS_C0); float* D0 = (float*)(ws + WS_D0);
#define CNT_PUBLISH(W) do { asm volatile("s_waitcnt vmcnt(0)" ::: "memory"); __syncthreads(); \
        if (C.tid == 0) { __builtin_amdgcn_fence(__ATOMIC_RELEASE, "agent"); asm volatile("s_waitcnt vmcnt(0)" ::: "memory"); (void)xb_add((unsigned*)ctl + (W), 1u); } } while (0)
#define CNT_WAIT(W, N) do { if (C.tid == 0) { XB_SPIN(xb_ld((unsigned*)ctl + (W)) < (unsigned)(N), bar.bar); __builtin_amdgcn_fence(__ATOMIC_ACQUIRE, "agent"); asm volatile("s_waitcnt vmcnt(0)" ::: "memory"); } \
        __syncthreads(); } while (0)
    if (IN(0) && (!local || C.vcu < 128)) {
        for (int w = C.vcu; w < 192; w += local ? 128 : C.G) gemv4_phase(C, args.in[6], 3 * DM, 3 * DM, mod, MODW, C0, 3 * DM, w);
        CNT_PUBLISH(CW_C0); }
#define PSEAM(k) do { if (IN(k) && IN((k) + 1)) { if (local) xcd_pair_barrier(bar, (unsigned*)ctl + CW_PAIR + 128 * (C.vcu >> 6)); else xcd_barrier(bar); } } while (0)
#define LSEAM(k) do { if (IN(k) && IN((k) + 1)) { if (local) xcd_local_barrier(bar); else xcd_barrier(bar); } } while (0)
    if (IN(1)) for (int rep = 0; rep <= REP(1); ++rep) { if (rep) xcd_barrier(bar); modulate_phase<false, false, false, true, true>(C, x, args.in[4], mod, 0, DM, HB, nullptr, 0, nullptr, 0, XR); } LSEAM(1);
    if (IN(0) && IN(2)) CNT_WAIT(CW_C0, local ? 128 : C.G);
    if (IN(2)) for (int rep = 0; rep <= REP(2); ++rep) { if (rep) xcd_barrier(bar); pg8::Gemm g{HB, (const bf16*)(ws + WS_WQKV), M, 3 * DM, DM / 2, F8_XS - 4 * MiB, 122, 127};     pg8::StaticOrder S; S.init(M, 3 * DM, C.G, cvb, KN_WGM_QKV);
        pg8::EpiQKV E{QB, KB, VB, args.in[8], args.in[9], (LAS float*)(C.lds + EPI_OFF), QSCALE, kmean, VXTRA, C0};
        pg8::gemm_phase<pg8::EpiQKV, pg8::StaticOrder, true, KN_SP2, true>(ring, g, S, E); } PSEAM(2);
    if (IN(0) && IN(3) && (C.vcu & 3) == 0) { gemv4_phase(C, args.in[7], DM, DM, C0 + 2 * DM, 3 * DM, D0, DM, C.vcu >> 2); CNT_PUBLISH(CW_D0); }
    if (IN(3)) for (int rep = 0; rep <= REP(3); ++rep) { if (rep) xcd_barrier(bar); route_phase(C, QB, kmean, lists, ctl + CW_LCNT); } PSEAM(3);
    if (IN(4)) for (int rep = 0; rep <= REP(4); ++rep) { if (rep) xcd_barrier(bar); moba::attn_phase(C, QB, KB, VB, lists, (const unsigned*)(ws + WS_CTL) + CW_LCNT, ctl + CW_QCTR + 64 * rep, POa, POb, LSE, args.in[8], args.in[9], rep ? ATTN_ABL : 0); } PSEAM(4);
    if (IN(5)) for (int rep = 0; rep <= REP(5); ++rep) { if (rep) xcd_barrier(bar); combine_phase(C, POa, POb, LSE, HB); }
#ifdef ATTN_SELFCHECK
    xcd_barrier(bar); check_phase(C, QB, KB, VB, kmean, HB, ctl + 256, ctl + 320);
#endif
    LSEAM(5);
    if (local && IN(0) && IN(6)) {
        if (C.tid == 0) { XB_SPIN(xb_ld((unsigned*)ctl + CW_LATE) < 128u, bar.bar); __builtin_amdgcn_fence(__ATOMIC_ACQUIRE, "agent"); asm volatile("s_waitcnt vmcnt(0)" ::: "memory"); }
        __syncthreads(); }
    if (IN(6)) for (int rep = 0; rep <= REP(6); ++rep) { if (rep) xcd_barrier(bar); pg8::Gemm g{HB, (const bf16*)(ws + WS_WO), M, DM, DM / 2, F8_XS - 4 * MiB, 122, 123};     pg8::StaticOrder S; S.init(M, DM, C.G, cvb, KN_WGM_RES);
        pg8::EpiPlain8 E{(unsigned char*)YB, F8_XS - 4 * MiB};
        pg8::gemm_phase<pg8::EpiPlain8, pg8::StaticOrder, KN_ALIGN_RES, KN_SP2, true>(ring, g, S, E); } LSEAM(6);
    if (IN(0) && IN(7)) CNT_WAIT(CW_D0, C.G / 4);
    if (IN(7)) for (int rep = 0; rep <= REP(7); ++rep) { if (rep) xcd_barrier(bar); modulate_phase<true, true, false, false, false, true, true>(C, XR, args.in[5], mod, 3 * DM, 4 * DM, HB, YB, 2 * DM, nullptr, 0, nullptr, D0); } LSEAM(7);
    if (IN(8)) for (int rep = 0; rep <= REP(8); ++rep) { if (rep) xcd_barrier(bar); pg8::Gemm g{HB, (const bf16*)(ws + WS_WGU0), M, 2 * FF, DM}; pg8::StaticOrder S; S.init(M, 2 * FF, C.G, cvb, KN_WGM_GU);
        pg8::EpiSwiglu E{ACT, FF, AXTRA};
        pg8::gemm_phase<pg8::EpiSwiglu, pg8::StaticOrder, KN_ALIGN_FFN, KN_SP2>(ring, g, S, E); } LSEAM(8);
    if (IN(9)) for (int rep = 0; rep <= REP(9); ++rep) { if (rep) xcd_barrier(bar); pg8::Gemm g{ACT, (const bf16*)(ws + WS_WDN0), M, DM, FF, AXTRA * 2}; pg8::StaticOrder S; S.init(M, DM, C.G, cvb, KN_WGM_RES);
        pg8::EpiPlain E{FB};
        pg8::gemm_phase<pg8::EpiPlain, pg8::StaticOrder, KN_ALIGN_RES, KN_SP2>(ring, g, S, E); } LSEAM(9);
    const float* mod1 = mod + 4 * MODW;
    if (IN(10)) for (int rep = 0; rep <= REP(10); ++rep) { if (rep) xcd_barrier(bar); modulate_phase<true, true, true, true, false, true, true>(C, XR, args.in[4] + DM, mod, 4 * MODW, 4 * MODW + DM, HB, YB, 2 * DM, FB, 5 * DM, XR, D0); } LSEAM(10);
    if (IN(11)) for (int rep = 0; rep <= REP(11); ++rep) { if (rep) xcd_barrier(bar); pg8::Gemm g{HB, (const bf16*)(ws + WS_WIN), M, 3 * DM, DM}; pg8::StaticOrder S; S.init(M, 3 * DM, C.G, cvb, KN_WGM_QKV);
        pg8::EpiConvIn E{BG, UU};
        pg8::gemm_phase<pg8::EpiConvIn, pg8::StaticOrder, KN_ALIGN_FFN, KN_SP2>(ring, g, S, E); } PSEAM(11);
    if (IN(12)) for (int rep = 0; rep <= REP(12); ++rep) { if (rep) xcd_barrier(bar); conv_phase(C, BG, UU, args.in[11], ZB); } LSEAM(12);
    if (IN(13)) for (int rep = 0; rep <= REP(13); ++rep) { if (rep) xcd_barrier(bar); pg8::Gemm g{ZB, (const bf16*)(ws + WS_WOUT), M, DM, DM}; pg8::StaticOrder S; S.init(M, DM, C.G, cvb, KN_WGM_RES);
        pg8::EpiPlain E{YB};
        pg8::gemm_phase<pg8::EpiPlain, pg8::StaticOrder, KN_ALIGN_RES, KN_SP2>(ring, g, S, E); } LSEAM(13);
    if (IN(14)) for (int rep = 0; rep <= REP(14); ++rep) { if (rep) xcd_barrier(bar); modulate_phase<true, true, false, false>(C, XR, args.in[5] + DM, mod1, 3 * DM, 4 * DM, HB, YB, 2 * DM); } LSEAM(14);
    if (IN(15)) for (int rep = 0; rep <= REP(15); ++rep) { if (rep) xcd_barrier(bar); pg8::Gemm g{HB, (const bf16*)(ws + WS_WGU1), M, 2 * FF, DM}; pg8::StaticOrder S; S.init(M, 2 * FF, C.G, cvb, KN_WGM_GU);
        pg8::EpiSwiglu8 E{(unsigned char*)ACT, FF, XCHUNK - 4096 * (size_t)FF};
        pg8::gemm_phase<pg8::EpiSwiglu8, pg8::StaticOrder, KN_ALIGN_FFN, KN_SP2>(ring, g, S, E); } LSEAM(15);
    if (IN(16)) for (int rep = 0; rep <= REP(16); ++rep) { if (rep) xcd_barrier(bar); pg8::Gemm g{ACT, (const bf16*)(ws + WS_WDN1), M, DM, FF / 2, XCHUNK - 4096 * (size_t)FF, 122, 127};     pg8::StaticOrder S; S.init(M, DM, C.G, cvb, KN_WGM_RES);
        pg8::EpiResid E{XR, out, mod1 + 5 * DM, YB, mod1 + 2 * DM};
        pg8::gemm_phase<pg8::EpiResid, pg8::StaticOrder, KN_ALIGN_RES, KN_SP2, true>(ring, g, S, E); }
#ifdef ATTN_SELFCHECK
    xcd_barrier(bar);
    if (blockIdx.x == 0 && C.tid == 0) { const unsigned nbad = __hip_atomic_load(ctl + 256, __ATOMIC_RELAXED, __HIP_MEMORY_SCOPE_AGENT), nskip = __hip_atomic_load(ctl + 320, __ATOMIC_RELAXED, __HIP_MEMORY_SCOPE_AGENT);
        out[0] += 1.0f * (float)nbad; out[1] += 0.125f + 0.001f * (float)nskip; }
#endif
#ifdef ATTN_PROBE
    xcd_barrier(bar);
    if (blockIdx.x == 0 && C.tid == 0) { const unsigned long long* pc = (const unsigned long long*)((const unsigned*)(ctl + CW_QCTR) + 512);
        const double v0 = (double)pc[0] / (double)pc[1], v1 = 100.0 * (double)pc[0] / (double)pc[6], v2 = (double)pc[2] / (double)pc[3], v3 = (double)pc[4] / (double)pc[5], v4 = (double)pc[6] / (double)pc[7], v5 = (double)pc[1] / (double)pc[7];
        const double sel[10] = {v0, v1, v2, v3, v4, v5, (double)pc[8] / (double)pc[3], (double)pc[9] / (double)pc[3], (double)pc[10] / (double)pc[3], (double)pc[3] / (double)pc[7]};
        out[0] += exp2f(rintf(log2f((float)sel[ATTN_PROBE]) * 3.0f) * (1.0f / 3.0f)); }
#endif
#ifdef EXTRA_BARRIERS
    for (int i_ = 0; i_ < EXTRA_BARRIERS; ++i_) xcd_barrier(bar);
#endif
#undef IN
#undef SEAM
}

#ifndef MK_N_LAUNCHES
#define MK_N_LAUNCHES 1
#endif
extern "C" void kernel_launch(void* const* d_in, const int* in_sizes, int n_in, void* d_out, int out_size, void* d_ws, size_t ws_size, hipStream_t stream) {
    static int grid = 0;
    if (grid == 0) {
        if (n_in != 15 || in_sizes[0] != M * DM || out_size != M * DM || ws_size < WS_END) {
            fprintf(stderr, "kernel_launch: built for 15 inputs, x/out of %d floats, >= %zu bytes of workspace; got n_in %d, in0 %d, out %d, ws %zu; nothing launched\n", M * DM, (size_t)WS_END, n_in, n_in > 0 ? in_sizes[0] : -1, out_size, ws_size);
            grid = -1; return; }
        int dev = 0, cus = 0, per_cu = 0;
        if (hipGetDevice(&dev) != hipSuccess || hipDeviceGetAttribute(&cus, hipDeviceAttributeMultiprocessorCount, dev) != hipSuccess) { fprintf(stderr, "kernel_launch: device query failed\n"); grid = -1; return; }
        if (hipFuncSetAttribute((const void*)moba_fwd, hipFuncAttributeMaxDynamicSharedMemorySize, LDS_BYTES) != hipSuccess) { fprintf(stderr, "kernel_launch: hipFuncSetAttribute failed\n"); grid = -1; return; }
        if (hipOccupancyMaxActiveBlocksPerMultiprocessor(&per_cu, (const void*)moba_fwd, NT, LDS_BYTES) != hipSuccess || per_cu < 1) { fprintf(stderr, "kernel_launch: occupancy query reports %d workgroups per CU\n", per_cu); per_cu = 1; }
        (void)hipGetLastError();
        grid = cus;
    }
    if (grid < 0) return;
    if (hipMemsetAsync((char*)d_ws + WS_CTL, 0, CTL_ZERO_BYTES, stream) != hipSuccess) { fprintf(stderr, "kernel_launch: memset failed\n"); return; }
    Args a{};
    for (int i = 0; i < 15; ++i) a.in[i] = (const float*)d_in[i];
    a.out = (float*)d_out; a.ws = (unsigned char*)d_ws;
    if (MK_N_LAUNCHES == 1) {
        a.ph_lo = 0; a.ph_hi = N_PHASES;
        hipLaunchKernelGGL(moba_fwd, dim3(grid), dim3(NT), LDS_BYTES, stream, a);
    } else {
        for (int p = 0; p < N_PHASES; ++p) { a.ph_lo = p; a.ph_hi = p + 1; hipLaunchKernelGGL(moba_fwd, dim3(grid), dim3(NT), LDS_BYTES, stream, a); }
    }
    const hipError_t le = hipPeekAtLastError();
    if (le != hipSuccess) fprintf(stderr, "kernel_launch: launch failed: %s\n", hipGetErrorName(le));
}
```

```cpp
#include <hip/hip_runtime.h>
#include <cstdio>
#include <cstdint>
#ifndef KN_WGM
#define KN_WGM 8
#endif
namespace pg8 {
#define PG8_LAS __attribute__((address_space(3)))
typedef unsigned short bf16_t;
typedef short bf16x8 __attribute__((ext_vector_type(8)));
typedef float f32x4 __attribute__((ext_vector_type(4)));
typedef unsigned u32x4 __attribute__((ext_vector_type(4)));
constexpr int BM = 256, BK = 64, HALF = 128, HTB = HALF * BK * 2  , STAGE_BYTES = 8 * HTB, NXCD = 8, WGM = KN_WGM;

__host__ __device__ __forceinline__ int lds_byte(int r, int c) { const int st = (r >> 4) * 2 + (c >> 5), rr = r & 15, cc = c & 31, ob = rr * 64 + cc * 2; return st * 1024 + (ob ^ (((ob >> 9) & 1) << 5)); }
__host__ __device__ __forceinline__ void stage_rc(int b, int& R, int& C) { const int st = b / 1024, sb = b % 1024, swz = sb ^ (((sb >> 9) & 1) << 5); R = (st >> 1) * 16 + swz / 64; C = (st & 1) * 32 + (swz % 64) / 2; }
__host__ __device__ __forceinline__ int perm32(int rho) { const int n = rho >> 4, i = rho & 15; return 8 * (i >> 2) + 4 * n + (i & 3); }

struct Unit { int pm, pn; };
struct Gemm { const bf16_t* A; const bf16_t* Bt; int M, N, K; size_t axtra = 0; int sa = 127, sb = 127; };

struct StaticOrder {
    int nM, nN, nwg, G, c, wgm;
    __host__ __device__ void init(int M, int N, int G_, int c_, int wgm_ = WGM) { nM = M / BM; nN = N / BM; nwg = nM * nN; G = G_; c = c_; wgm = wgm_; }
    __host__ __device__ bool next(int i, Unit& u) const {
        const long L = (long)i * G + c; if (L >= nwg) return false;
        int wgid = (int)L; { const int q = nwg / NXCD, r = nwg % NXCD, xcd = wgid % NXCD, off = wgid / NXCD; wgid = (xcd < r ? xcd * (q + 1) : r * (q + 1) + (xcd - r) * q) + off; }
        const int nig = wgm * nN, gid = wgid / nig, fm = gid * wgm, gsz = (nM - fm) < wgm ? (nM - fm) : wgm;
        u.pm = fm + ((wgid % nig) % gsz); u.pn = (wgid % nig) / gsz; return true;
    }
    __device__ __forceinline__ void a_ready(const Unit&) const {}
    __device__ __forceinline__ void done(const Unit&) const {}
};

__device__ __forceinline__ unsigned cvt_pk_bf16(float lo, float hi) { unsigned r; asm volatile("v_cvt_pk_bf16_f32 %0, %1, %2" : "=v"(r) : "v"(lo), "v"(hi)); return r; }
typedef float f32x2 __attribute__((ext_vector_type(2)));
__device__ __forceinline__ float silu_f(float x) { return x * __builtin_amdgcn_rcpf(1.0f + __builtin_amdgcn_exp2f(-1.4426950408889634f * x)); }
__device__ __forceinline__ u32x4 pack8(const f32x4 a, const f32x4 b) { u32x4 w; w.x = cvt_pk_bf16(a[0], a[1]); w.y = cvt_pk_bf16(a[2], a[3]); w.z = cvt_pk_bf16(b[0], b[1]); w.w = cvt_pk_bf16(b[2], b[3]); return w; }

struct EpiResid {
    static constexpr bool PERM = true, AFTER_DRAIN = false;
    const bf16_t* base; float* out; const float* gate; const bf16_t* Y; const float* gate2;
    __device__ __forceinline__ void operator()(const f32x4 (&acc)[2][2][4][2], const Unit& u, int wr, int wc, int fr, int fq) const {
        asm volatile("" : "+v"(fr), "+v"(fq));
        const int b = u.pm >> 5, col0 = u.pn * BM + wc * 32 + 8 * fq;
        const float* gp = gate + (size_t)b * 6144 + col0; const float* gp2 = gate2 + (size_t)b * 6144 + col0;
        f32x4 gv[2][2], g2[2][2];
#pragma unroll
        for (int bj = 0; bj < 2; ++bj)
#pragma unroll
            for (int n = 0; n < 2; ++n) { gv[bj][n] = *(const f32x4*)(gp + bj * HALF + 4 * n); g2[bj][n] = *(const f32x4*)(gp2 + bj * HALF + 4 * n); }
#pragma unroll
        for (int ai = 0; ai < 2; ++ai)
#pragma unroll
            for (int mh = 0; mh < 2; ++mh) {
                u32x4 bs[2][2], yv[2][2];
#pragma unroll
                for (int mm = 0; mm < 2; ++mm) { const size_t off = (size_t)(u.pm * BM + ai * HALF + wr * 64 + (2 * mh + mm) * 16 + fr) * 1024 + col0;
#pragma unroll
                    for (int bj = 0; bj < 2; ++bj) { bs[mm][bj] = *(const u32x4*)(base + off + bj * HALF); yv[mm][bj] = *(const u32x4*)(Y + off + bj * HALF); } }
#pragma unroll
                for (int mm = 0; mm < 2; ++mm) { const int m = 2 * mh + mm; const size_t off = (size_t)(u.pm * BM + ai * HALF + wr * 64 + m * 16 + fr) * 1024 + col0;
#pragma unroll
                    for (int bj = 0; bj < 2; ++bj) { const u32x4 y = yv[mm][bj], xw = bs[mm][bj];
                        const f32x4 x0 = (f32x4){__uint_as_float(xw.x << 16), __uint_as_float(xw.x & 0xffff0000u), __uint_as_float(xw.y << 16), __uint_as_float(xw.y & 0xffff0000u)};
                        const f32x4 x1 = (f32x4){__uint_as_float(xw.z << 16), __uint_as_float(xw.z & 0xffff0000u), __uint_as_float(xw.w << 16), __uint_as_float(xw.w & 0xffff0000u)};
                        const f32x4 y0 = (f32x4){__uint_as_float(y.x << 16), __uint_as_float(y.x & 0xffff0000u), __uint_as_float(y.y << 16), __uint_as_float(y.y & 0xffff0000u)};
                        const f32x4 y1 = (f32x4){__uint_as_float(y.z << 16), __uint_as_float(y.z & 0xffff0000u), __uint_as_float(y.w << 16), __uint_as_float(y.w & 0xffff0000u)};
                        *(f32x4*)(out + off + bj * HALF) = x0 + g2[bj][0] * y0 + gv[bj][0] * acc[ai][bj][m][0];
                        *(f32x4*)(out + off + bj * HALF + 4) = x1 + g2[bj][1] * y1 + gv[bj][1] * acc[ai][bj][m][1]; } }
                asm volatile("" ::: "memory");
            }
    }
};
struct EpiPlain {
    static constexpr bool PERM = true, AFTER_DRAIN = false;
    bf16_t* O;
    __device__ __forceinline__ void operator()(const f32x4 (&acc)[2][2][4][2], const Unit& u, int wr, int wc, int fr, int fq) const {
        asm volatile("" : "+v"(fr), "+v"(fq));
        const int row0 = u.pm * BM + wr * 64 + fr, col0 = u.pn * BM + wc * 32 + 8 * fq;
#pragma unroll
        for (int ai = 0; ai < 2; ++ai)
#pragma unroll
            for (int m = 0; m < 4; ++m) { bf16_t* rowp = O + (size_t)(row0 + ai * HALF + m * 16) * 1024 + col0;
#pragma unroll
                for (int bj = 0; bj < 2; ++bj) *(u32x4*)(rowp + bj * HALF) = pack8(acc[ai][bj][m][0], acc[ai][bj][m][1]); }
    }
};

struct EpiPlain8 {
    static constexpr bool PERM = true, AFTER_DRAIN = false;
    unsigned char* O; size_t xtra;
    __device__ __forceinline__ void operator()(const f32x4 (&acc)[2][2][4][2], const Unit& u, int wr, int wc, int fr, int fq) const {
        asm volatile("" : "+v"(fr), "+v"(fq));
        const int row0 = u.pm * BM + wr * 64 + fr, col0 = u.pn * BM + wc * 32 + 8 * fq;
#pragma unroll
        for (int ai = 0; ai < 2; ++ai)
#pragma unroll
            for (int m = 0; m < 4; ++m) { unsigned char* rowp = O + (size_t)(u.pm >> 4) * xtra + (size_t)(row0 + ai * HALF + m * 16) * 1024 + col0;
#pragma unroll
                for (int bj = 0; bj < 2; ++bj) { const f32x4 a = acc[ai][bj][m][0] * 16.0f, b = acc[ai][bj][m][1] * 16.0f; unsigned w0 = 0u, w1 = 0u;
                    w0 = __builtin_amdgcn_cvt_pk_fp8_f32(a[0], a[1], w0, false); w0 = __builtin_amdgcn_cvt_pk_fp8_f32(a[2], a[3], w0, true);
                    w1 = __builtin_amdgcn_cvt_pk_fp8_f32(b[0], b[1], w1, false); w1 = __builtin_amdgcn_cvt_pk_fp8_f32(b[2], b[3], w1, true);
                    *(unsigned long long*)(rowp + bj * HALF) = (unsigned long long)w0 | ((unsigned long long)w1 << 32); } }
    }
};

struct EpiSwiglu {
    static constexpr bool PERM = true, AFTER_DRAIN = false;
    bf16_t* O; int ldc; size_t xtra;
    __device__ __forceinline__ void operator()(const f32x4 (&acc)[2][2][4][2], const Unit& u, int wr, int wc, int fr, int fq) const {
        asm volatile("" : "+v"(fr), "+v"(fq));
        const int row0 = u.pm * BM + wr * 64 + fr, col0 = u.pn * HALF + wc * 32 + 8 * fq;
#pragma unroll
        for (int ai = 0; ai < 2; ++ai)
#pragma unroll
            for (int m = 0; m < 4; ++m) { bf16_t* rowp = O + (size_t)(u.pm >> 4) * xtra + (size_t)(row0 + ai * HALF + m * 16) * ldc + col0;
                f32x4 r0, r1;
#pragma unroll
                for (int e = 0; e < 4; ++e) { r0[e] = silu_f(acc[ai][0][m][0][e]) * acc[ai][1][m][0][e]; r1[e] = silu_f(acc[ai][0][m][1][e]) * acc[ai][1][m][1][e]; }
                *(u32x4*)rowp = pack8(r0, r1); }
    }
};

struct EpiSwiglu8 {
    static constexpr bool PERM = true, AFTER_DRAIN = false;
    unsigned char* O; int ldc; size_t xtra;
    __device__ __forceinline__ void operator()(const f32x4 (&acc)[2][2][4][2], const Unit& u, int wr, int wc, int fr, int fq) const {
        asm volatile("" : "+v"(fr), "+v"(fq));
        const int row0 = u.pm * BM + wr * 64 + fr, col0 = u.pn * HALF + wc * 32 + 8 * fq;
#pragma unroll
        for (int ai = 0; ai < 2; ++ai)
#pragma unroll
            for (int m = 0; m < 4; ++m) { unsigned char* rowp = O + (size_t)(u.pm >> 4) * xtra + (size_t)(row0 + ai * HALF + m * 16) * ldc + col0;
                f32x4 r0, r1;
#pragma unroll
                for (int e = 0; e < 4; ++e) { r0[e] = silu_f(acc[ai][0][m][0][e]) * acc[ai][1][m][0][e]; r1[e] = silu_f(acc[ai][0][m][1][e]) * acc[ai][1][m][1][e]; }
                unsigned w0 = 0u, w1 = 0u; w0 = __builtin_amdgcn_cvt_pk_fp8_f32(r0[0], r0[1], w0, false); w0 = __builtin_amdgcn_cvt_pk_fp8_f32(r0[2], r0[3], w0, true);
                w1 = __builtin_amdgcn_cvt_pk_fp8_f32(r1[0], r1[1], w1, false); w1 = __builtin_amdgcn_cvt_pk_fp8_f32(r1[2], r1[3], w1, true);
                *(unsigned long long*)rowp = (unsigned long long)w0 | ((unsigned long long)w1 << 32); }
    }
};

struct EpiConvIn {
    static constexpr bool PERM = true, AFTER_DRAIN = false;
    bf16_t* BG; bf16_t* UU;
    __device__ __forceinline__ void operator()(const f32x4 (&acc)[2][2][4][2], const Unit& u, int wr, int wc, int fr, int fq) const {
        asm volatile("" : "+v"(fr), "+v"(fq));
        const int row0 = u.pm * BM + wr * 64 + fr;
        if (u.pn < 4) {
            const int col0 = u.pn * BM + wc * 32 + 8 * fq;
#pragma unroll
            for (int ai = 0; ai < 2; ++ai)
#pragma unroll
                for (int m = 0; m < 4; ++m) { bf16_t* rowp = BG + (size_t)(row0 + ai * HALF + m * 16) * 1024 + col0;
#pragma unroll
                    for (int bj = 0; bj < 2; ++bj) *(u32x4*)(rowp + bj * HALF) = pack8(acc[ai][bj][m][0], acc[ai][bj][m][1]); }
        } else {
            const int col0 = (u.pn - 4) * HALF + wc * 32 + 8 * fq;
#pragma unroll
            for (int ai = 0; ai < 2; ++ai)
#pragma unroll
                for (int m = 0; m < 4; ++m) { bf16_t* rowp = UU + (size_t)(row0 + ai * HALF + m * 16) * 1024 + col0;
                    *(u32x4*)rowp = pack8(acc[ai][0][m][0] * acc[ai][1][m][0], acc[ai][0][m][1] * acc[ai][1][m][1]); }
        }
    }
};

struct EpiQKV {
    static constexpr bool PERM = true, AFTER_DRAIN = false;
    bf16_t *Q, *K, *V; const float *qg, *kg; PG8_LAS float* ss; float qscale; float* kmean; size_t vxtra; const float* cvec;
    __device__ __forceinline__ void operator()(const f32x4 (&acc)[2][2][4][2], const Unit& u, int wr, int wc, int fr, int fq) const {
        asm volatile("" : "+v"(fr), "+v"(fq));
        const int t = u.pn >> 2, colt = (u.pn & 3) * BM;
        const int row0 = u.pm * BM + wr * 64 + fr, col0 = colt + wc * 32 + 8 * fq;
        if (t == 2) {
#pragma unroll
            for (int ai = 0; ai < 2; ++ai)
#pragma unroll
                for (int m = 0; m < 4; ++m) { bf16_t* rowp = V + (size_t)(u.pm >> 4) * vxtra + (size_t)(row0 + ai * HALF + m * 16) * 1024 + col0;
#pragma unroll
                    for (int bj = 0; bj < 2; ++bj) *(u32x4*)(rowp + bj * HALF) = pack8(acc[ai][bj][m][0], acc[ai][bj][m][1]); }
            return;
        }
        const float* cp = cvec + (size_t)(u.pm >> 5) * 3072 + u.pn * BM + wc * 32 + 8 * fq;
#pragma unroll
        for (int bj = 0; bj < 2; ++bj) { asm volatile("" : "+v"(cp)); const f32x4 cb0 = *(const f32x4*)(cp + bj * HALF), cb1 = *(const f32x4*)(cp + bj * HALF + 4);
#pragma unroll
            for (int ai = 0; ai < 2; ++ai)
#pragma unroll
                for (int m = 0; m < 4; ++m) { const f32x4 a = acc[ai][bj][m][0] + cb0, b = acc[ai][bj][m][1] + cb1;
                    float s = (a[0] * a[0] + a[1] * a[1]) + (a[2] * a[2] + a[3] * a[3]) + (b[0] * b[0] + b[1] * b[1]) + (b[2] * b[2] + b[3] * b[3]);
                    s += __shfl_xor(s, 16); s += __shfl_xor(s, 32);
                    if (fq == 0) ss[(ai * HALF + wr * 64 + m * 16 + fr) * 8 + bj * 4 + wc] = s; } }
        asm volatile("s_waitcnt lgkmcnt(0)" ::: "memory"); __builtin_amdgcn_s_barrier(); asm volatile("" ::: "memory");
        const float* gain = (t == 0) ? qg : kg; const float sc = (t == 0) ? qscale : 1.0f;
        const f32x4 g0 = *(const f32x4*)(gain + wc * 32 + 8 * fq) * sc, g1 = *(const f32x4*)(gain + wc * 32 + 8 * fq + 4) * sc;
        bf16_t* base = (t == 0) ? Q : K;
#pragma unroll
        for (int bj = 0; bj < 2; ++bj) { asm volatile("" : "+v"(cp)); const f32x4 cb0 = *(const f32x4*)(cp + bj * HALF), cb1 = *(const f32x4*)(cp + bj * HALF + 4);
#pragma unroll
            for (int ai = 0; ai < 2; ++ai)
#pragma unroll
                for (int m = 0; m < 4; ++m) { const int r = ai * HALF + wr * 64 + m * 16 + fr; bf16_t* rowp = base + (size_t)(u.pm * BM + r) * 1024 + col0;
                    const f32x4 p = *(const PG8_LAS f32x4*)(ss + r * 8 + bj * 4);
                    const float rstd = __builtin_amdgcn_rsqf(((p[0] + p[1]) + (p[2] + p[3])) * (1.0f / 128.0f) + 1e-6f);
                    const f32x4 v0 = (acc[ai][bj][m][0] + cb0) * rstd * g0, v1 = (acc[ai][bj][m][1] + cb1) * rstd * g1;
                    *(u32x4*)(rowp + bj * HALF) = pack8(v0, v1);
                    asm volatile("" ::: "memory"); } }
        if (t == 1) {
            PG8_LAS float* km = ss + 2048;
#pragma unroll
            for (int bj = 0; bj < 2; ++bj) { f32x4 c0 = (f32x4){0.f, 0.f, 0.f, 0.f}, c1 = c0; asm volatile("" : "+v"(cp)); const f32x4 cb0 = *(const f32x4*)(cp + bj * HALF), cb1 = *(const f32x4*)(cp + bj * HALF + 4);
#pragma unroll
                for (int ai = 0; ai < 2; ++ai)
#pragma unroll
                    for (int m = 0; m < 4; ++m) { const f32x4 p = *(const PG8_LAS f32x4*)(ss + (ai * HALF + wr * 64 + m * 16 + fr) * 8 + bj * 4);
                        const float rstd = __builtin_amdgcn_rsqf(((p[0] + p[1]) + (p[2] + p[3])) * (1.0f / 128.0f) + 1e-6f);
                        c0 += (acc[ai][bj][m][0] + cb0) * rstd; c1 += (acc[ai][bj][m][1] + cb1) * rstd; }
                c0 = c0 * g0; c1 = c1 * g1;
#pragma unroll
                for (int e = 0; e < 4; ++e) { float a = c0[e], b = c1[e];
                    a += __shfl_xor(a, 1); b += __shfl_xor(b, 1); a += __shfl_xor(a, 2); b += __shfl_xor(b, 2); a += __shfl_xor(a, 4); b += __shfl_xor(b, 4); a += __shfl_xor(a, 8); b += __shfl_xor(b, 8);
                    if (fr == 0) { km[wr * 256 + bj * HALF + wc * 32 + 8 * fq + e] = a; km[wr * 256 + bj * HALF + wc * 32 + 8 * fq + 4 + e] = b; } }
                asm volatile("" ::: "memory"); }
            asm volatile("s_waitcnt lgkmcnt(0)" ::: "memory"); __builtin_amdgcn_s_barrier(); asm volatile("" ::: "memory");
            const int tid = (wr * 4 + wc) * 64 + fq * 16 + fr;
            if (tid < 256) { const float v = (km[tid] + km[256 + tid]) * (1.0f / 256.0f);
                const int h = (u.pn & 3) * 2 + (tid >> 7), b = u.pm >> 5, blk = u.pm & 31;
                kmean[(size_t)((b * 8 + h) * 32 + blk) * 128 + (tid & 127)] = v; }
        }
    }
};

template <class Epi, class Sched, bool ALIGN_EPI = false, bool SP2 = false, bool F8 = false>
__device__ __forceinline__ void gemm_phase(PG8_LAS unsigned char* lds, const Gemm g, const Sched& S, const Epi& E) {
    const int tid = threadIdx.x, wid = __builtin_amdgcn_readfirstlane(tid >> 6), lane = tid & 63, wr = wid >> 2, wc = wid & 3, fr = lane & 15, fq = lane >> 4;
    const int K = g.K, nt = K / BK;
    unsigned voffA[2], voffB[2];
#pragma unroll
    for (int i = 0; i < 2; ++i) { int R, C; stage_rc(tid * 16 + i * 8192, R, C); const int Rb = Epi::PERM ? ((R & ~31) + perm32(R & 31)) : R;
        voffA[i] = (unsigned)(R * K + C) * 2u; voffB[i] = (unsigned)(Rb * K + C) * 2u; }
    const size_t kstep = (size_t)(BK * 2);
    const size_t hstep = (size_t)HALF * K * 2;
    const size_t tstep = 2 * hstep;
    const unsigned ldsw = (unsigned)wid * 1024u;
    const int aoff = lds_byte(wr * 64 + fr, fq * 8), boff = lds_byte(wc * 32 + fr, fq * 8);
#define PG8_SA(b, h) (((b) * 2 + (h)) * HTB)
#define PG8_SB(b, h) ((4 + (b) * 2 + (h)) * HTB)
#define PG8_STAGE(bufoff, gbase, voff) do { _Pragma("unroll") for (int _i = 0; _i < 2; ++_i) \
        __builtin_amdgcn_global_load_lds((const unsigned*)((const char*)(gbase) + (voff)[_i]), (PG8_LAS unsigned*)(lds + (bufoff) + ldsw + _i * 8192), 16, 0, 0); } while (0)
#define PG8_LD16(off) (*(const PG8_LAS i32x4_*)(lds + (off)))
#define PG8_LDA(dst, b, h) do { _Pragma("unroll") for (int m = 0; m < 4; ++m) { \
        if constexpr (F8) dst##8[m] = __builtin_shufflevector(PG8_LD16(PG8_SA(b, h) + aoff + m * 2048), PG8_LD16(PG8_SA(b, h) + aoff + m * 2048 + 1024), 0, 1, 2, 3, 4, 5, 6, 7); \
        else { _Pragma("unroll") for (int k = 0; k < 2; ++k) dst[m][k] = *(const PG8_LAS bf16x8*)(lds + PG8_SA(b, h) + aoff + m * 2048 + k * 1024); } } } while (0)
#define PG8_LDB(dst, b, h) do { _Pragma("unroll") for (int n = 0; n < 2; ++n) { \
        if constexpr (F8) dst##8[n] = __builtin_shufflevector(PG8_LD16(PG8_SB(b, h) + boff + n * 2048), PG8_LD16(PG8_SB(b, h) + boff + n * 2048 + 1024), 0, 1, 2, 3, 4, 5, 6, 7); \
        else { _Pragma("unroll") for (int k = 0; k < 2; ++k) dst[n][k] = *(const PG8_LAS bf16x8*)(lds + PG8_SB(b, h) + boff + n * 2048 + k * 1024); } } } while (0)
#define PG8_MMA(ai, bj, At, Bt) do { __builtin_amdgcn_s_setprio(1); _Pragma("unroll") for (int m = 0; m < 4; ++m) _Pragma("unroll") for (int n = 0; n < 2; ++n) { \
        if constexpr (F8) asm volatile("v_mfma_scale_f32_16x16x128_f8f6f4 %0, %1, %2, %0, %3, %4 op_sel_hi:[0,0,0]" : "+v"(acc[ai][bj][m][n]) : "v"(Bt##8[n]), "v"(At##8[m]), "v"(f8sa), "v"(f8sb)); \
        else { _Pragma("unroll") for (int k = 0; k < 2; ++k) acc[ai][bj][m][n] = __builtin_amdgcn_mfma_f32_16x16x32_bf16(Bt[n][k], At[m][k], acc[ai][bj][m][n], 0, 0, 0); } } \
        __builtin_amdgcn_s_setprio(0); } while (0)
#define PG8_WAIT_V(n) asm volatile("s_waitcnt vmcnt(" #n ")" ::: "memory")
#define PG8_WAIT_L(n) asm volatile("s_waitcnt lgkmcnt(" #n ")" ::: "memory")
#define PG8_BAR __builtin_amdgcn_s_barrier()
#define PG8_SCHED __builtin_amdgcn_sched_barrier(0)
    Unit cur, nxt; int ui = 0;
    if (!S.next(0, cur)) return;
    f32x4 acc[2][2][4][2];
#pragma unroll
    for (int a = 0; a < 2; ++a)
#pragma unroll
        for (int b = 0; b < 2; ++b)
#pragma unroll
            for (int m = 0; m < 4; ++m)
#pragma unroll
                for (int n = 0; n < 2; ++n) acc[a][b][m][n] = (f32x4){0.f, 0.f, 0.f, 0.f};
    bf16x8 At[4][2], B0[2][2], B1[2][2];
    typedef int i32x4_ __attribute__((ext_vector_type(4))); typedef int i32x8_ __attribute__((ext_vector_type(8)));
    const int f8sa = g.sa, f8sb = g.sb;
    i32x8_ At8[4], B08[2], B18[2];
    const char* cA = (const char*)g.A + (size_t)cur.pm * tstep + (size_t)(cur.pm >> 4) * g.axtra; const char* cB = (const char*)g.Bt + (size_t)cur.pn * tstep;
    S.a_ready(cur);
    if constexpr (SP2) {
        PG8_STAGE(PG8_SB(0, 0), cB, voffB); PG8_STAGE(PG8_SB(0, 1), cB + hstep, voffB); PG8_STAGE(PG8_SA(0, 0), cA, voffA); PG8_STAGE(PG8_SA(0, 1), cA + hstep, voffA);
        if (wr == 1) PG8_BAR;
        PG8_WAIT_V(2); PG8_BAR;
        PG8_STAGE(PG8_SB(1, 0), cB + kstep, voffB); PG8_STAGE(PG8_SA(1, 0), cA + kstep, voffA); PG8_STAGE(PG8_SB(1, 1), cB + hstep + kstep, voffB);
        PG8_WAIT_V(6); PG8_BAR;
    } else {
        PG8_STAGE(PG8_SB(0, 0), cB, voffB); PG8_STAGE(PG8_SA(0, 0), cA, voffA); PG8_STAGE(PG8_SB(0, 1), cB + hstep, voffB); PG8_STAGE(PG8_SA(0, 1), cA + hstep, voffA);
        if (wr == 1) PG8_BAR;
        PG8_WAIT_V(4); PG8_BAR;
        PG8_STAGE(PG8_SB(1, 0), cB + kstep, voffB); PG8_STAGE(PG8_SA(1, 0), cA + kstep, voffA); PG8_STAGE(PG8_SB(1, 1), cB + hstep + kstep, voffB);
        PG8_WAIT_V(6); PG8_BAR;
    }
    for (;;) {
        const bool has_next = S.next(ui + 1, nxt);
        const char* nA = has_next ? (const char*)g.A + (size_t)nxt.pm * tstep + (size_t)(nxt.pm >> 4) * g.axtra : cA; const char* nB = has_next ? (const char*)g.Bt + (size_t)nxt.pn * tstep : cB;
        for (int t = 0; t < nt; t += 2) {
            const bool last = (t == nt - 2);
            const char* a1 = cA + (size_t)(t + 1) * kstep;
            const char* a2 = last ? nA : cA + (size_t)(t + 2) * kstep; const char* b2 = last ? nB : cB + (size_t)(t + 2) * kstep;
            const char* a3 = a2 + kstep; const char* b3 = b2 + kstep;
            if (last && has_next) S.a_ready(nxt);
            if constexpr (SP2) {
            PG8_LDB(B0, 0, 0); PG8_LDB(B1, 0, 1); PG8_SCHED; PG8_LDA(At, 0, 0); PG8_STAGE(PG8_SA(1, 1), a1 + hstep, voffA);
            PG8_WAIT_V(8); PG8_WAIT_L(0); PG8_BAR; PG8_MMA(0, 0, At, B0); PG8_MMA(0, 1, At, B1); PG8_BAR; PG8_SCHED;
            PG8_LDA(At, 0, 1); PG8_STAGE(PG8_SB(0, 0), b2, voffB); PG8_STAGE(PG8_SB(0, 1), b2 + hstep, voffB); PG8_STAGE(PG8_SA(0, 0), a2, voffA);
            PG8_WAIT_V(8); PG8_WAIT_L(0); PG8_BAR; PG8_MMA(1, 0, At, B0); PG8_MMA(1, 1, At, B1); PG8_BAR; PG8_SCHED;
            PG8_LDB(B0, 1, 0); PG8_LDB(B1, 1, 1); PG8_SCHED; PG8_LDA(At, 1, 0); PG8_STAGE(PG8_SA(0, 1), a2 + hstep, voffA);
            PG8_WAIT_V(8); PG8_WAIT_L(0); PG8_BAR; PG8_MMA(0, 0, At, B0); PG8_MMA(0, 1, At, B1); PG8_BAR; PG8_SCHED;
            PG8_LDA(At, 1, 1); PG8_STAGE(PG8_SB(1, 0), b3, voffB); PG8_STAGE(PG8_SB(1, 1), b3 + hstep, voffB); PG8_STAGE(PG8_SA(1, 0), a3, voffA);
            PG8_WAIT_V(8); PG8_WAIT_L(0); PG8_BAR; PG8_MMA(1, 0, At, B0); PG8_MMA(1, 1, At, B1); PG8_BAR; PG8_SCHED;
            } else {
            PG8_LDB(B0, 0, 0); PG8_SCHED; PG8_LDA(At, 0, 0); PG8_STAGE(PG8_SA(1, 1), a1 + hstep, voffA);
            PG8_WAIT_L(8); PG8_BAR; PG8_WAIT_L(0); PG8_MMA(0, 0, At, B0); PG8_BAR; PG8_SCHED;
            PG8_LDB(B1, 0, 1); PG8_STAGE(PG8_SB(0, 0), b2, voffB);
            PG8_BAR; PG8_WAIT_L(0); PG8_MMA(0, 1, At, B1); PG8_BAR;
            PG8_LDA(At, 0, 1); PG8_STAGE(PG8_SA(0, 0), a2, voffA);
            PG8_BAR; PG8_WAIT_L(0); PG8_MMA(1, 0, At, B0); PG8_BAR; PG8_SCHED;
            PG8_STAGE(PG8_SB(0, 1), b2 + hstep, voffB);
            PG8_WAIT_V(6); PG8_BAR; PG8_MMA(1, 1, At, B1); PG8_BAR;
            PG8_LDB(B0, 1, 0); PG8_SCHED; PG8_LDA(At, 1, 0); PG8_STAGE(PG8_SA(0, 1), a2 + hstep, voffA);
            PG8_WAIT_L(8); PG8_BAR; PG8_WAIT_L(0); PG8_MMA(0, 0, At, B0); PG8_BAR; PG8_SCHED;
            PG8_LDB(B1, 1, 1); PG8_STAGE(PG8_SB(1, 0), b3, voffB);
            PG8_BAR; PG8_WAIT_L(0); PG8_MMA(0, 1, At, B1); PG8_BAR;
            PG8_LDA(At, 1, 1); PG8_STAGE(PG8_SA(1, 0), a3, voffA);
            PG8_BAR; PG8_WAIT_L(0); PG8_MMA(1, 0, At, B0); PG8_BAR; PG8_SCHED;
            PG8_STAGE(PG8_SB(1, 1), b3 + hstep, voffB);
            PG8_WAIT_V(6); PG8_BAR; PG8_MMA(1, 1, At, B1); PG8_BAR;
            }
        }
        if constexpr (ALIGN_EPI) { if (wr == 0) PG8_BAR; }
        if constexpr (F8) asm volatile("s_nop 15\n\ts_nop 15" ::: "memory");
        if constexpr (!Epi::AFTER_DRAIN) { E(acc, cur, wr, wc, fr, fq); S.done(cur); }
        if (!has_next) break;
#pragma unroll
        for (int a = 0; a < 2; ++a)
#pragma unroll
            for (int b = 0; b < 2; ++b)
#pragma unroll
                for (int m = 0; m < 4; ++m)
#pragma unroll
                    for (int n = 0; n < 2; ++n) acc[a][b][m][n] = (f32x4){0.f, 0.f, 0.f, 0.f};
        cur = nxt; cA = nA; cB = nB; ++ui;
        if constexpr (ALIGN_EPI) { if (wr == 1) PG8_BAR; }
    }
    PG8_WAIT_V(0);
    if constexpr (!ALIGN_EPI) { if (wr == 0) PG8_BAR; }
    PG8_BAR;
    if constexpr (Epi::AFTER_DRAIN) { E.fused(acc, cur, wr, wc, fr, fq, lds, wid, lane); S.done(cur); }
#undef PG8_SA
#undef PG8_SB
#undef PG8_STAGE
#undef PG8_LDA
#undef PG8_LDB
#undef PG8_MMA
#undef PG8_WAIT_V
#undef PG8_WAIT_L
#undef PG8_BAR
#undef PG8_SCHED
}
}
#define GAS __attribute__((address_space(1)))
#define LAS __attribute__((address_space(3)))
typedef unsigned short bf16;
typedef unsigned v4u __attribute__((ext_vector_type(4)));
typedef float f32x4 __attribute__((ext_vector_type(4)));
typedef short bf16x8 __attribute__((ext_vector_type(8)));
typedef GAS unsigned gu32;
typedef GAS unsigned long long gu64;
#define RLX_AGENT __ATOMIC_RELAXED, __HIP_MEMORY_SCOPE_AGENT
#define LDS_WAIT() asm volatile("s_waitcnt lgkmcnt(0)" ::: "memory")
#define VM_WAIT() asm volatile("s_waitcnt vmcnt(0)" ::: "memory")
__device__ __forceinline__ unsigned long long rt() { return __builtin_amdgcn_s_memrealtime(); }
__device__ __forceinline__ unsigned f2bf(float f) { unsigned u = __builtin_bit_cast(unsigned, f); return (u + 0x7fffu + ((u >> 16) & 1u)) >> 16; }
__device__ __forceinline__ unsigned pk2(float lo, float hi) { return f2bf(lo) | (f2bf(hi) << 16); }

#define XB_TMO      128
#define XB_XCNT(j)  (256  + 64 * (j))
#define XB_XSUB(j)  (1280 + 64 * (j))
#define XB_XGEN(j)  (2304 + 64 * (j))
#define XB_TOP      3328
#define XB_TOPGEN   3392
#define XCD_BAR_WORDS 3456
#define XB_SPIN_CAP (1u << 18)

__device__ __forceinline__ unsigned xb_ld(unsigned* p)              { return __hip_atomic_load(p, __ATOMIC_RELAXED, __HIP_MEMORY_SCOPE_AGENT); }
__device__ __forceinline__ unsigned xb_add(unsigned* p, unsigned v) { return __hip_atomic_fetch_add(p, v, __ATOMIC_RELAXED, __HIP_MEMORY_SCOPE_AGENT); }
__device__ __forceinline__ unsigned xb_xcc_id() { return (unsigned)__builtin_amdgcn_s_getreg((3 << 11) | 20) & 0xFu; }
#define XB_SPIN(cond, bar) do { unsigned _sp = 0; while (cond) { __builtin_amdgcn_s_sleep(1); \
    if ((++_sp & 255u) == 0u) { if (xb_ld(&(bar)[XB_TMO])) break; if (_sp > XB_SPIN_CAP) { atomicAdd(&(bar)[XB_TMO], 1u); break; } } } } while (0)

struct XcdBarrier {
    unsigned* bar; unsigned x;
    volatile LAS unsigned* st;
};

__device__ __forceinline__ XcdBarrier xcd_barrier_post(unsigned* bar, volatile LAS unsigned* st) {
    XcdBarrier b; b.bar = bar; b.x = xb_xcc_id(); b.st = st;
    if (threadIdx.x == 0) (void)xb_add(&bar[XB_XCNT(b.x)], 1u);
    return b;
}
__device__ __forceinline__ void xcd_barrier_complete(unsigned* bar, unsigned x, unsigned& nloc, unsigned& nx) {
    const unsigned G = gridDim.x * gridDim.y * gridDim.z;
    unsigned sum, cnt, mine, sp = 0u;
    for (;;) {
        sum = 0u; cnt = 0u; mine = 0u;
#pragma unroll
        for (unsigned j = 0; j < 16; ++j) { const unsigned c = xb_ld(&bar[XB_XCNT(j)]); sum += c; cnt += (c > 0u) ? 1u : 0u; mine = (j == x) ? c : mine; }
        if (sum == G) break;
        __builtin_amdgcn_s_sleep(1);
        if ((++sp & 255u) == 0u) { if (xb_ld(&bar[XB_TMO])) break; if (sp > XB_SPIN_CAP) { atomicAdd(&bar[XB_TMO], 1u); break; } }
    }
    nloc = mine > 0u ? mine : 1u; nx = cnt > 0u ? cnt : 1u;
}

__device__ __forceinline__ void xcd_barrier(const XcdBarrier& b) {
    asm volatile("s_waitcnt vmcnt(0)" ::: "memory");
    __syncthreads();
    if (threadIdx.x == 0) {
        unsigned* bar = b.bar;
        __builtin_amdgcn_s_waitcnt(0);
        unsigned nloc = b.st[0], nx = b.st[1];
        if (nloc == 0u) { xcd_barrier_complete(bar, b.x, nloc, nx); b.st[0] = nloc; b.st[1] = nx; }
        const unsigned old = xb_add(&bar[XB_XSUB(b.x)], 1u);
        const unsigned gen = old / nloc;
        if (old + 1u == (gen + 1u) * nloc) {
            __builtin_amdgcn_fence(__ATOMIC_RELEASE, "agent");
            asm volatile("s_waitcnt vmcnt(0)" ::: "memory");
            const unsigned og = xb_add(&bar[XB_TOP], 1u);
            const unsigned tg = og / nx;
            if (og + 1u == (tg + 1u) * nx) xb_add(&bar[XB_TOPGEN], 1u);
            else XB_SPIN(xb_ld(&bar[XB_TOPGEN]) == tg, bar);
            __builtin_amdgcn_fence(__ATOMIC_ACQUIRE, "agent");
            xb_add(&bar[XB_XGEN(b.x)], 1u);
            asm volatile("s_waitcnt vmcnt(0)" ::: "memory");
        } else {
            XB_SPIN(xb_ld(&bar[XB_XGEN(b.x)]) == gen, bar);
            __builtin_amdgcn_fence(__ATOMIC_ACQUIRE, "agent");
            asm volatile("s_waitcnt vmcnt(0)" ::: "memory");
        }
    }
    __syncthreads();
}

constexpr int NBATCH = 4, SEQ = 8192, DM = 1024, NH = 8, HD = 128, M = NBATCH * SEQ, FF = 2816, NBLK = 32;
constexpr int NWAVES = 8, NT = NWAVES * 64;
constexpr int MODW = 6 * DM;
constexpr float QSCALE = 0.08838834764831845f * 1.4426950408889634f;
constexpr int LCAP = 8192;

constexpr size_t MiB = 1u << 20;
constexpr size_t WS_CTL = 0, CTL_ZERO_BYTES = 64 * 1024;
constexpr size_t WS_MOD = 1 * MiB;
constexpr size_t WS_C0 = 1 * MiB + 256 * 1024, WS_D0 = 1 * MiB + 320 * 1024;
constexpr size_t WS_KMEAN = 1 * MiB + 512 * 1024;
constexpr size_t WS_WQKV = 2 * MiB, WS_WO = 8 * MiB, WS_WIN = 10 * MiB, WS_WOUT = 16 * MiB, WS_WGU0 = 18 * MiB, WS_WGU1 = 29 * MiB, WS_WDN0 = 40 * MiB, WS_WDN1 = 46 * MiB;
constexpr size_t WS_LSE = 52 * MiB;
constexpr size_t WS_XB = 56 * MiB;
constexpr size_t WS_H = 120 * MiB;
constexpr size_t WS_LIST = WS_H;
constexpr size_t WS_Z = WS_H;
constexpr size_t WS_Q = 184 * MiB;
constexpr size_t WS_YB = WS_Q, WS_BG = WS_Q;
constexpr size_t WS_K = 248 * MiB;
constexpr size_t WS_FB = WS_K, WS_UU = WS_K;
constexpr size_t WS_R = 312 * MiB, XCHUNK = 25 * MiB;
constexpr size_t WS_V = WS_R, WS_ACT = WS_R, WS_POB = WS_R + 8 * MiB;
constexpr size_t VXTRA = (XCHUNK - 8 * MiB) / 2, AXTRA = (XCHUNK - 22 * MiB) / 2;
constexpr size_t WS_END = 512 * MiB;
constexpr size_t F8_XS = 8 * MiB;
constexpr size_t PO_XS_A = 16 * MiB, PO_XS_B = XCHUNK, PO_SL = 8 * MiB;
__device__ __forceinline__ size_t po_off(int sl, int tok) { return (size_t)(tok >> 12) * (sl < 2 ? PO_XS_A : PO_XS_B) + (size_t)(sl & 1) * PO_SL + (size_t)(tok & 4095) * 1024; }
__device__ __forceinline__ size_t psc_off(int tok, int h) { return (size_t)(tok >> 12) * (16 * MiB / 4) + (4 * MiB / 4) + (size_t)((tok & 4095) * 8 + h) * 4; }
__device__ __forceinline__ size_t list_off(int bh, int j) { return (size_t)(bh >> 3) * (16 * MiB / 4) + (size_t)((bh & 7) * 32 + j) * 8192; }
constexpr int CW_QCTR = 64, CW_RANK = 2048, CW_PAIR = 3072, CW_LATE = 3584, CW_C0 = 3648, CW_D0 = 3712, CW_BAR = 4096, CW_LCNT = 8192;
static_assert((CW_LCNT + 1024) * 4 <= (int)CTL_ZERO_BYTES && CW_BAR + XCD_BAR_WORDS <= CW_LCNT, "CTL map");

constexpr int RING_BYTES = 131072, EPI_OFF = RING_BYTES, EPI_BYTES = 10240, MISC_OFF = EPI_OFF + EPI_BYTES, LDS_BYTES = 147456;

struct Ctx { LAS unsigned char* lds; volatile LAS unsigned* misc; int tid, lane, wave, vcu, G, local; };

__device__ __forceinline__ float wave_sum(float v) {
#pragma unroll
    for (int o = 1; o < 64; o <<= 1) v += __shfl_xor(v, o);
    return v;
}
__device__ __forceinline__ float bf_lo(unsigned u) { return __uint_as_float(u << 16); }
__device__ __forceinline__ float bf_hi(unsigned u) { return __uint_as_float(u & 0xffff0000u); }

__device__ __forceinline__ void transpose_item(const float* W, int K, int N, bf16* WT, int k0, int n0, int drow0, LAS float* scr, int lane) {
    float v[32];
#pragma unroll
    for (int i = 0; i < 32; ++i) { const int kk = 2 * i + (lane >> 5); v[i] = W[(size_t)(k0 + kk) * N + n0 + (lane & 31)]; }
#pragma unroll
    for (int i = 0; i < 32; ++i) { const int kk = 2 * i + (lane >> 5); scr[kk * 33 + (lane & 31)] = v[i]; }
    LDS_WAIT(); asm volatile("" ::: "memory");
    const int c = lane & 7;
#pragma unroll
    for (int j = 0; j < 4; ++j) { const int n = (lane >> 3) + 8 * j; const LAS float* s = scr + (8 * c) * 33 + n;
        v4u o; o.x = pk2(s[0 * 33], s[1 * 33]); o.y = pk2(s[2 * 33], s[3 * 33]); o.z = pk2(s[4 * 33], s[5 * 33]); o.w = pk2(s[6 * 33], s[7 * 33]);
        *(GAS v4u*)(WT + (size_t)(drow0 + n) * K + k0 + 8 * c) = o; }
    LDS_WAIT(); asm volatile("" ::: "memory");
}
__device__ __forceinline__ int pair_row(int n, int seg) { return 256 * (n >> 7) + 128 * seg + (n & 127); }

__device__ __forceinline__ void p0_prologue(const Ctx& C, const float* const* in, unsigned char* ws, int which, int wcu, int ncu) {
    LAS float* scr = (LAS float*)(C.lds + C.wave * 16384);
    if (which == 0) for (int mu = wcu; mu < 192; mu += ncu) {
        const float* cin = in[1]; const float* w_ada = in[2]; const float* b_ada = in[3]; float* mod = (float*)(ws + WS_MOD);
        LAS float* tab = (LAS float*)C.lds; LAS float* part = (LAS float*)(C.lds + 16384);
#pragma unroll
        for (int kk = 0; kk < 2; ++kk) { const int k = C.tid + NT * kk;
#pragma unroll
            for (int b = 0; b < 4; ++b) { const float x = cin[b * DM + k]; tab[k * 4 + b] = x / (1.0f + __expf(-x)); } }
        __syncthreads();
        const int l = mu / 96, col = (mu % 96) * 64 + C.lane, kw = C.wave * 128;
        const float* W = w_ada + (size_t)l * DM * MODW + (size_t)kw * MODW + col;
        float a0 = 0.f, a1 = 0.f, a2 = 0.f, a3 = 0.f;
#pragma unroll 2
        for (int k0 = 0; k0 < 128; k0 += 16) {
            float w[16];
#pragma unroll
            for (int jj = 0; jj < 16; ++jj) w[jj] = W[(size_t)(k0 + jj) * MODW];
#pragma unroll
            for (int jj = 0; jj < 16; ++jj) { const f32x4 sv = *(const LAS f32x4*)(tab + (kw + k0 + jj) * 4); a0 += sv[0] * w[jj]; a1 += sv[1] * w[jj]; a2 += sv[2] * w[jj]; a3 += sv[3] * w[jj]; }
        }
        part[(C.wave * 4 + 0) * 64 + C.lane] = a0; part[(C.wave * 4 + 1) * 64 + C.lane] = a1; part[(C.wave * 4 + 2) * 64 + C.lane] = a2; part[(C.wave * 4 + 3) * 64 + C.lane] = a3;
        __syncthreads();
        if (C.wave < 4) { float sacc = 0.f;
#pragma unroll
            for (int w8 = 0; w8 < 8; ++w8) sacc += part[(w8 * 4 + C.wave) * 64 + C.lane];
            mod[(size_t)(l * 4 + C.wave) * MODW + col] = sacc + b_ada[l * MODW + col]; }
        __syncthreads();
    }
    const int NGW = ncu * NWAVES;
    constexpr int I_QKV = 16 * 96, I_O = 16 * 32, I_IN = 16 * 96, I_OUT = 16 * 32, I_GU = 16 * 176, I_DN = 44 * 32;
    constexpr int NITEMS = I_QKV + I_O + I_IN + I_OUT + 2 * I_GU + 2 * I_DN;
    struct TItem { const float* W; bf16* WT; int K, N, k0, n0, drow, f8; };
#define P0_DESC(D, IT) do { int r = (IT); \
        if (r < I_QKV) { D = TItem{in[6], (bf16*)(ws + WS_WQKV), DM, 3 * DM, 64 * (r / 96), 32 * (r % 96), 32 * (r % 96), 1}; break; } r -= I_QKV; \
        if (r < I_O) { D = TItem{in[7], (bf16*)(ws + WS_WO), DM, DM, 64 * (r / 32), 32 * (r % 32), 32 * (r % 32), 1}; break; } r -= I_O; \
        if (r < I_IN) { const int n0_ = 32 * (r % 96); D = TItem{in[10], (bf16*)(ws + WS_WIN), DM, 3 * DM, 64 * (r / 96), n0_, n0_ < DM ? n0_ : (n0_ < 2 * DM ? DM + pair_row(n0_ - DM, 0) : DM + pair_row(n0_ - 2 * DM, 1)), 0}; break; } r -= I_IN; \
        if (r < I_OUT) { D = TItem{in[12], (bf16*)(ws + WS_WOUT), DM, DM, 64 * (r / 32), 32 * (r % 32), 32 * (r % 32), 0}; break; } r -= I_OUT; \
        if (r < 2 * I_GU) { const int l_ = r / I_GU; r -= l_ * I_GU; const int n0_ = 32 * (r % 176); \
            D = TItem{in[13] + (size_t)l_ * DM * 2 * FF, (bf16*)(ws + (l_ ? WS_WGU1 : WS_WGU0)), DM, 2 * FF, 64 * (r / 176), n0_, n0_ < FF ? pair_row(n0_, 0) : pair_row(n0_ - FF, 1), 0}; break; } r -= 2 * I_GU; \
        { const int l_ = r / I_DN; r -= l_ * I_DN; D = TItem{in[14] + (size_t)l_ * FF * DM, (bf16*)(ws + (l_ ? WS_WDN1 : WS_WDN0)), FF, DM, 64 * (r / 32), 32 * (r % 32), 32 * (r % 32), l_}; } } while (0)
#define P0_LOAD(V, D) do { const float* wp_ = (D).W + (size_t)((D).k0 + (C.lane >> 5)) * (D).N + (D).n0 + (C.lane & 31); _Pragma("unroll") for (int i = 0; i < 32; ++i) V[i] = wp_[(size_t)(2 * i) * (D).N]; } while (0)
    const int gw = (which ? I_QKV : 0) + wcu * NWAVES + C.wave, IEND = which ? NITEMS : I_QKV;
    if (gw < IEND) {
        TItem cur, nx1; float v[32], v1[32];
        P0_DESC(cur, gw); P0_LOAD(v, cur); nx1 = cur;
        if (gw + NGW < IEND) { P0_DESC(nx1, gw + NGW); P0_LOAD(v1, nx1); }
        for (int it = gw; it < IEND; it += NGW) {
            TItem nx2 = nx1; float v2[32]; const bool has1 = it + NGW < IEND, has2 = it + 2 * NGW < IEND;
            if (has2) { P0_DESC(nx2, it + 2 * NGW); P0_LOAD(v2, nx2); }
#pragma unroll
            for (int i = 0; i < 32; ++i) scr[(2 * i + (C.lane >> 5)) * 33 + (C.lane & 31)] = v[i];
            LDS_WAIT(); asm volatile("" ::: "memory");
            const int c = C.lane & 7;
#pragma unroll
            for (int j = 0; j < 4; ++j) { const int n = (C.lane >> 3) + 8 * j; const LAS float* s = scr + (8 * c) * 33 + n;
                if (cur.f8) { unsigned w0 = 0u, w1 = 0u;
                    w0 = __builtin_amdgcn_cvt_pk_fp8_f32(32.f * s[0 * 33], 32.f * s[1 * 33], w0, false); w0 = __builtin_amdgcn_cvt_pk_fp8_f32(32.f * s[2 * 33], 32.f * s[3 * 33], w0, true);
                    w1 = __builtin_amdgcn_cvt_pk_fp8_f32(32.f * s[4 * 33], 32.f * s[5 * 33], w1, false); w1 = __builtin_amdgcn_cvt_pk_fp8_f32(32.f * s[6 * 33], 32.f * s[7 * 33], w1, true);
                    *(GAS unsigned long long*)((GAS unsigned char*)cur.WT + (size_t)(cur.drow + n) * cur.K + cur.k0 + 8 * c) = (unsigned long long)w0 | ((unsigned long long)w1 << 32); }
                else { v4u o; o.x = pk2(s[0 * 33], s[1 * 33]); o.y = pk2(s[2 * 33], s[3 * 33]); o.z = pk2(s[4 * 33], s[5 * 33]); o.w = pk2(s[6 * 33], s[7 * 33]);
                    *(GAS v4u*)(cur.WT + (size_t)(cur.drow + n) * cur.K + cur.k0 + 8 * c) = o; } }
            LDS_WAIT(); asm volatile("" ::: "memory");
            if (has1) { cur = nx1; nx1 = nx2;
#pragma unroll
                for (int i = 0; i < 32; ++i) { v[i] = v1[i]; v1[i] = v2[i]; } }
        }
    }
#undef P0_DESC
#undef P0_LOAD
}


__device__ __forceinline__ void gemv4_phase(const Ctx& C, const float* __restrict__ W, int ldw, int ncols, const float* __restrict__ svec, int sstride, float* __restrict__ out, int ostride, int wcu) {
    if (wcu * 16 >= ncols) return;
    LAS float* tab = (LAS float*)C.lds; LAS float* part = (LAS float*)(C.lds + 16384);
#pragma unroll
    for (int kk = 0; kk < 2; ++kk) { const int k = C.tid + NT * kk;
#pragma unroll
        for (int b = 0; b < 4; ++b) tab[k * 4 + b] = svec[(size_t)b * sstride + k]; }
    __syncthreads();
    const int cc = C.lane & 15, ks = C.lane >> 4, k0 = C.wave * 128 + ks * 32;
    const float* wp = W + (size_t)k0 * ldw + wcu * 16 + cc;
    float a0 = 0.f, a1 = 0.f, a2 = 0.f, a3 = 0.f;
#pragma unroll 2
    for (int k = 0; k < 32; k += 16) { float w[16];
#pragma unroll
        for (int jj = 0; jj < 16; ++jj) w[jj] = wp[(size_t)(k + jj) * ldw];
#pragma unroll
        for (int jj = 0; jj < 16; ++jj) { const f32x4 sv = *(const LAS f32x4*)(tab + (k0 + k + jj) * 4); a0 += sv[0] * w[jj]; a1 += sv[1] * w[jj]; a2 += sv[2] * w[jj]; a3 += sv[3] * w[jj]; } }
    a0 += __shfl_xor(a0, 16); a1 += __shfl_xor(a1, 16); a2 += __shfl_xor(a2, 16); a3 += __shfl_xor(a3, 16);
    a0 += __shfl_xor(a0, 32); a1 += __shfl_xor(a1, 32); a2 += __shfl_xor(a2, 32); a3 += __shfl_xor(a3, 32);
    if (C.lane < 16) *(LAS f32x4*)(part + (C.wave * 16 + cc) * 4) = (f32x4){a0, a1, a2, a3};
    __syncthreads();
    if (C.tid < 64) { const int col = C.tid & 15, b = C.tid >> 4; float s = 0.f;
#pragma unroll
        for (int w8 = 0; w8 < 8; ++w8) s += part[(w8 * 16 + col) * 4 + b];
        out[(size_t)b * ostride + wcu * 16 + col] = s; }
    __syncthreads();
}

template <bool XB, bool HY, bool HY2, bool HXO, bool H8 = false, bool HD0 = false, bool Y8 = false>
__device__ __forceinline__ void modulate_phase(const Ctx& C, const void* __restrict__ Xv, const float* __restrict__ gain, const float* __restrict__ modl, int sh_off, int sc_off, bf16* __restrict__ Hout,
                                               const bf16* __restrict__ Y = nullptr, int g_off = 0, const bf16* __restrict__ Y2 = nullptr, int g2_off = 0, bf16* Xout = nullptr, const float* __restrict__ d0 = nullptr) {
    const int gw = C.vcu * NWAVES + C.wave, NGW = C.G * NWAVES;
    for (int rg = gw; rg < M / 16; rg += NGW) {
        const int row0 = rg * 16, b = row0 >> 13;
        f32x4 Gv[4], Sv[4], Yg[4], Yg2[4], Yd[4];
#pragma unroll
        for (int j = 0; j < 4; ++j) { const int col = 4 * C.lane + 256 * j;
            const f32x4 g = *(const f32x4*)(gain + col), sc = *(const f32x4*)(modl + (size_t)b * MODW + sc_off + col);
            Gv[j] = g * (sc + 1.0f); Sv[j] = *(const f32x4*)(modl + (size_t)b * MODW + sh_off + col);
            if constexpr (HY) Yg[j] = *(const f32x4*)(modl + (size_t)b * MODW + g_off + col);
            if constexpr (HD0) Yd[j] = Yg[j] * *(const f32x4*)(d0 + (size_t)b * DM + col);
            if constexpr (Y8) Yg[j] = Yg[j] * 0.0625f;
            if constexpr (HY2) Yg2[j] = *(const f32x4*)(modl + (size_t)b * MODW + g2_off + col); }
        struct Buf { f32x4 v[2][4]; unsigned long long xb[2][4], y[2][4], y2[2][4]; };
        auto load = [&](Buf& B, int r) __attribute__((always_inline)) {
#pragma unroll
            for (int q = 0; q < 2; ++q) { const size_t ro = (size_t)(row0 + r + q) * DM;
                if constexpr (XB) { const GAS unsigned long long* xr = (const GAS unsigned long long*)((const bf16*)Xv + ro) + C.lane;
#pragma unroll
                    for (int j = 0; j < 4; ++j) B.xb[q][j] = xr[64 * j]; }
                else { const GAS f32x4* xr = (const GAS f32x4*)((const float*)Xv + ro) + C.lane;
#pragma unroll
                    for (int j = 0; j < 4; ++j) B.v[q][j] = xr[64 * j]; }
                if constexpr (HY && Y8) { const GAS unsigned* yr = (const GAS unsigned*)((const GAS unsigned char*)Y + (size_t)((row0 + r + q) >> 12) * F8_XS + (size_t)((row0 + r + q) & 4095) * DM) + C.lane;
#pragma unroll
                    for (int j = 0; j < 4; ++j) B.y[q][j] = yr[64 * j]; }
                if constexpr (HY && !Y8) { const GAS unsigned long long* yr = (const GAS unsigned long long*)(Y + ro) + C.lane;
#pragma unroll
                    for (int j = 0; j < 4; ++j) B.y[q][j] = yr[64 * j]; }
                if constexpr (HY2) { const GAS unsigned long long* yr = (const GAS unsigned long long*)(Y2 + ro) + C.lane;
#pragma unroll
                    for (int j = 0; j < 4; ++j) B.y2[q][j] = yr[64 * j]; } }
        };
        auto comp = [&](Buf& B, int r) __attribute__((always_inline)) {
#pragma unroll
            for (int q = 0; q < 2; ++q) { const size_t ro = (size_t)(row0 + r + q) * DM; float s = 0.f;
#pragma unroll
                for (int j = 0; j < 4; ++j) {
                    if constexpr (XB) { const unsigned lo = (unsigned)B.xb[q][j], hi = (unsigned)(B.xb[q][j] >> 32); B.v[q][j] = (f32x4){bf_lo(lo), bf_hi(lo), bf_lo(hi), bf_hi(hi)}; }
                    if constexpr (HY && Y8) { const unsigned w = (unsigned)B.y[q][j]; B.v[q][j] = B.v[q][j] + Yg[j] * (f32x4){__builtin_amdgcn_cvt_f32_fp8(w, 0), __builtin_amdgcn_cvt_f32_fp8(w, 1), __builtin_amdgcn_cvt_f32_fp8(w, 2), __builtin_amdgcn_cvt_f32_fp8(w, 3)}; }
                    if constexpr (HY && !Y8) { const unsigned lo = (unsigned)B.y[q][j], hi = (unsigned)(B.y[q][j] >> 32); B.v[q][j] = B.v[q][j] + Yg[j] * (f32x4){bf_lo(lo), bf_hi(lo), bf_lo(hi), bf_hi(hi)}; }
                    if constexpr (HD0) B.v[q][j] = B.v[q][j] + Yd[j];
                    if constexpr (HY2) { const unsigned lo = (unsigned)B.y2[q][j], hi = (unsigned)(B.y2[q][j] >> 32); B.v[q][j] = B.v[q][j] + Yg2[j] * (f32x4){bf_lo(lo), bf_hi(lo), bf_lo(hi), bf_hi(hi)}; }
                    s += (B.v[q][j].x * B.v[q][j].x + B.v[q][j].y * B.v[q][j].y) + (B.v[q][j].z * B.v[q][j].z + B.v[q][j].w * B.v[q][j].w); }
                if constexpr (HXO) { GAS unsigned long long* xo = (GAS unsigned long long*)(Xout + ro) + C.lane;
#pragma unroll
                    for (int j = 0; j < 4; ++j) xo[64 * j] = (unsigned long long)pk2(B.v[q][j].x, B.v[q][j].y) | ((unsigned long long)pk2(B.v[q][j].z, B.v[q][j].w) << 32); }
                const float rstd = __builtin_amdgcn_rsqf(wave_sum(s) * (1.0f / DM) + 1e-6f);
                if constexpr (H8) {
                    GAS unsigned* o4 = (GAS unsigned*)((GAS unsigned char*)Hout + (size_t)((row0 + r + q) >> 12) * F8_XS + (size_t)((row0 + r + q) & 4095) * DM) + C.lane;
#pragma unroll
                    for (int j = 0; j < 4; ++j) { const f32x4 o = B.v[q][j] * rstd * Gv[j];
                        unsigned w = 0u; w = __builtin_amdgcn_cvt_pk_fp8_f32(o.x, o.y, w, false); w = __builtin_amdgcn_cvt_pk_fp8_f32(o.z, o.w, w, true); o4[64 * j] = w; }
                } else {
                GAS unsigned long long* o8 = (GAS unsigned long long*)(Hout + ro) + C.lane;
#pragma unroll
                for (int j = 0; j < 4; ++j) { const f32x4 o = B.v[q][j] * rstd * Gv[j] + Sv[j];
                    o8[64 * j] = (unsigned long long)pk2(o.x, o.y) | ((unsigned long long)pk2(o.z, o.w) << 32); } } }
        };
        Buf A, Bb;
        load(A, 0);
        for (int r = 0; r < 12; r += 4) { load(Bb, r + 2); comp(A, r); load(A, r + 4); comp(Bb, r + 2); }
        load(Bb, 14); comp(A, 12); comp(Bb, 14);
    }
}

__device__ __forceinline__ void kmean_phase(const Ctx& C, const bf16* Kb, float* kmean) {
    LAS float* part = (LAS float*)C.lds;
    const int ch = C.tid & 15, rg = C.tid >> 4;
    for (int u = C.vcu; u < 1024; u += C.G) {
        const int bh = u >> 5, j = u & 31, b = bh >> 3, h = bh & 7;
        const bf16* Kg = Kb + (size_t)(b * SEQ + j * 256 + rg * 8) * DM + h * HD + ch * 8;
        float a[8];
#pragma unroll
        for (int e = 0; e < 8; ++e) a[e] = 0.f;
#pragma unroll
        for (int r = 0; r < 8; ++r) { const v4u w = *(const v4u*)(Kg + (size_t)r * DM);
            a[0] += bf_lo(w.x); a[1] += bf_hi(w.x); a[2] += bf_lo(w.y); a[3] += bf_hi(w.y); a[4] += bf_lo(w.z); a[5] += bf_hi(w.z); a[6] += bf_lo(w.w); a[7] += bf_hi(w.w); }
        __syncthreads();
        *(LAS f32x4*)(part + rg * 128 + ch * 8) = (f32x4){a[0], a[1], a[2], a[3]}; *(LAS f32x4*)(part + rg * 128 + ch * 8 + 4) = (f32x4){a[4], a[5], a[6], a[7]};
        __syncthreads();
        if (C.tid < 128) { float s = 0.f;
#pragma unroll 8
            for (int g = 0; g < 32; ++g) s += part[g * 128 + C.tid];
            kmean[(size_t)(bh * 32 + j) * 128 + C.tid] = s * (1.0f / 256.0f); }
    }
}

typedef float f32x16r __attribute__((ext_vector_type(16)));
#define ROUTE_INS(SC, JJ) { const float sc_ = (SC); const int jj_ = (JJ); if (sc_ > v2) { if (sc_ > v1) { v2 = v1; i2 = i1; if (sc_ > v0) { v1 = v0; i1 = i0; v0 = sc_; i0 = jj_; } else { v1 = sc_; i1 = jj_; } } else { v2 = sc_; i2 = jj_; } } }
__device__ __forceinline__ void route_phase(const Ctx& C, const bf16* Qb, const float* kmean, unsigned* lists, gu32* lcnt) {
    const int r32 = C.lane & 31, hi = C.lane >> 5;
    for (int u = C.vcu; u < 512; u += C.G) {
        int bh = u >> 4, qc = (u & 256) ? 15 - (u & 15) : (u & 15);
        if (C.local) { const int w = C.vcu & 63, k = u >> 8; bh = 8 * (C.vcu >> 6) + 4 * k + (w >> 4); qc = k ? 15 - (w & 15) : (w & 15); }
        const int b = bh >> 3, h = bh & 7;
        const int s = qc * 512 + C.tid, nb = __builtin_amdgcn_readfirstlane(s >> 8);
        bf16x8 kh[8], kl[8];
        { const float* kp = kmean + (size_t)bh * 4096 + r32 * 128 + 8 * hi;
#pragma unroll
            for (int t = 0; t < 8; ++t) { const f32x4 a = *(const f32x4*)(kp + 16 * t), c = *(const f32x4*)(kp + 16 * t + 4);
                pg8::u32x4 wh, wl;
                wh.x = pg8::cvt_pk_bf16(a[0], a[1]); wh.y = pg8::cvt_pk_bf16(a[2], a[3]); wh.z = pg8::cvt_pk_bf16(c[0], c[1]); wh.w = pg8::cvt_pk_bf16(c[2], c[3]);
                wl.x = pg8::cvt_pk_bf16(a[0] - bf_lo(wh.x), a[1] - bf_hi(wh.x)); wl.y = pg8::cvt_pk_bf16(a[2] - bf_lo(wh.y), a[3] - bf_hi(wh.y));
                wl.z = pg8::cvt_pk_bf16(c[0] - bf_lo(wh.z), c[1] - bf_hi(wh.z)); wl.w = pg8::cvt_pk_bf16(c[2] - bf_lo(wh.w), c[3] - bf_hi(wh.w));
                kh[t] = __builtin_bit_cast(bf16x8, wh); kl[t] = __builtin_bit_cast(bf16x8, wl); } }
        const float NEG = -__builtin_inff();
        int i0 = -1, i1 = -1, i2 = -1;
#pragma unroll
        for (int tl = 0; tl < 2; ++tl) {
            const bf16* qp = Qb + (size_t)(b * SEQ + qc * 512 + C.wave * 64 + tl * 32 + r32) * DM + h * HD + 8 * hi;
            bf16x8 qf[8];
#pragma unroll
            for (int t = 0; t < 8; ++t) qf[t] = *(const bf16x8*)(qp + 16 * t);
            f32x16r acc;
#pragma unroll
            for (int r = 0; r < 16; ++r) acc[r] = 0.f;
#pragma unroll
            for (int t = 0; t < 8; ++t) { acc = __builtin_amdgcn_mfma_f32_32x32x16_bf16(kh[t], qf[t], acc, 0, 0, 0); acc = __builtin_amdgcn_mfma_f32_32x32x16_bf16(kl[t], qf[t], acc, 0, 0, 0); }
            float v0 = NEG, v1 = NEG, v2 = NEG; int j0 = -1, j1 = -1, j2 = -1;
            { int i0 = -1, i1 = -1, i2 = -1;
#pragma unroll
                for (int r = 0; r < 16; ++r) { const int j = (r & 3) + 8 * (r >> 2) + 4 * hi; if (j < nb) ROUTE_INS(acc[r], j) }
                const auto a0 = __builtin_amdgcn_permlane32_swap(__float_as_uint(v0), __float_as_uint(v0), false, false), a1 = __builtin_amdgcn_permlane32_swap(__float_as_uint(v1), __float_as_uint(v1), false, false),
                           a2 = __builtin_amdgcn_permlane32_swap(__float_as_uint(v2), __float_as_uint(v2), false, false);
                const auto b0 = __builtin_amdgcn_permlane32_swap((unsigned)i0, (unsigned)i0, false, false), b1 = __builtin_amdgcn_permlane32_swap((unsigned)i1, (unsigned)i1, false, false),
                           b2 = __builtin_amdgcn_permlane32_swap((unsigned)i2, (unsigned)i2, false, false);
                v0 = NEG; v1 = NEG; v2 = NEG; i0 = -1; i1 = -1; i2 = -1;
                ROUTE_INS(__uint_as_float(a0[0]), (int)b0[0]) ROUTE_INS(__uint_as_float(a1[0]), (int)b1[0]) ROUTE_INS(__uint_as_float(a2[0]), (int)b2[0])
                ROUTE_INS(__uint_as_float(a0[1]), (int)b0[1]) ROUTE_INS(__uint_as_float(a1[1]), (int)b1[1]) ROUTE_INS(__uint_as_float(a2[1]), (int)b2[1])
                j0 = i0; j1 = i1; j2 = i2; }
            if (hi == tl) { i0 = j0; i1 = j1; i2 = j2; }
        }
        unsigned long long mymask = 0ull;
        for (int jj = 0; jj < nb; ++jj) { const bool hit = (i0 == jj) | (i1 == jj) | (i2 == jj); const unsigned long long mk = __ballot(hit); if (C.lane == jj) mymask = mk; }
        const int n = __popcll(mymask); unsigned base = 0u;
        if (C.lane < nb && n > 0) base = __hip_atomic_fetch_add(lcnt + bh * 32 + C.lane, (unsigned)n, __ATOMIC_RELAXED, __HIP_MEMORY_SCOPE_AGENT);
        const unsigned long long below = (1ull << C.lane) - 1ull;
#pragma unroll
        for (int t = 0; t < 3; ++t) { const int it = t == 0 ? i0 : (t == 1 ? i1 : i2); const int src = it < 0 ? 0 : it;
            const unsigned bs = __shfl(base, src); const unsigned mlo = __shfl((unsigned)mymask, src), mhi = __shfl((unsigned)(mymask >> 32), src);
            const unsigned long long mk = ((unsigned long long)mhi << 32) | mlo;
            const unsigned pos = bs + (unsigned)__popcll(mk & below);
            if (it >= 0 && pos < (unsigned)LCAP) lists[list_off(bh, it) + pos] = ((unsigned)s << 2) | (unsigned)(t + 1); }
    }
}

namespace moba {
__device__ const unsigned short ATT_SCHED_PAIR[64 * 8] = {
    0, 135, 192, 65535, 65535, 65535, 65535, 65535,
    1, 134, 193, 65535, 65535, 65535, 65535, 65535,
    2, 133, 194, 65535, 65535, 65535, 65535, 65535,
    3, 132, 195, 65535, 65535, 65535, 65535, 65535,
    4, 131, 196, 65535, 65535, 65535, 65535, 65535,
    5, 130, 197, 65535, 65535, 65535, 65535, 65535,
    6, 129, 198, 65535, 65535, 65535, 65535, 65535,
    7, 128, 199, 65535, 65535, 65535, 65535, 65535,
    8, 143, 184, 240, 65535, 65535, 65535, 65535,
    9, 142, 185, 241, 65535, 65535, 65535, 65535,
    10, 141, 186, 242, 65535, 65535, 65535, 65535,
    11, 140, 187, 243, 65535, 65535, 65535, 65535,
    12, 139, 188, 244, 65535, 65535, 65535, 65535,
    13, 138, 189, 245, 65535, 65535, 65535, 65535,
    14, 137, 190, 246, 65535, 65535, 65535, 65535,
    15, 136, 191, 247, 65535, 65535, 65535, 65535,
    16, 104, 183, 232, 65535, 65535, 65535, 65535,
    17, 105, 182, 233, 65535, 65535, 65535, 65535,
    18, 106, 181, 234, 65535, 65535, 65535, 65535,
    19, 107, 180, 235, 65535, 65535, 65535, 65535,
    20, 108, 179, 236, 65535, 65535, 65535, 65535,
    21, 109, 178, 237, 65535, 65535, 65535, 65535,
    22, 110, 177, 238, 65535, 65535, 65535, 65535,
    23, 111, 176, 239, 65535, 65535, 65535, 65535,
    24, 95, 160, 224, 65535, 65535, 65535, 65535,
    25, 94, 161, 225, 65535, 65535, 65535, 65535,
    26, 93, 162, 226, 65535, 65535, 65535, 65535,
    27, 92, 163, 227, 65535, 65535, 65535, 65535,
    28, 91, 164, 228, 65535, 65535, 65535, 65535,
    29, 90, 165, 229, 65535, 65535, 65535, 65535,
    30, 89, 166, 230, 65535, 65535, 65535, 65535,
    31, 88, 167, 231, 65535, 65535, 65535, 65535,
    32, 103, 127, 208, 65535, 65535, 65535, 65535,
    33, 102, 126, 209, 65535, 65535, 65535, 65535,
    34, 101, 125, 210, 65535, 65535, 65535, 65535,
    35, 100, 124, 211, 65535, 65535, 65535, 65535,
    36, 99, 123, 212, 65535, 65535, 65535, 65535,
    37, 98, 122, 213, 65535, 65535, 65535, 65535,
    38, 97, 121, 214, 65535, 65535, 65535, 65535,
    39, 96, 120, 215, 65535, 65535, 65535, 65535,
    40, 80, 144, 175, 65535, 65535, 65535, 65535,
    41, 81, 145, 174, 65535, 65535, 65535, 65535,
    42, 82, 146, 173, 65535, 65535, 65535, 65535,
    43, 83, 147, 172, 65535, 65535, 65535, 65535,
    44, 84, 148, 171, 65535, 65535, 65535, 65535,
    45, 85, 149, 170, 65535, 65535, 65535, 65535,
    46, 86, 150, 169, 65535, 65535, 65535, 65535,
    47, 87, 151, 168, 65535, 65535, 65535, 65535,
    48, 72, 112, 200, 65535, 65535, 65535, 65535,
    49, 73, 113, 201, 65535, 65535, 65535, 65535,
    50, 74, 114, 202, 65535, 65535, 65535, 65535,
    51, 75, 115, 203, 65535, 65535, 65535, 65535,
    52, 76, 116, 204, 65535, 65535, 65535, 65535,
    53, 77, 117, 205, 65535, 65535, 65535, 65535,
    54, 78, 118, 206, 65535, 65535, 65535, 65535,
    55, 79, 119, 207, 65535, 65535, 65535, 65535,
    56, 64, 159, 216, 248, 65535, 65535, 65535,
    57, 65, 158, 217, 249, 65535, 65535, 65535,
    58, 66, 157, 218, 250, 65535, 65535, 65535,
    59, 67, 156, 219, 251, 65535, 65535, 65535,
    60, 68, 155, 220, 252, 65535, 65535, 65535,
    61, 69, 154, 221, 253, 65535, 65535, 65535,
    62, 70, 153, 222, 254, 65535, 65535, 65535,
    63, 71, 152, 223, 255, 65535, 65535, 65535,
};
__device__ const unsigned short ATT_SCHED[256 * 8] = {
    0, 552, 545, 65535, 65535, 65535, 65535, 65535,
    1, 556, 565, 65535, 65535, 65535, 65535, 65535,
    2, 560, 564, 65535, 65535, 65535, 65535, 65535,
    3, 513, 588, 65535, 65535, 65535, 65535, 65535,
    4, 480, 612, 65535, 65535, 65535, 65535, 65535,
    5, 524, 589, 65535, 65535, 65535, 65535, 65535,
    6, 498, 611, 65535, 65535, 65535, 65535, 65535,
    7, 457, 664, 65535, 65535, 65535, 65535, 65535,
    8, 458, 663, 65535, 65535, 65535, 65535, 65535,
    9, 459, 656, 65535, 65535, 65535, 65535, 65535,
    10, 460, 655, 65535, 65535, 65535, 65535, 65535,
    11, 491, 620, 65535, 65535, 65535, 65535, 65535,
    12, 492, 630, 65535, 65535, 65535, 65535, 65535,
    13, 493, 623, 65535, 65535, 65535, 65535, 65535,
    14, 530, 601, 65535, 65535, 65535, 65535, 65535,
    15, 531, 603, 65535, 65535, 65535, 65535, 65535,
    16, 523, 605, 65535, 65535, 65535, 65535, 65535,
    17, 522, 607, 65535, 65535, 65535, 65535, 65535,
    18, 537, 591, 65535, 65535, 65535, 65535, 65535,
    19, 534, 594, 65535, 65535, 65535, 65535, 65535,
    20, 536, 593, 65535, 65535, 65535, 65535, 65535,
    21, 535, 596, 65535, 65535, 65535, 65535, 65535,
    22, 539, 595, 65535, 65535, 65535, 65535, 65535,
    23, 466, 651, 65535, 65535, 65535, 65535, 65535,
    24, 386, 784, 65535, 65535, 65535, 65535, 65535,
    25, 387, 782, 65535, 65535, 65535, 65535, 65535,
    26, 388, 799, 65535, 65535, 65535, 65535, 65535,
    27, 389, 798, 65535, 65535, 65535, 65535, 65535,
    28, 390, 797, 65535, 65535, 65535, 65535, 65535,
    29, 391, 796, 65535, 65535, 65535, 65535, 65535,
    30, 352, 842, 65535, 65535, 65535, 65535, 65535,
    31, 456, 644, 65535, 65535, 65535, 65535, 65535,
    32, 540, 786, 1019, 65535, 65535, 65535, 65535,
    33, 504, 915, 946, 65535, 65535, 65535, 65535,
    34, 428, 964, 1017, 65535, 65535, 65535, 65535,
    35, 427, 991, 1009, 65535, 65535, 65535, 65535,
    36, 426, 990, 997, 65535, 65535, 65535, 65535,
    37, 425, 965, 996, 65535, 65535, 65535, 65535,
    38, 424, 966, 995, 65535, 65535, 65535, 65535,
    39, 461, 951, 986, 65535, 65535, 65535, 65535,
    40, 547, 792, 968, 65535, 65535, 65535, 65535,
    41, 561, 791, 969, 65535, 65535, 65535, 65535,
    42, 515, 790, 992, 65535, 65535, 65535, 65535,
    43, 558, 789, 971, 65535, 65535, 65535, 65535,
    44, 518, 885, 903, 65535, 65535, 65535, 65535,
    45, 519, 854, 931, 65535, 65535, 65535, 65535,
    46, 568, 809, 911, 65535, 65535, 65535, 65535,
    47, 566, 736, 1011, 65535, 65535, 65535, 65535,
    48, 567, 737, 1020, 65535, 65535, 65535, 65535,
    49, 600, 714, 977, 65535, 65535, 65535, 65535,
    50, 514, 881, 904, 65535, 65535, 65535, 65535,
    51, 602, 716, 979, 65535, 65535, 65535, 65535,
    52, 541, 893, 920, 65535, 65535, 65535, 65535,
    53, 604, 712, 981, 65535, 65535, 65535, 65535,
    54, 528, 872, 919, 65535, 65535, 65535, 65535,
    55, 606, 715, 983, 65535, 65535, 65535, 65535,
    56, 538, 892, 906, 65535, 65535, 65535, 65535,
    57, 520, 864, 896, 65535, 65535, 65535, 65535,
    58, 521, 880, 898, 65535, 65535, 65535, 65535,
    59, 526, 877, 899, 65535, 65535, 65535, 65535,
    60, 529, 866, 927, 65535, 65535, 65535, 65535,
    61, 577, 725, 970, 65535, 65535, 65535, 65535,
    62, 576, 728, 976, 65535, 65535, 65535, 65535,
    63, 497, 913, 942, 65535, 65535, 65535, 65535,
    64, 416, 693, 999, 65535, 65535, 65535, 65535,
    65, 417, 673, 998, 65535, 65535, 65535, 65535,
    66, 418, 765, 940, 65535, 65535, 65535, 65535,
    67, 419, 709, 973, 65535, 65535, 65535, 65535,
    68, 420, 695, 1010, 65535, 65535, 65535, 65535,
    69, 421, 724, 972, 65535, 65535, 65535, 65535,
    70, 422, 723, 980, 65535, 65535, 65535, 65535,
    71, 423, 726, 967, 65535, 65535, 65535, 65535,
    72, 490, 680, 889, 65535, 65535, 65535, 65535,
    73, 489, 681, 890, 65535, 65535, 65535, 65535,
    74, 488, 682, 887, 65535, 65535, 65535, 65535,
    75, 487, 683, 888, 65535, 65535, 65535, 65535,
    76, 507, 694, 878, 65535, 65535, 65535, 65535,
    77, 429, 722, 962, 65535, 65535, 65535, 65535,
    78, 430, 731, 982, 65535, 65535, 65535, 65535,
    79, 431, 743, 943, 65535, 65535, 65535, 65535,
    80, 432, 745, 944, 65535, 65535, 65535, 65535,
    81, 433, 747, 945, 65535, 65535, 65535, 65535,
    82, 434, 732, 984, 65535, 65535, 65535, 65535,
    83, 435, 721, 985, 65535, 65535, 65535, 65535,
    84, 436, 734, 961, 65535, 65535, 65535, 65535,
    85, 437, 748, 949, 65535, 65535, 65535, 65535,
    86, 438, 751, 950, 65535, 65535, 65535, 65535,
    87, 439, 767, 907, 65535, 65535, 65535, 65535,
    88, 440, 696, 1023, 65535, 65535, 65535, 65535,
    89, 465, 697, 953, 65535, 65535, 65535, 65535,
    90, 455, 698, 954, 65535, 65535, 65535, 65535,
    91, 454, 699, 955, 65535, 65535, 65535, 65535,
    92, 453, 700, 956, 65535, 65535, 65535, 65535,
    93, 452, 701, 957, 65535, 65535, 65535, 65535,
    94, 451, 702, 958, 65535, 65535, 65535, 65535,
    95, 450, 703, 959, 65535, 65535, 65535, 65535,
    96, 502, 640, 657, 65535, 65535, 65535, 65535,
    97, 501, 641, 658, 65535, 65535, 65535, 65535,
    98, 500, 642, 659, 65535, 65535, 65535, 65535,
    99, 499, 643, 660, 65535, 65535, 65535, 65535,
    100, 525, 609, 661, 65535, 65535, 65535, 65535,
    101, 469, 646, 727, 65535, 65535, 65535, 65535,
    102, 463, 636, 757, 65535, 65535, 65535, 65535,
    103, 462, 647, 730, 65535, 65535, 65535, 65535,
    104, 464, 648, 705, 65535, 65535, 65535, 65535,
    105, 393, 689, 768, 65535, 65535, 65535, 65535,
    106, 394, 688, 769, 65535, 65535, 65535, 65535,
    107, 395, 704, 754, 65535, 65535, 65535, 65535,
    108, 396, 583, 909, 65535, 65535, 65535, 65535,
    109, 397, 581, 910, 65535, 65535, 65535, 65535,
    110, 398, 582, 921, 65535, 65535, 65535, 65535,
    111, 399, 586, 922, 65535, 65535, 65535, 65535,
    112, 400, 590, 912, 65535, 65535, 65535, 65535,
    113, 401, 690, 776, 65535, 65535, 65535, 65535,
    114, 402, 686, 778, 65535, 65535, 65535, 65535,
    115, 403, 685, 780, 65535, 65535, 65535, 65535,
    116, 404, 707, 750, 65535, 65535, 65535, 65535,
    117, 405, 706, 749, 65535, 65535, 65535, 65535,
    118, 392, 621, 874, 65535, 65535, 65535, 65535,
    119, 407, 599, 925, 65535, 65535, 65535, 65535,
    120, 408, 580, 926, 65535, 65535, 65535, 65535,
    121, 409, 613, 884, 65535, 65535, 65535, 65535,
    122, 410, 666, 831, 65535, 65535, 65535, 65535,
    123, 411, 639, 873, 65535, 65535, 65535, 65535,
    124, 412, 638, 894, 65535, 65535, 65535, 65535,
    125, 353, 674, 853, 65535, 65535, 65535, 65535,
    126, 414, 670, 800, 65535, 65535, 65535, 65535,
    127, 415, 671, 830, 65535, 65535, 65535, 65535,
    128, 406, 448, 908, 65535, 65535, 65535, 65535,
    174, 285, 592, 840, 65535, 65535, 65535, 65535,
    130, 304, 672, 807, 65535, 65535, 65535, 65535,
    131, 301, 760, 739, 65535, 65535, 65535, 65535,
    132, 284, 720, 841, 65535, 65535, 65535, 65535,
    133, 281, 756, 812, 65535, 65535, 65535, 65535,
    134, 282, 753, 828, 65535, 65535, 65535, 65535,
    135, 279, 755, 826, 65535, 65535, 65535, 65535,
    136, 280, 735, 851, 65535, 65535, 65535, 65535,
    137, 277, 777, 771, 65535, 65535, 65535, 65535,
    138, 316, 758, 738, 65535, 65535, 65535, 65535,
    139, 317, 710, 766, 65535, 65535, 65535, 65535,
    140, 276, 744, 823, 65535, 65535, 65535, 65535,
    141, 273, 729, 857, 65535, 65535, 65535, 65535,
    142, 274, 691, 923, 65535, 65535, 65535, 65535,
    143, 271, 692, 924, 65535, 65535, 65535, 65535,
    144, 272, 742, 808, 65535, 65535, 65535, 65535,
    145, 269, 746, 802, 65535, 65535, 65535, 65535,
    146, 270, 752, 801, 65535, 65535, 65535, 65535,
    147, 267, 770, 787, 65535, 65535, 65535, 65535,
    148, 268, 773, 788, 65535, 65535, 65535, 65535,
    149, 265, 772, 779, 65535, 65535, 65535, 65535,
    150, 266, 775, 783, 65535, 65535, 65535, 65535,
    151, 263, 774, 781, 65535, 65535, 65535, 65535,
    182, 319, 449, 974, 65535, 65535, 65535, 65535,
    180, 318, 485, 914, 65535, 65535, 65535, 65535,
    181, 275, 484, 993, 65535, 65535, 65535, 65535,
    178, 278, 483, 994, 65535, 65535, 65535, 65535,
    179, 315, 482, 917, 65535, 65535, 65535, 65535,
    176, 314, 481, 918, 65535, 65535, 65535, 65535,
    177, 313, 543, 843, 65535, 65535, 65535, 65535,
    159, 256, 717, 855, 65535, 65535, 65535, 65535,
    160, 320, 546, 713, 65535, 65535, 65535, 65535,
    161, 376, 527, 708, 65535, 65535, 65535, 65535,
    162, 322, 563, 718, 65535, 65535, 65535, 65535,
    163, 323, 562, 719, 65535, 65535, 65535, 65535,
    164, 324, 517, 795, 65535, 65535, 65535, 65535,
    165, 325, 512, 794, 65535, 65535, 65535, 65535,
    166, 326, 494, 814, 65535, 65535, 65535, 65535,
    167, 327, 495, 852, 65535, 65535, 65535, 65535,
    168, 328, 447, 938, 65535, 65535, 65535, 65535,
    169, 329, 446, 937, 65535, 65535, 65535, 65535,
    170, 330, 445, 939, 65535, 65535, 65535, 65535,
    171, 331, 444, 934, 65535, 65535, 65535, 65535,
    172, 332, 443, 930, 65535, 65535, 65535, 65535,
    173, 333, 442, 933, 65535, 65535, 65535, 65535,
    129, 365, 503, 901, 65535, 65535, 65535, 65535,
    175, 335, 441, 932, 65535, 65535, 65535, 65535,
    157, 336, 675, 711, 65535, 65535, 65535, 65535,
    158, 337, 597, 839, 65535, 65535, 65535, 65535,
    155, 338, 544, 895, 65535, 65535, 65535, 65535,
    156, 339, 548, 886, 65535, 65535, 65535, 65535,
    153, 340, 549, 883, 65535, 65535, 65535, 65535,
    154, 341, 550, 879, 65535, 65535, 65535, 65535,
    152, 342, 551, 875, 65535, 65535, 65535, 65535,
    183, 343, 516, 793, 65535, 65535, 65535, 65535,
    184, 344, 542, 785, 65535, 65535, 65535, 65535,
    185, 345, 505, 803, 65535, 65535, 65535, 65535,
    186, 346, 506, 824, 65535, 65535, 65535, 65535,
    187, 347, 486, 820, 65535, 65535, 65535, 65535,
    188, 289, 508, 905, 65535, 65535, 65535, 65535,
    189, 349, 509, 821, 65535, 65535, 65535, 65535,
    190, 350, 510, 818, 65535, 65535, 65535, 65535,
    191, 351, 511, 822, 65535, 65535, 65535, 65535,
    192, 288, 385, 935, 65535, 65535, 65535, 65535,
    193, 348, 496, 687, 65535, 65535, 65535, 65535,
    194, 290, 384, 941, 65535, 65535, 65535, 65535,
    195, 291, 479, 859, 65535, 65535, 65535, 65535,
    196, 292, 478, 863, 65535, 65535, 65535, 65535,
    197, 293, 477, 862, 65535, 65535, 65535, 65535,
    198, 294, 476, 861, 65535, 65535, 65535, 65535,
    199, 295, 475, 834, 65535, 65535, 65535, 65535,
    200, 296, 474, 860, 65535, 65535, 65535, 65535,
    201, 297, 473, 849, 65535, 65535, 65535, 65535,
    202, 298, 472, 850, 65535, 65535, 65535, 65535,
    203, 299, 471, 847, 65535, 65535, 65535, 65535,
    204, 300, 470, 848, 65535, 65535, 65535, 65535,
    205, 283, 669, 665, 65535, 65535, 65535, 65535,
    206, 302, 468, 845, 65535, 65535, 65535, 65535,
    207, 303, 467, 846, 65535, 65535, 65535, 65535,
    208, 286, 587, 733, 65535, 65535, 65535, 65535,
    209, 305, 578, 645, 65535, 65535, 65535, 65535,
    210, 306, 579, 662, 65535, 65535, 65535, 65535,
    211, 307, 553, 679, 65535, 65535, 65535, 65535,
    212, 308, 555, 678, 65535, 65535, 65535, 65535,
    213, 309, 557, 677, 65535, 65535, 65535, 65535,
    214, 310, 559, 676, 65535, 65535, 65535, 65535,
    243, 311, 533, 633, 65535, 65535, 65535, 65535,
    242, 312, 532, 632, 65535, 65535, 65535, 65535,
    217, 258, 569, 759, 65535, 65535, 65535, 65535,
    218, 257, 570, 741, 65535, 65535, 65535, 65535,
    219, 260, 571, 740, 65535, 65535, 65535, 65535,
    220, 259, 572, 764, 65535, 65535, 65535, 65535,
    221, 262, 573, 762, 65535, 65535, 65535, 65535,
    222, 261, 574, 761, 65535, 65535, 65535, 65535,
    223, 264, 575, 763, 65535, 65535, 65535, 65535,
    224, 383, 668, 876, 897, 65535, 65535, 65535,
    225, 381, 667, 856, 936, 65535, 65535, 65535,
    226, 382, 598, 900, 952, 65535, 65535, 65535,
    227, 379, 637, 833, 987, 65535, 65535, 65535,
    228, 380, 634, 836, 988, 65535, 65535, 65535,
    229, 377, 635, 835, 989, 65535, 65535, 65535,
    230, 378, 649, 838, 929, 65535, 65535, 65535,
    231, 375, 650, 837, 928, 65535, 65535, 65535,
    232, 321, 653, 858, 1000, 65535, 65535, 65535,
    233, 373, 631, 829, 1001, 65535, 65535, 65535,
    234, 374, 628, 817, 1002, 65535, 65535, 65535,
    235, 371, 629, 816, 1003, 65535, 65535, 65535,
    236, 372, 626, 815, 1004, 65535, 65535, 65535,
    237, 369, 627, 827, 1005, 65535, 65535, 65535,
    238, 370, 624, 819, 1006, 65535, 65535, 65535,
    239, 367, 625, 813, 1007, 65535, 65535, 65535,
    240, 368, 622, 825, 1008, 65535, 65535, 65535,
    241, 334, 652, 844, 1022, 65535, 65535, 65535,
    216, 366, 654, 916, 1021, 65535, 65535, 65535,
    215, 363, 684, 871, 975, 65535, 65535, 65535,
    244, 364, 618, 811, 1012, 65535, 65535, 65535,
    245, 361, 619, 806, 1013, 65535, 65535, 65535,
    246, 362, 616, 810, 1014, 65535, 65535, 65535,
    247, 359, 617, 805, 1015, 65535, 65535, 65535,
    248, 360, 614, 804, 1016, 65535, 65535, 65535,
    249, 357, 615, 870, 948, 65535, 65535, 65535,
    250, 358, 585, 867, 1018, 65535, 65535, 65535,
    251, 355, 584, 868, 960, 65535, 65535, 65535,
    252, 356, 610, 865, 947, 65535, 65535, 65535,
    253, 413, 554, 882, 978, 65535, 65535, 65535,
    254, 354, 608, 832, 963, 65535, 65535, 65535,
    255, 287, 891, 869, 902, 65535, 65535, 65535
};
typedef float f32x16 __attribute__((ext_vector_type(16)));
typedef short s16x4 __attribute__((ext_vector_type(4)));
__device__ __forceinline__ int v_st(int k, int c) { return ((k >> 3) * 4 + (c >> 5)) * 512 + ((k & 7) * 32 + (c & 31)) * 2; }
__device__ __forceinline__ int v_rd_base(int lane) { return ((lane & 3) << 3) | (((lane >> 2) & 3) << 6) | (((lane >> 4) & 1) << 5) | (((lane >> 5) & 1) << 8); }
constexpr int v_rd_off(int d0, int ks, int half) { return d0 * 512 + ks * 4096 + half * 2048; }
template <int OFF> __device__ __forceinline__ s16x4 tr_read(int vb) { s16x4 r; asm volatile("ds_read_b64_tr_b16 %0, %1 offset:%2" : "=&v"(r) : "v"(vb), "i"(OFF) : "memory"); return r; }
__device__ __forceinline__ unsigned cvtpk(float lo, float hi) { unsigned r; asm volatile("v_cvt_pk_bf16_f32 %0, %1, %2" : "=v"(r) : "v"(lo), "v"(hi)); return r; }
#define MOBA_RD8(S, D0) if (abl & 64) { S##l0 = fk; S##h0 = fk; S##l1 = fk; S##h1 = fk; S##l2 = fk; S##h2 = fk; S##l3 = fk; S##h3 = fk; } else { S##l0 = tr_read<v_rd_off(D0, 0, 0)>(vb); S##h0 = tr_read<v_rd_off(D0, 0, 1)>(vb); S##l1 = tr_read<v_rd_off(D0, 1, 0)>(vb); S##h1 = tr_read<v_rd_off(D0, 1, 1)>(vb); \
                        S##l2 = tr_read<v_rd_off(D0, 2, 0)>(vb); S##h2 = tr_read<v_rd_off(D0, 2, 1)>(vb); S##l3 = tr_read<v_rd_off(D0, 3, 0)>(vb); S##h3 = tr_read<v_rd_off(D0, 3, 1)>(vb); }
#define MOBA_PK(L, H) (bf16x8){L[0], L[1], L[2], L[3], H[0], H[1], H[2], H[3]}
#define MOBA_MM(S, OD) OD = __builtin_amdgcn_mfma_f32_32x32x16_bf16(MOBA_PK(S##l0, S##h0), pb0, OD, 0, 0, 0); OD = __builtin_amdgcn_mfma_f32_32x32x16_bf16(MOBA_PK(S##l1, S##h1), pb1, OD, 0, 0, 0); \
                       OD = __builtin_amdgcn_mfma_f32_32x32x16_bf16(MOBA_PK(S##l2, S##h2), pb2, OD, 0, 0, 0); OD = __builtin_amdgcn_mfma_f32_32x32x16_bf16(MOBA_PK(S##l3, S##h3), pb3, OD, 0, 0, 0)
#define MOBA_WAIT(N) asm volatile("s_waitcnt lgkmcnt(" #N ")" ::: "memory"); __builtin_amdgcn_sched_barrier(0)
__device__ __forceinline__ void pv_all(f32x16 (&o)[4], int vb, bf16x8 pb0, bf16x8 pb1, bf16x8 pb2, bf16x8 pb3, int abl = 0) {
    const s16x4 fk = {pb0[0], pb0[1], pb0[2], pb0[3]};
    s16x4 Al0, Ah0, Al1, Ah1, Al2, Ah2, Al3, Ah3, Bl0, Bh0, Bl1, Bh1, Bl2, Bh2, Bl3, Bh3;
#define MOBA_MM2(OA, OB) OA = __builtin_amdgcn_mfma_f32_32x32x16_bf16(MOBA_PK(Al0, Ah0), pb0, OA, 0, 0, 0); OB = __builtin_amdgcn_mfma_f32_32x32x16_bf16(MOBA_PK(Bl0, Bh0), pb0, OB, 0, 0, 0); \
                         OA = __builtin_amdgcn_mfma_f32_32x32x16_bf16(MOBA_PK(Al1, Ah1), pb1, OA, 0, 0, 0); OB = __builtin_amdgcn_mfma_f32_32x32x16_bf16(MOBA_PK(Bl1, Bh1), pb1, OB, 0, 0, 0); \
                         OA = __builtin_amdgcn_mfma_f32_32x32x16_bf16(MOBA_PK(Al2, Ah2), pb2, OA, 0, 0, 0); OB = __builtin_amdgcn_mfma_f32_32x32x16_bf16(MOBA_PK(Bl2, Bh2), pb2, OB, 0, 0, 0); \
                         OA = __builtin_amdgcn_mfma_f32_32x32x16_bf16(MOBA_PK(Al3, Ah3), pb3, OA, 0, 0, 0); OB = __builtin_amdgcn_mfma_f32_32x32x16_bf16(MOBA_PK(Bl3, Bh3), pb3, OB, 0, 0, 0)
    MOBA_RD8(A, 0); MOBA_RD8(B, 1);
    MOBA_WAIT(0); MOBA_MM2(o[0], o[1]); __builtin_amdgcn_sched_barrier(0);
    MOBA_RD8(A, 2); MOBA_RD8(B, 3);
    MOBA_WAIT(0); MOBA_MM2(o[2], o[3]);
#undef MOBA_MM2
}
#undef MOBA_RD8
#undef MOBA_PK
#undef MOBA_MM
#undef MOBA_WAIT
__device__ __forceinline__ float max3f(float a, float b, float c) { float r; asm("v_max3_f32 %0, %1, %2, %3" : "=v"(r) : "v"(a), "v"(b), "v"(c)); return r; }
__device__ __forceinline__ bf16x8 pack_p(const f32x16& p, int base) {
    v4u w; w.x = cvtpk(p[base + 0], p[base + 1]); w.y = cvtpk(p[base + 2], p[base + 3]); w.z = cvtpk(p[base + 4], p[base + 5]); w.w = cvtpk(p[base + 6], p[base + 7]);
    return __builtin_bit_cast(bf16x8, w);
}

typedef int i32x4m __attribute__((ext_vector_type(4))); typedef int i32x8m __attribute__((ext_vector_type(8)));
__device__ __forceinline__ void attn_phase(const Ctx& C, const bf16* Qb, const bf16* Kb, const bf16* Vb, const unsigned* lists, const unsigned* lcnt, gu32* qctr,
                                           bf16* POa, bf16* POb, float* LSE, const float* q_gain, const float* k_gain, int abl = 0) {
    LAS unsigned char* lds = C.lds;
    const int lane = C.lane, r32 = lane & 31, hi = lane >> 5;
    int koff[4];
#pragma unroll
    for (int c4 = 0; c4 < 4; ++c4) koff[c4] = r32 * 128 + ((((c4 >> 1) * 4 + 2 * hi + (c4 & 1)) ^ (r32 & 7)) << 4);
    const int vb0 = (int)(uintptr_t)(lds + 65536) + v_rd_base(lane);
    bool bounded;
    { float gq = 0.f, gk = 0.f;
#pragma unroll
        for (int i = 0; i < 2; ++i) { gq = fmaxf(gq, fabsf(q_gain[lane + 64 * i])); gk = fmaxf(gk, fabsf(k_gain[lane + 64 * i])); }
#pragma unroll
        for (int o_ = 1; o_ < 64; o_ <<= 1) { gq = fmaxf(gq, __shfl_xor(gq, o_)); gk = fmaxf(gk, __shfl_xor(gk, o_)); }
        bounded = (gq * gk * 11.313708499f * 1.4426950408889634f * 1.02f) <= 40.0f; }
#ifdef ATTN_PROBE
    unsigned long long pr_step = 0, pr_nstep = 0, pr_stage = 0, pr_nunit = 0, pr_tile = 0, pr_ntile = 0, pr_ta = 0, pr_tb = 0, pr_tc = 0; const unsigned long long pr_t0 = clock64();
#define PR_T() clock64()
#endif
    const bool tab = (C.G == 256); const unsigned short* sched = C.local ? ATT_SCHED_PAIR + (C.vcu & 63) * 8 : ATT_SCHED + (blockIdx.x & 255) * 8;
    const unsigned bh0 = 8u * (unsigned)(C.vcu >> 6);
#define MOBA_SCHED(K) ((K) < 8 ? (C.local ? (sched[K] == 0xFFFFu ? 0xFFFFu : ((unsigned)(sched[K] >> 3) << 5) + bh0 + (unsigned)(sched[K] & 7)) : (unsigned)sched[K]) : 0xFFFFu)
    unsigned u = tab ? MOBA_SCHED(0) : (unsigned)blockIdx.x;
    for (int k = 0; u < 1024u; ++k) {
        const int j = (int)(u >> 5), bh = (int)(u & 31u), b = bh >> 3, h = bh & 7;
#ifdef ATTN_PROBE
        const unsigned long long pr_s0 = PR_T();
#endif
        v4u kreg[8], vreg[8];
        int tidv = C.tid; asm volatile("" : "+v"(tidv));
        { const bf16* Kg = Kb + (size_t)(b * SEQ + j * 256) * DM + h * HD; const bf16* Vg = Vb + (size_t)((b * SEQ + j * 256) >> 12) * VXTRA + (size_t)(b * SEQ + j * 256) * DM + h * HD;
#pragma unroll
            for (int i = 0; i < 8; ++i) { const int c = tidv + i * NT, row = c >> 4, ch = c & 15;
                kreg[i] = *(const v4u*)(Kg + (size_t)row * DM + ch * 8); vreg[i] = *(const v4u*)(Vg + (size_t)row * DM + ch * 8); } }
        int cnt = (int)lcnt[bh * 32 + j]; cnt = cnt > LCAP ? LCAP : cnt;
        const unsigned* lst = lists + list_off(bh, j);
        const int G = (cnt + 31) >> 5, ntiles = G + 8;
        int r32l = r32; asm volatile("" : "+v"(r32l));
#define MOBA_ENTRY(E, T) do { if ((T) >= G) E = ((unsigned)(j * 256 + (7 - ((T) - G)) * 32 + r32l) << 2); else E = lst[(T) * 32 + r32l]; } while (0)
#define MOBA_LOADQ(QV, E) do { const bf16* qp_ = Qb + (size_t)(b * SEQ + ((abl & 2) ? r32 : (int)(((E) >> 2) & 8191u))) * DM + h * HD + hi * 8; _Pragma("unroll") for (int d0 = 0; d0 < 8; ++d0) QV[d0] = *(const bf16x8*)(qp_ + d0 * 16); } while (0)
#define MOBA_FETCH(T) do { int t_ = 0; if (lane == 0) t_ = (int)__hip_atomic_fetch_add((LAS unsigned*)(C.misc + 1), 1u, __ATOMIC_RELAXED, __HIP_MEMORY_SCOPE_WORKGROUP); T = __builtin_amdgcn_readfirstlane(t_); } while (0)
        int t0 = C.wave, t1 = C.wave + 8; unsigned e0 = 0u, e1 = 0u;
        if (t0 < ntiles) MOBA_ENTRY(e0, t0);
        if (t1 < ntiles) MOBA_ENTRY(e1, t1);
#ifdef ATTN_PROBE
        asm volatile("s_waitcnt vmcnt(0) lgkmcnt(0)" ::: "memory"); const unsigned long long pr_s1 = PR_T();
#endif
        __syncthreads();
#ifdef ATTN_PROBE
        const unsigned long long pr_s2 = PR_T();
#endif
        if (C.tid == 0) C.misc[1] = 16u;
        bf16x8 qr[8];
        MOBA_LOADQ(qr, e0);
#pragma unroll
        for (int i = 0; i < 8; ++i) { const int c = tidv + i * NT, row = c >> 4, ch = c & 15;
            { const v4u kw = kreg[i]; unsigned w0 = 0u, w1 = 0u;
                w0 = __builtin_amdgcn_cvt_pk_fp8_f32(bf_lo(kw.x), bf_hi(kw.x), w0, false); w0 = __builtin_amdgcn_cvt_pk_fp8_f32(bf_lo(kw.y), bf_hi(kw.y), w0, true);
                w1 = __builtin_amdgcn_cvt_pk_fp8_f32(bf_lo(kw.z), bf_hi(kw.z), w1, false); w1 = __builtin_amdgcn_cvt_pk_fp8_f32(bf_lo(kw.w), bf_hi(kw.w), w1, true);
                const int s_ = ch >> 1, off_ = (s_ >> 2) * 64 + (ch & 1) * 32 + (s_ & 3) * 8;
                *(LAS unsigned long long*)(lds + row * 128 + ((((off_ >> 4) ^ (row & 7)) << 4) | (off_ & 8))) = (unsigned long long)w0 | ((unsigned long long)w1 << 32); }
            *(LAS v4u*)(lds + 65536 + (row >> 6) * 16384 + v_st(row & 63, ch * 8)) = vreg[i]; }
        __syncthreads();
#ifdef ATTN_PROBE
        { const unsigned long long pr_s3 = PR_T(); pr_stage += pr_s3 - pr_s0; pr_nunit += 1; pr_ta += pr_s1 - pr_s0; pr_tb += pr_s2 - pr_s1; pr_tc += pr_s3 - pr_s2; }
#endif
        unsigned opk[16]; unsigned oent = 0u; float olse = 0.f, oscl = 0.f; bool ovalid = false;
#define MOBA_FLUSH() do { if (ovalid) { const int sq_ = (int)((oent >> 2) & 8191u), sl_ = (int)(oent & 3u); \
            unsigned char* dst_ = (unsigned char*)(sl_ < 2 ? POa : POb) + po_off(sl_, b * SEQ + sq_) + h * HD + 16 * hi; \
            _Pragma("unroll") for (int i_ = 0; i_ < 4; ++i_) { v4u w_; w_.x = opk[4 * i_]; w_.y = opk[4 * i_ + 1]; w_.z = opk[4 * i_ + 2]; w_.w = opk[4 * i_ + 3]; *(v4u*)(dst_ + 32 * i_) = w_; } \
            if (hi == 0) ((float*)POa)[psc_off(b * SEQ + sq_, h) + sl_] = oscl; \
            if (hi == 0) LSE[((size_t)bh * SEQ + sq_) * 4 + sl_] = olse; } } while (0)
        if ((abl & 128) && C.wave >= 4) t0 = ntiles;
        while (t0 < ntiles) {
            bf16x8 qn[8];
            MOBA_LOADQ(qn, e1);
            int t2; unsigned e2 = 0u; MOBA_FETCH(t2); if (t2 < ntiles) MOBA_ENTRY(e2, t2);
            if (!(abl & 1)) MOBA_FLUSH();
            const int sq = (int)((e0 >> 2) & 8191u);
            const bool causal = t0 >= G; const int nkt = (abl & 4) ? 1 : (causal ? (((7 - (t0 - G)) >> 1) + 1) : 4);
            const bool valid = causal || (t0 * 32 + r32 < cnt);
#ifdef ATTN_PROBE
            const unsigned long long pr_a = PR_T();
#endif
            const int qpos = sq & 255;
            float m = bounded ? 0.0f : -1e30f, l = 0.f; f32x16 o[4];
#pragma unroll
            for (int d0 = 0; d0 < 4; ++d0) o[d0] = f32x16{};
            i32x8m q8[2];
#pragma unroll
            for (int s2 = 0; s2 < 2; ++s2) { unsigned w[8];
#pragma unroll
                for (int s = 0; s < 4; ++s) { const v4u qw = __builtin_bit_cast(v4u, qr[4 * s2 + s]); unsigned w0 = 0u, w1 = 0u;
                    w0 = __builtin_amdgcn_cvt_pk_fp8_f32(bf_lo(qw.x), bf_hi(qw.x), w0, false); w0 = __builtin_amdgcn_cvt_pk_fp8_f32(bf_lo(qw.y), bf_hi(qw.y), w0, true);
                    w1 = __builtin_amdgcn_cvt_pk_fp8_f32(bf_lo(qw.z), bf_hi(qw.z), w1, false); w1 = __builtin_amdgcn_cvt_pk_fp8_f32(bf_lo(qw.w), bf_hi(qw.w), w1, true);
                    w[2 * s] = w0; w[2 * s + 1] = w1; }
                q8[s2] = (i32x8m){(int)w[0], (int)w[1], (int)w[2], (int)w[3], (int)w[4], (int)w[5], (int)w[6], (int)w[7]}; }
#ifdef ATTN_PROBE
            const unsigned long long pr_b = PR_T();
#endif
            for (int kt = 0; kt < nkt; ++kt) {
                f32x16 p0 = f32x16{}, p1 = f32x16{};
#define MOBA_KRD(DST, C4, HALF) asm volatile("ds_read_b128 %0, %1 offset:%2" : "=&v"(DST) : "v"(kbase + koff[C4]), "i"((HALF) * 4096) : "memory")
#define MOBA_KWAIT(N) asm volatile("s_waitcnt lgkmcnt(" #N ")" ::: "memory"); __builtin_amdgcn_sched_barrier(0)
#define MOBA_CAT(A, B) __builtin_shufflevector(__builtin_bit_cast(i32x4m, A), __builtin_bit_cast(i32x4m, B), 0, 1, 2, 3, 4, 5, 6, 7)
                { const int kbase = (int)(uintptr_t)lds + kt * 8192;
                    v4u ka0, ka1, kb0, kb1, ka2, ka3, kb2, kb3;
                    MOBA_KRD(ka0, 0, 0); MOBA_KRD(ka1, 1, 0); MOBA_KRD(kb0, 0, 1); MOBA_KRD(kb1, 1, 1);
                    MOBA_KRD(ka2, 2, 0); MOBA_KRD(ka3, 3, 0); MOBA_KRD(kb2, 2, 1); MOBA_KRD(kb3, 3, 1);
                    MOBA_KWAIT(4);
                    p0 = __builtin_amdgcn_mfma_scale_f32_32x32x64_f8f6f4(MOBA_CAT(ka0, ka1), q8[0], p0, 0, 0, 0, 127, 0, 127);
                    p1 = __builtin_amdgcn_mfma_scale_f32_32x32x64_f8f6f4(MOBA_CAT(kb0, kb1), q8[0], p1, 0, 0, 0, 127, 0, 127);
                    MOBA_KWAIT(0);
                    p0 = __builtin_amdgcn_mfma_scale_f32_32x32x64_f8f6f4(MOBA_CAT(ka2, ka3), q8[1], p0, 0, 0, 0, 127, 0, 127);
                    p1 = __builtin_amdgcn_mfma_scale_f32_32x32x64_f8f6f4(MOBA_CAT(kb2, kb3), q8[1], p1, 0, 0, 0, 127, 0, 127); __builtin_amdgcn_sched_barrier(0); }
#undef MOBA_KRD
#undef MOBA_KWAIT
#undef MOBA_CAT
                if (causal && kt == nkt - 1) { const float NEG = -__builtin_inff(); const int kb = kt * 64 + 4 * hi;
#pragma unroll
                    for (int r = 0; r < 16; ++r) { const int kv = kb + (r & 3) + 8 * (r >> 2); if (kv > qpos) p0[r] = NEG; if (kv + 32 > qpos) p1[r] = NEG; } }
                if (!(abl & 8)) {
                float ps = 0.f;
                if (bounded) {
#pragma unroll
                    for (int r = 0; r < 16; ++r) { p0[r] = __builtin_amdgcn_exp2f(p0[r]); p1[r] = __builtin_amdgcn_exp2f(p1[r]); ps += p0[r] + p1[r]; }
                } else {
                float pm = max3f(p0[0], p1[0], p0[1]), pm2 = max3f(p1[1], p0[2], p1[2]);
#pragma unroll
                for (int r = 3; r < 15; r += 3) { pm = max3f(pm, p0[r], p1[r]); pm2 = max3f(pm2, p0[r + 1], p1[r + 1]); pm = max3f(pm, p0[r + 2], p1[r + 2]); }
                pm = max3f(pm, pm2, p0[15]); pm = max3f(pm, p1[15], m);
                { auto rr = __builtin_amdgcn_permlane32_swap(__float_as_uint(pm), __float_as_uint(pm), false, false); pm = max3f(__uint_as_float(rr[0]), __uint_as_float(rr[1]), m); }
                if (kt == 0) m = pm;
                else if (__any(pm > m + 8.0f)) { const float mn = pm > m + 8.0f ? pm : m, alpha = __builtin_amdgcn_exp2f(m - mn); m = mn; l = l * alpha;
#pragma unroll
                    for (int d0 = 0; d0 < 4; ++d0) o[d0] = o[d0] * alpha; }
#pragma unroll
                for (int r = 0; r < 16; ++r) { p0[r] = __builtin_amdgcn_exp2f(p0[r] - m); p1[r] = __builtin_amdgcn_exp2f(p1[r] - m); ps += p0[r] + p1[r]; }
                }
                l += ps;
                }
                const bf16x8 pb0 = pack_p(p0, 0), pb1 = pack_p(p0, 8), pb2 = pack_p(p1, 0), pb3 = pack_p(p1, 8);
                const int vb = vb0 + kt * 16384;
                if (!(abl & 16)) pv_all(o, vb, pb0, pb1, pb2, pb3, abl);
                else { asm volatile("" :: "v"(pb0), "v"(pb1), "v"(pb2), "v"(pb3)); }
            }
#ifdef ATTN_PROBE
            pr_step += PR_T() - pr_b; pr_nstep += nkt;
#endif
            { auto rr = __builtin_amdgcn_permlane32_swap(__float_as_uint(l), __float_as_uint(l), false, false); l = __uint_as_float(rr[0]) + __uint_as_float(rr[1]); }
            const float inv = 1.0f / l, lse = m + __builtin_amdgcn_logf(l);
            float amax = 0.f;
#pragma unroll
            for (int d0 = 0; d0 < 4; ++d0)
#pragma unroll
                for (int r = 0; r < 16; r += 2) amax = fmaxf(amax, fmaxf(fabsf(o[d0][r]), fabsf(o[d0][r + 1])));
            { auto rr = __builtin_amdgcn_permlane32_swap(__float_as_uint(amax), __float_as_uint(amax), false, false); amax = fmaxf(__uint_as_float(rr[0]), __uint_as_float(rr[1])); }
            amax = fmaxf(amax, 1e-30f);
            const float qinv = 127.0f / amax, oscale = amax * inv * (1.0f / 127.0f);
#pragma unroll
            for (int d0 = 0; d0 < 4; ++d0) {
                unsigned wg[4];
#pragma unroll
                for (int g = 0; g < 4; ++g) { unsigned w = 0u;
#pragma unroll
                    for (int e4 = 0; e4 < 4; ++e4) w = __builtin_amdgcn_cvt_pk_u8_f32(__builtin_rintf(__builtin_fmaf(o[d0][4 * g + e4], qinv, 128.0f)), (unsigned)e4, w);
                    wg[g] = w; }
                const auto r02 = __builtin_amdgcn_permlane32_swap(wg[0], wg[2], false, false), r13 = __builtin_amdgcn_permlane32_swap(wg[1], wg[3], false, false);
                opk[4 * d0] = r02[0]; opk[4 * d0 + 1] = r02[1]; opk[4 * d0 + 2] = r13[0]; opk[4 * d0 + 3] = r13[1]; }
            oscl = oscale;
            oent = e0; olse = lse; ovalid = valid;
            t0 = t1; e0 = e1; t1 = t2; e1 = e2;
#pragma unroll
            for (int d0 = 0; d0 < 8; ++d0) qr[d0] = qn[d0];
#ifdef ATTN_PROBE
            pr_tile += PR_T() - pr_a; pr_ntile += 1;
#endif
        }
        if (!(abl & 1)) MOBA_FLUSH();
#undef MOBA_FLUSH
#undef MOBA_FETCH
#undef MOBA_ENTRY
#undef MOBA_LOADQ
        u = tab ? MOBA_SCHED(k + 1) : u + (unsigned)C.G;
    }
#ifdef ATTN_PROBE
    if (lane == 0) { unsigned long long* pc = (unsigned long long*)((unsigned*)qctr + 512);
        atomicAdd(pc + 0, pr_step); atomicAdd(pc + 1, pr_nstep); atomicAdd(pc + 2, pr_stage); atomicAdd(pc + 3, pr_nunit); atomicAdd(pc + 4, pr_tile); atomicAdd(pc + 5, pr_ntile); atomicAdd(pc + 6, clock64() - pr_t0); atomicAdd(pc + 7, 1ull); atomicAdd(pc + 8, pr_ta); atomicAdd(pc + 9, pr_tb); atomicAdd(pc + 10, pr_tc); }
#endif
}
}

__device__ __forceinline__ void combine_phase(const Ctx& C, const bf16* __restrict__ POa, const bf16* __restrict__ POb, const float* __restrict__ LSE, bf16* __restrict__ AO) {
    const int gw = C.vcu * NWAVES + C.wave, NGW = C.G * NWAVES, h = C.lane >> 3, dch = (C.lane & 7) * 16;
    for (int tg = gw; tg < M / 16; tg += NGW) {
        const int tok0 = tg * 16, b = tok0 >> 13, nbk = (tok0 & (SEQ - 1)) >> 8, nv = 1 + (nbk < 3 ? nbk : 3);
#pragma unroll 4
        for (int r = 0; r < 16; ++r) {
            const int tok = tok0 + r, s = tok & (SEQ - 1);
            const size_t bhs = (size_t)(b * NH + h) * SEQ + s;
            const f32x4 ls = *(const f32x4*)(LSE + bhs * 4);
            v4u pa[4];
#pragma unroll
            for (int i = 0; i < 4; ++i) pa[i] = *(const v4u*)((const unsigned char*)(i < 2 ? POa : POb) + po_off(i, tok) + h * HD + dch);
            const f32x4 sc4 = *(const f32x4*)((const float*)POa + psc_off(tok, h));
            float mx = ls[0]; if (nv > 1) mx = fmaxf(mx, ls[1]); if (nv > 2) mx = fmaxf(mx, ls[2]); if (nv > 3) mx = fmaxf(mx, ls[3]);
            float w[4]; float wsum = 0.f;
#pragma unroll
            for (int i = 0; i < 4; ++i) { w[i] = i < nv ? __builtin_amdgcn_exp2f(ls[i] - mx) : 0.f; wsum += w[i]; }
            const float inv = 1.0f / wsum;
            float acc[16]; float wtot = 0.f;
#pragma unroll
            for (int e = 0; e < 16; ++e) acc[e] = 0.f;
#pragma unroll
            for (int i = 0; i < 4; ++i) {
                const float wi = i < nv ? w[i] * inv * sc4[i] : 0.f;
                wtot += wi;
                const unsigned q4[4] = {pa[i].x, pa[i].y, pa[i].z, pa[i].w};
#pragma unroll
                for (int k = 0; k < 4; ++k) { acc[4 * k] += wi * (float)(q4[k] & 255u); acc[4 * k + 1] += wi * (float)((q4[k] >> 8) & 255u); acc[4 * k + 2] += wi * (float)((q4[k] >> 16) & 255u); acc[4 * k + 3] += wi * (float)(q4[k] >> 24); } }
#pragma unroll
            for (int e = 0; e < 16; ++e) acc[e] -= 128.0f * wtot;
            v4u o0;
            o0.x = __builtin_amdgcn_cvt_pk_fp8_f32(16.f * acc[2], 16.f * acc[3], __builtin_amdgcn_cvt_pk_fp8_f32(16.f * acc[0], 16.f * acc[1], 0u, false), true);
            o0.y = __builtin_amdgcn_cvt_pk_fp8_f32(16.f * acc[6], 16.f * acc[7], __builtin_amdgcn_cvt_pk_fp8_f32(16.f * acc[4], 16.f * acc[5], 0u, false), true);
            o0.z = __builtin_amdgcn_cvt_pk_fp8_f32(16.f * acc[10], 16.f * acc[11], __builtin_amdgcn_cvt_pk_fp8_f32(16.f * acc[8], 16.f * acc[9], 0u, false), true);
            o0.w = __builtin_amdgcn_cvt_pk_fp8_f32(16.f * acc[14], 16.f * acc[15], __builtin_amdgcn_cvt_pk_fp8_f32(16.f * acc[12], 16.f * acc[13], 0u, false), true);
            *(v4u*)((unsigned char*)AO + (size_t)(tok >> 12) * F8_XS + (size_t)(tok & 4095) * DM + h * HD + dch) = o0;
        }
    }
}

#ifdef ATTN_SELFCHECK
__device__ __forceinline__ void check_phase(const Ctx& C, const bf16* Qb, const bf16* Kb, const bf16* Vb, const float* kmean, const bf16* AO, gu32* bad, gu32* skipped) {
    const int gw = C.vcu * NWAVES + C.wave, lane = C.lane;
    for (int rep = 0; rep < 4; ++rep) {
    const unsigned i = (unsigned)gw + 2048u * (unsigned)rep;
    const int b = i & 3, h = (i >> 2) & 7;
    int s;
    if (i < 512u) { const int k = i >> 5; const int offs[4] = {0, 1, 254, 255}; s = (k & 3) * 256 + offs[(k >> 2) & 3]; }
    else s = (int)((i * 2654435761u) >> 12) & (SEQ - 1);
    const int nb = s >> 8, bh = b * 8 + h;
    const bf16* qp = Qb + (size_t)(b * SEQ + s) * DM + h * HD;
    const unsigned qw = *(const unsigned*)(qp + 2 * lane); const float q0 = bf_lo(qw), q1 = bf_hi(qw);
    const float NEG = -__builtin_inff();
    float v0 = NEG, v1 = NEG, v2 = NEG, v3 = NEG; int i0 = -1, i1 = -1, i2 = -1;
    for (int j = 0; j < nb; ++j) { const float* km = kmean + (size_t)(bh * 32 + j) * 128; const float sc = wave_sum(q0 * km[2 * lane] + q1 * km[2 * lane + 1]);
        if (sc > v3) v3 = sc;
        if (sc > v2) { v3 = v2; if (sc > v1) { v2 = v1; i2 = i1; if (sc > v0) { v1 = v0; i1 = i0; v0 = sc; i0 = j; } else { v1 = sc; i1 = j; } } else { v2 = sc; i2 = j; } } }
    if (nb > 3 && (v2 - v3) < 2e-3f * (fabsf(v2) + fabsf(v3)) + 1e-6f) { if (lane == 0) atomicAdd((unsigned*)skipped, 1u); continue; }
    float m = -1e30f, l = 0.f, o0 = 0.f, o1 = 0.f;
    for (int t = 0; t < 4; ++t) { const int blk = t == 0 ? nb : (t == 1 ? i0 : (t == 2 ? i1 : i2)); if (blk < 0) continue;
        const int nk = t == 0 ? (s & 255) + 1 : 256;
        for (int k = 0; k < nk; ++k) { const size_t row = (size_t)(b * SEQ + blk * 256 + k) * DM + h * HD + 2 * lane;
            const unsigned kw = *(const unsigned*)(Kb + row), vw = *(const unsigned*)(Vb + (size_t)((b * SEQ + blk * 256 + k) >> 12) * VXTRA + row);
            const float sc = wave_sum(q0 * bf_lo(kw) + q1 * bf_hi(kw));
            const float mn = fmaxf(m, sc), al = __builtin_amdgcn_exp2f(m - mn), p = __builtin_amdgcn_exp2f(sc - mn); m = mn;
            l = l * al + p; o0 = o0 * al + p * bf_lo(vw); o1 = o1 * al + p * bf_hi(vw); } }
    const unsigned aw = *(const unsigned*)(AO + (size_t)(b * SEQ + s) * DM + h * HD + 2 * lane);
    const float r0 = o0 / l, r1 = o1 / l, e0 = fabsf(r0 - bf_lo(aw)), e1 = fabsf(r1 - bf_hi(aw));
    const bool wrong = !(e0 <= 2.5e-3f + 0.01f * fabsf(r0)) || !(e1 <= 2.5e-3f + 0.01f * fabsf(r1));
    if (__any(wrong)) { if (lane == 0) atomicAdd((unsigned*)bad, 1u); }
    }
}
#endif

__device__ __forceinline__ void conv_phase(const Ctx& C, const bf16* __restrict__ BG, const bf16* __restrict__ UU, const float* __restrict__ cw, bf16* __restrict__ Z) {
    const int gw = C.vcu * NWAVES + C.wave, NGW = C.G * NWAVES;
    for (int wu = gw * 2; wu < (M / 16) * 2; wu += ((wu & 1) ? NGW * 2 - 1 : 1)) {
        const int rg = wu >> 1, c0 = (wu & 1) * 512 + C.lane * 8, row0 = rg * 16;
        float w0[8], w1[8], w2[8];
#pragma unroll
        for (int e = 0; e < 8; ++e) { w0[e] = cw[c0 + e]; w1[e] = cw[DM + c0 + e]; w2[e] = cw[2 * DM + c0 + e]; }
        float p2[8], p1[8];
        if ((row0 & (SEQ - 1)) == 0) {
#pragma unroll
            for (int e = 0; e < 8; ++e) { p2[e] = 0.f; p1[e] = 0.f; }
        } else {
            const v4u a = *(const v4u*)(UU + (size_t)(row0 - 2) * DM + c0), c = *(const v4u*)(UU + (size_t)(row0 - 1) * DM + c0);
            p2[0] = bf_lo(a.x); p2[1] = bf_hi(a.x); p2[2] = bf_lo(a.y); p2[3] = bf_hi(a.y); p2[4] = bf_lo(a.z); p2[5] = bf_hi(a.z); p2[6] = bf_lo(a.w); p2[7] = bf_hi(a.w);
            p1[0] = bf_lo(c.x); p1[1] = bf_hi(c.x); p1[2] = bf_lo(c.y); p1[3] = bf_hi(c.y); p1[4] = bf_lo(c.z); p1[5] = bf_hi(c.z); p1[6] = bf_lo(c.w); p1[7] = bf_hi(c.w);
        }
#pragma unroll 4
        for (int r = 0; r < 16; ++r) {
            const v4u a = *(const v4u*)(UU + (size_t)(row0 + r) * DM + c0), g = *(const v4u*)(BG + (size_t)(row0 + r) * DM + c0);
            float cu[8], bg[8], z[8];
            cu[0] = bf_lo(a.x); cu[1] = bf_hi(a.x); cu[2] = bf_lo(a.y); cu[3] = bf_hi(a.y); cu[4] = bf_lo(a.z); cu[5] = bf_hi(a.z); cu[6] = bf_lo(a.w); cu[7] = bf_hi(a.w);
            bg[0] = bf_lo(g.x); bg[1] = bf_hi(g.x); bg[2] = bf_lo(g.y); bg[3] = bf_hi(g.y); bg[4] = bf_lo(g.z); bg[5] = bf_hi(g.z); bg[6] = bf_lo(g.w); bg[7] = bf_hi(g.w);
#pragma unroll
            for (int e = 0; e < 8; ++e) { z[e] = bg[e] * (w0[e] * p2[e] + w1[e] * p1[e] + w2[e] * cu[e]); p2[e] = p1[e]; p1[e] = cu[e]; }
            v4u o; o.x = pk2(z[0], z[1]); o.y = pk2(z[2], z[3]); o.z = pk2(z[4], z[5]); o.w = pk2(z[6], z[7]);
            *(v4u*)(Z + (size_t)(row0 + r) * DM + c0) = o;
        }
    }
}

__device__ __forceinline__ void xcd_local_barrier(const XcdBarrier& b) {
    asm volatile("s_waitcnt vmcnt(0)" ::: "memory");
    __syncthreads();
    if (threadIdx.x == 0) {
        unsigned* bar = b.bar;
        __builtin_amdgcn_s_waitcnt(0);
        const unsigned nloc = b.st[0];
        const unsigned old = xb_add(&bar[XB_XSUB(b.x)], 1u);
        const unsigned gen = old / nloc;
        if (old + 1u == (gen + 1u) * nloc) xb_add(&bar[XB_XGEN(b.x)], 1u);
        else XB_SPIN(xb_ld(&bar[XB_XGEN(b.x)]) == gen, bar);
        __builtin_amdgcn_fence(__ATOMIC_ACQUIRE, "agent");
        asm volatile("s_waitcnt vmcnt(0)" ::: "memory");
    }
    __syncthreads();
}

__device__ __forceinline__ void xcd_pair_barrier(const XcdBarrier& b, unsigned* ptop) {
    asm volatile("s_waitcnt vmcnt(0)" ::: "memory");
    __syncthreads();
    if (threadIdx.x == 0) {
        unsigned* bar = b.bar;
        __builtin_amdgcn_s_waitcnt(0);
        const unsigned nloc = b.st[0];
        const unsigned old = xb_add(&bar[XB_XSUB(b.x)], 1u);
        const unsigned gen = old / nloc;
        if (old + 1u == (gen + 1u) * nloc) {
            __builtin_amdgcn_fence(__ATOMIC_RELEASE, "agent");
            asm volatile("s_waitcnt vmcnt(0)" ::: "memory");
            const unsigned og = xb_add(ptop, 1u);
            const unsigned tg = og / 2u;
            if (og + 1u == (tg + 1u) * 2u) xb_add(ptop + 64, 1u);
            else XB_SPIN(xb_ld(ptop + 64) == tg, bar);
            __builtin_amdgcn_fence(__ATOMIC_ACQUIRE, "agent");
            xb_add(&bar[XB_XGEN(b.x)], 1u);
            asm volatile("s_waitcnt vmcnt(0)" ::: "memory");
        } else {
            XB_SPIN(xb_ld(&bar[XB_XGEN(b.x)]) == gen, bar);
            __builtin_amdgcn_fence(__ATOMIC_ACQUIRE, "agent");
            asm volatile("s_waitcnt vmcnt(0)" ::: "memory");
        }
    }
    __syncthreads();
}

#ifndef KN_WGM_QKV
#define KN_WGM_QKV 4
#endif
#ifndef KN_WGM_GU
#define KN_WGM_GU 4
#endif
#ifndef KN_WGM_RES
#define KN_WGM_RES 4
#endif
#ifndef ATTN_ABL
#define ATTN_ABL 0
#endif
#ifndef KN_SP2
#define KN_SP2 true
#endif
#ifndef KN_ALIGN_RES
#define KN_ALIGN_RES true
#endif
#ifndef KN_ALIGN_FFN
#define KN_ALIGN_FFN true
#endif
constexpr int N_PHASES = 17;
struct Args { const float* in[15]; float* out; unsigned char* ws; int ph_lo, ph_hi; };
static_assert(sizeof(Args) == 15 * 8 + 8 + 8 + 8, "Args has no padding");

__global__ void __launch_bounds__(NT, 2) moba_fwd(Args args) {
    extern __shared__ __attribute__((aligned(16))) unsigned char lds_raw[];
    Ctx C;
    C.lds = (LAS unsigned char*)lds_raw; C.misc = (volatile LAS unsigned*)(C.lds + MISC_OFF);
    C.tid = threadIdx.x; C.lane = C.tid & 63; C.wave = __builtin_amdgcn_readfirstlane(C.tid >> 6);
    C.local = 0; C.G = gridDim.x; { const int bx = blockIdx.x; C.vcu = (C.G % 8 == 0) ? (bx % 8) * (C.G / 8) + bx / 8 : bx; }
    unsigned char* ws = args.ws;
    gu32* ctl = (gu32*)(ws + WS_CTL);
    if (C.tid < 32) C.misc[C.tid] = 0u;
    __syncthreads();
    const int lo = args.ph_lo, hi = args.ph_hi;
    XcdBarrier bar; bar.bar = (unsigned*)ctl + CW_BAR; bar.x = 0; bar.st = nullptr;
    if (hi - lo > 1) { bar = xcd_barrier_post((unsigned*)ctl + CW_BAR, C.misc + 8);
        if (C.tid == 0) C.misc[12] = __hip_atomic_fetch_add(ctl + CW_RANK + 64 * bar.x, 1u, __ATOMIC_RELAXED, __HIP_MEMORY_SCOPE_AGENT); }
    bool local = false; int cvb = (int)blockIdx.x;
#ifndef PHASE_MASK
#define PHASE_MASK 0x1ffff
#endif
#define IN(k) ((((PHASE_MASK) >> (k)) & 1) && lo <= (k) && (k) < hi)
#ifndef REPEAT_MASK
#define REPEAT_MASK 0
#endif
#define REP(k) (((REPEAT_MASK) >> (k)) & 1)
#define SEAM(k) do { if (IN(k) && IN((k) + 1)) xcd_barrier(bar); } while (0)
    const float* x = args.in[0]; float* out = args.out;
    float* mod = (float*)(ws + WS_MOD); float* kmean = (float*)(ws + WS_KMEAN);
    bf16* HB = (bf16*)(ws + WS_H); bf16* QB = (bf16*)(ws + WS_Q); bf16* KB = (bf16*)(ws + WS_K); bf16* VB = (bf16*)(ws + WS_V);
    bf16* POa = (bf16*)out; bf16* POb = (bf16*)(ws + WS_POB); float* LSE = (float*)(ws + WS_LSE); unsigned* lists = (unsigned*)(ws + WS_LIST);
    bf16* FB = (bf16*)(ws + WS_FB); bf16* YB = (bf16*)(ws + WS_YB);
    bf16* ACT = (bf16*)(ws + WS_ACT); bf16* BG = (bf16*)(ws + WS_BG); bf16* UU = (bf16*)(ws + WS_UU); bf16* ZB = (bf16*)(ws + WS_Z);
    bf16* XR = (bf16*)(ws + WS_XB);
    LAS unsigned char* ring = C.lds;

    if (IN(0)) p0_prologue(C, args.in, ws, 0, C.vcu, C.G); SEAM(0);
    if (lo == 0 && hi == N_PHASES && IN(0)) {
        if (C.tid == 0) { unsigned nz = 0, below = 0; bool ok = C.G == 256;
            for (unsigned j = 0; j < 16; ++j) { const unsigned c = xb_ld(bar.bar + XB_XCNT(j)); if (c) { ok = ok && c == 32u; ++nz; if (j < bar.x) ++below; } }
            ok = ok && nz == 8u && C.misc[12] < 32u;
#ifdef FORCE_NO_LOCAL
            ok = false;
#endif
            C.misc[13] = ok ? (0x80000000u | (below * 32u + C.misc[12])) : 0u; }
        __syncthreads();
        const unsigned w = C.misc[13];
        if (w >> 31) { local = true; C.local = 1; C.vcu = (int)(w & 255u); cvb = (C.vcu & 31) * 8 + (C.vcu >> 5); }
#ifdef STAGGER_TICKS
        if (local && C.vcu >= 128) { const unsigned long long t0_ = __builtin_amdgcn_s_memrealtime(); while (__builtin_amdgcn_s_memrealtime() - t0_ < (unsigned long long)(STAGGER_TICKS)) __builtin_amdgcn_s_sleep(8); }
#endif
    }
    if (IN(0)) {
        const bool do_late = !local || C.vcu >= 128;
        if (do_late) p0_prologue(C, args.in, ws, 1, local ? C.vcu - 128 : C.vcu, local ? 128 : C.G);
        if (local) { if (do_late) { asm volatile("s_waitcnt vmcnt(0)" ::: "memory"); __syncthreads();
                         if (C.tid == 0) { __builtin_amdgcn_fence(__ATOMIC_RELEASE, "agent"); asm volatile("s_waitcnt vmcnt(0)" ::: "memory"); (void)xb_add((unsigned*)ctl + CW_LATE, 1u); } } }
        else if (IN(1) && hi - lo > 1) xcd_barrier(bar);
    }
    float* C0 = (float*)(ws + WS_C0); float* D0 = (float*)(ws + WS_D0);
#define CNT_PUBLISH(W) do { asm volatile("s_waitcnt vmcnt(0)" ::: "memory"); __syncthreads(); \
        if (C.tid == 0) { __builtin_amdgcn_fence(__ATOMIC_RELEASE, "agent"); asm volatile("s_waitcnt vmcnt(0)" ::: "memory"); (void)xb_add((unsigned*)ctl + (W), 1u); } } while (0)
#define CNT_WAIT(W, N) do { if (C.tid == 0) { XB_SPIN(xb_ld((unsigned*)ctl + (W)) < (unsigned)(N), bar.bar); __builtin_amdgcn_fence(__ATOMIC_ACQUIRE, "agent"); asm volatile("s_waitcnt vmcnt(0)" ::: "memory"); } \
        __syncthreads(); } while (0)
    if (IN(0) && (!local || C.vcu < 128)) {
        for (int w = C.vcu; w < 192; w += local ? 128 : C.G) gemv4_phase(C, args.in[6], 3 * DM, 3 * DM, mod, MODW, C0, 3 * DM, w);
        CNT_PUBLISH(CW_C0); }
#define PSEAM(k) do { if (IN(k) && IN((k) + 1)) { if (local) xcd_pair_barrier(bar, (unsigned*)ctl + CW_PAIR + 128 * (C.vcu >> 6)); else xcd_barrier(bar); } } while (0)
#define LSEAM(k) do { if (IN(k) && IN((k) + 1)) { if (local) xcd_local_barrier(bar); else xcd_barrier(bar); } } while (0)
    if (IN(1)) for (int rep = 0; rep <= REP(1); ++rep) { if (rep) xcd_barrier(bar); modulate_phase<false, false, false, true, true>(C, x, args.in[4], mod, 0, DM, HB, nullptr, 0, nullptr, 0, XR); } LSEAM(1);
    if (IN(0) && IN(2)) CNT_WAIT(CW_C0, local ? 128 : C.G);
    if (IN(2)) for (int rep = 0; rep <= REP(2); ++rep) { if (rep) xcd_barrier(bar); pg8::Gemm g{HB, (const bf16*)(ws + WS_WQKV), M, 3 * DM, DM / 2, F8_XS - 4 * MiB, 122, 127};     pg8::StaticOrder S; S.init(M, 3 * DM, C.G, cvb, KN_WGM_QKV);
        pg8::EpiQKV E{QB, KB, VB, args.in[8], args.in[9], (LAS float*)(C.lds + EPI_OFF), QSCALE, kmean, VXTRA, C0};
        pg8::gemm_phase<pg8::EpiQKV, pg8::StaticOrder, true, KN_SP2, true>(ring, g, S, E); } PSEAM(2);
    if (IN(0) && IN(3) && (C.vcu & 3) == 0) { gemv4_phase(C, args.in[7], DM, DM, C0 + 2 * DM, 3 * DM, D0, DM, C.vcu >> 2); CNT_PUBLISH(CW_D0); }
    if (IN(3)) for (int rep = 0; rep <= REP(3); ++rep) { if (rep) xcd_barrier(bar); route_phase(C, QB, kmean, lists, ctl + CW_LCNT); } PSEAM(3);
    if (IN(4)) for (int rep = 0; rep <= REP(4); ++rep) { if (rep) xcd_barrier(bar); moba::attn_phase(C, QB, KB, VB, lists, (const unsigned*)(ws + WS_CTL) + CW_LCNT, ctl + CW_QCTR + 64 * rep, POa, POb, LSE, args.in[8], args.in[9], rep ? ATTN_ABL : 0); } PSEAM(4);
    if (IN(5)) for (int rep = 0; rep <= REP(5); ++rep) { if (rep) xcd_barrier(bar); combine_phase(C, POa, POb, LSE, HB); }
#ifdef ATTN_SELFCHECK
    xcd_barrier(bar); check_phase(C, QB, KB, VB, kmean, HB, ctl + 256, ctl + 320);
#endif
    LSEAM(5);
    if (local && IN(0) && IN(6)) {
        if (C.tid == 0) { XB_SPIN(xb_ld((unsigned*)ctl + CW_LATE) < 128u, bar.bar); __builtin_amdgcn_fence(__ATOMIC_ACQUIRE, "agent"); asm volatile("s_waitcnt vmcnt(0)" ::: "memory"); }
        __syncthreads(); }
    if (IN(6)) for (int rep = 0; rep <= REP(6); ++rep) { if (rep) xcd_barrier(bar); pg8::Gemm g{HB, (const bf16*)(ws + WS_WO), M, DM, DM / 2, F8_XS - 4 * MiB, 122, 123};     pg8::StaticOrder S; S.init(M, DM, C.G, cvb, KN_WGM_RES);
        pg8::EpiPlain8 E{(unsigned char*)YB, F8_XS - 4 * MiB};
        pg8::gemm_phase<pg8::EpiPlain8, pg8::StaticOrder, KN_ALIGN_RES, KN_SP2, true>(ring, g, S, E); } LSEAM(6);
    if (IN(0) && IN(7)) CNT_WAIT(CW_D0, C.G / 4);
    if (IN(7)) for (int rep = 0; rep <= REP(7); ++rep) { if (rep) xcd_barrier(bar); modulate_phase<true, true, false, false, false, true, true>(C, XR, args.in[5], mod, 3 * DM, 4 * DM, HB, YB, 2 * DM, nullptr, 0, nullptr, D0); } LSEAM(7);
    if (IN(8)) for (int rep = 0; rep <= REP(8); ++rep) { if (rep) xcd_barrier(bar); pg8::Gemm g{HB, (const bf16*)(ws + WS_WGU0), M, 2 * FF, DM}; pg8::StaticOrder S; S.init(M, 2 * FF, C.G, cvb, KN_WGM_GU);
        pg8::EpiSwiglu E{ACT, FF, AXTRA};
        pg8::gemm_phase<pg8::EpiSwiglu, pg8::StaticOrder, KN_ALIGN_FFN, KN_SP2>(ring, g, S, E); } LSEAM(8);
    if (IN(9)) for (int rep = 0; rep <= REP(9); ++rep) { if (rep) xcd_barrier(bar); pg8::Gemm g{ACT, (const bf16*)(ws + WS_WDN0), M, DM, FF, AXTRA * 2}; pg8::StaticOrder S; S.init(M, DM, C.G, cvb, KN_WGM_RES);
        pg8::EpiPlain E{FB};
        pg8::gemm_phase<pg8::EpiPlain, pg8::StaticOrder, KN_ALIGN_RES, KN_SP2>(ring, g, S, E); } LSEAM(9);
    const float* mod1 = mod + 4 * MODW;
    if (IN(10)) for (int rep = 0; rep <= REP(10); ++rep) { if (rep) xcd_barrier(bar); modulate_phase<true, true, true, true, false, true, true>(C, XR, args.in[4] + DM, mod, 4 * MODW, 4 * MODW + DM, HB, YB, 2 * DM, FB, 5 * DM, XR, D0); } LSEAM(10);
    if (IN(11)) for (int rep = 0; rep <= REP(11); ++rep) { if (rep) xcd_barrier(bar); pg8::Gemm g{HB, (const bf16*)(ws + WS_WIN), M, 3 * DM, DM}; pg8::StaticOrder S; S.init(M, 3 * DM, C.G, cvb, KN_WGM_QKV);
        pg8::EpiConvIn E{BG, UU};
        pg8::gemm_phase<pg8::EpiConvIn, pg8::StaticOrder, KN_ALIGN_FFN, KN_SP2>(ring, g, S, E); } PSEAM(11);
    if (IN(12)) for (int rep = 0; rep <= REP(12); ++rep) { if (rep) xcd_barrier(bar); conv_phase(C, BG, UU, args.in[11], ZB); } LSEAM(12);
    if (IN(13)) for (int rep = 0; rep <= REP(13); ++rep) { if (rep) xcd_barrier(bar); pg8::Gemm g{ZB, (const bf16*)(ws + WS_WOUT), M, DM, DM}; pg8::StaticOrder S; S.init(M, DM, C.G, cvb, KN_WGM_RES);
        pg8::EpiPlain E{YB};
        pg8::gemm_phase<pg8::EpiPlain, pg8::StaticOrder, KN_ALIGN_RES, KN_SP2>(ring, g, S, E); } LSEAM(13);
    if (IN(14)) for (int rep = 0; rep <= REP(14); ++rep) { if (rep) xcd_barrier(bar); modulate_phase<true, true, false, false>(C, XR, args.in[5] + DM, mod1, 3 * DM, 4 * DM, HB, YB, 2 * DM); } LSEAM(14);
    if (IN(15)) for (int rep = 0; rep <= REP(15); ++rep) { if (rep) xcd_barrier(bar); pg8::Gemm g{HB, (const bf16*)(ws + WS_WGU1), M, 2 * FF, DM}; pg8::StaticOrder S; S.init(M, 2 * FF, C.G, cvb, KN_WGM_GU);
        pg8::EpiSwiglu8 E{(unsigned char*)ACT, FF, XCHUNK - 4096 * (size_t)FF};
        pg8::gemm_phase<pg8::EpiSwiglu8, pg8::StaticOrder, KN_ALIGN_FFN, KN_SP2>(ring, g, S, E); } LSEAM(15);
    if (IN(16)) for (int rep = 0; rep <= REP(16); ++rep) { if (rep) xcd_barrier(bar); pg8::Gemm g{ACT, (const bf16*)(ws + WS_WDN1), M, DM, FF / 2, XCHUNK - 4096 * (size_t)FF, 122, 127};     pg8::StaticOrder S; S.init(M, DM, C.G, cvb, KN_WGM_RES);
        pg8::EpiResid E{XR, out, mod1 + 5 * DM, YB, mod1 + 2 * DM};
        pg8::gemm_phase<pg8::EpiResid, pg8::StaticOrder, KN_ALIGN_RES, KN_SP2, true>(ring, g, S, E); }
#ifdef ATTN_SELFCHECK
    xcd_barrier(bar);
    if (blockIdx.x == 0 && C.tid == 0) { const unsigned nbad = __hip_atomic_load(ctl + 256, __ATOMIC_RELAXED, __HIP_MEMORY_SCOPE_AGENT), nskip = __hip_atomic_load(ctl + 320, __ATOMIC_RELAXED, __HIP_MEMORY_SCOPE_AGENT);
        out[0] += 1.0f * (float)nbad; out[1] += 0.125f + 0.001f * (float)nskip; }
#endif
#ifdef ATTN_PROBE
    xcd_barrier(bar);
    if (blockIdx.x == 0 && C.tid == 0) { const unsigned long long* pc = (const unsigned long long*)((const unsigned*)(ctl + CW_QCTR) + 512);
        const double v0 = (double)pc[0] / (double)pc[1], v1 = 100.0 * (double)pc[0] / (double)pc[6], v2 = (double)pc[2] / (double)pc[3], v3 = (double)pc[4] / (double)pc[5], v4 = (double)pc[6] / (double)pc[7], v5 = (double)pc[1] / (double)pc[7];
        const double sel[10] = {v0, v1, v2, v3, v4, v5, (double)pc[8] / (double)pc[3], (double)pc[9] / (double)pc[3], (double)pc[10] / (double)pc[3], (double)pc[3] / (double)pc[7]};
        out[0] += exp2f(rintf(log2f((float)sel[ATTN_PROBE]) * 3.0f) * (1.0f / 3.0f)); }
#endif
#ifdef EXTRA_BARRIERS
    for (int i_ = 0; i_ < EXTRA_BARRIERS; ++i_) xcd_barrier(bar);
#endif
#undef IN
#undef SEAM
}

#ifndef MK_N_LAUNCHES
#define MK_N_LAUNCHES 1
#endif
extern "C" void kernel_launch(void* const* d_in, const int* in_sizes, int n_in, void* d_out, int out_size, void* d_ws, size_t ws_size, hipStream_t stream) {
    static int grid = 0;
    if (grid == 0) {
        if (n_in != 15 || in_sizes[0] != M * DM || out_size != M * DM || ws_size < WS_END) {
            fprintf(stderr, "kernel_launch: built for 15 inputs, x/out of %d floats, >= %zu bytes of workspace; got n_in %d, in0 %d, out %d, ws %zu; nothing launched\n", M * DM, (size_t)WS_END, n_in, n_in > 0 ? in_sizes[0] : -1, out_size, ws_size);
            grid = -1; return; }
        int dev = 0, cus = 0, per_cu = 0;
        if (hipGetDevice(&dev) != hipSuccess || hipDeviceGetAttribute(&cus, hipDeviceAttributeMultiprocessorCount, dev) != hipSuccess) { fprintf(stderr, "kernel_launch: device query failed\n"); grid = -1; return; }
        if (hipFuncSetAttribute((const void*)moba_fwd, hipFuncAttributeMaxDynamicSharedMemorySize, LDS_BYTES) != hipSuccess) { fprintf(stderr, "kernel_launch: hipFuncSetAttribute failed\n"); grid = -1; return; }
        if (hipOccupancyMaxActiveBlocksPerMultiprocessor(&per_cu, (const void*)moba_fwd, NT, LDS_BYTES) != hipSuccess || per_cu < 1) { fprintf(stderr, "kernel_launch: occupancy query reports %d workgroups per CU\n", per_cu); per_cu = 1; }
        (void)hipGetLastError();
        grid = cus;
    }
    if (grid < 0) return;
    if (hipMemsetAsync((char*)d_ws + WS_CTL, 0, CTL_ZERO_BYTES, stream) != hipSuccess) { fprintf(stderr, "kernel_launch: memset failed\n"); return; }
    Args a{};
    for (int i = 0; i < 15; ++i) a.in[i] = (const float*)d_in[i];
    a.out = (float*)d_out; a.ws = (unsigned char*)d_ws;
    if (MK_N_LAUNCHES == 1) {
        a.ph_lo = 0; a.ph_hi = N_PHASES;
        hipLaunchKernelGGL(moba_fwd, dim3(grid), dim3(NT), LDS_BYTES, stream, a);
    } else {
        for (int p = 0; p < N_PHASES; ++p) { a.ph_lo = p; a.ph_hi = p + 1; hipLaunchKernelGGL(moba_fwd, dim3(grid), dim3(NT), LDS_BYTES, stream, a); }
    }
    const hipError_t le = hipPeekAtLastError();
    if (le != hipSuccess) fprintf(stderr, "kernel_launch: launch failed: %s\n", hipGetErrorName(le));
}
```

```cpp
#include <hip/hip_runtime.h>
#include <cstdio>
#include <cstdint>
#ifndef KN_WGM
#define KN_WGM 8
#endif
namespace pg8 {
#define PG8_LAS __attribute__((address_space(3)))
typedef unsigned short bf16_t;
typedef short bf16x8 __attribute__((ext_vector_type(8)));
typedef float f32x4 __attribute__((ext_vector_type(4)));
typedef unsigned u32x4 __attribute__((ext_vector_type(4)));
constexpr int BM = 256, BK = 64, HALF = 128, HTB = HALF * BK * 2  , STAGE_BYTES = 8 * HTB, NXCD = 8, WGM = KN_WGM;

__host__ __device__ __forceinline__ int lds_byte(int r, int c) { const int st = (r >> 4) * 2 + (c >> 5), rr = r & 15, cc = c & 31, ob = rr * 64 + cc * 2; return st * 1024 + (ob ^ (((ob >> 9) & 1) << 5)); }
__host__ __device__ __forceinline__ void stage_rc(int b, int& R, int& C) { const int st = b / 1024, sb = b % 1024, swz = sb ^ (((sb >> 9) & 1) << 5); R = (st >> 1) * 16 + swz / 64; C = (st & 1) * 32 + (swz % 64) / 2; }
__host__ __device__ __forceinline__ int perm32(int rho) { const int n = rho >> 4, i = rho & 15; return 8 * (i >> 2) + 4 * n + (i & 3); }

struct Unit { int pm, pn; };
struct Gemm { const bf16_t* A; const bf16_t* Bt; int M, N, K; size_t axtra = 0; int sa = 127, sb = 127; };

struct StaticOrder {
    int nM, nN, nwg, G, c, wgm;
    __host__ __device__ void init(int M, int N, int G_, int c_, int wgm_ = WGM) { nM = M / BM; nN = N / BM; nwg = nM * nN; G = G_; c = c_; wgm = wgm_; }
    __host__ __device__ bool next(int i, Unit& u) const {
        const long L = (long)i * G + c; if (L >= nwg) return false;
        int wgid = (int)L; { const int q = nwg / NXCD, r = nwg % NXCD, xcd = wgid % NXCD, off = wgid / NXCD; wgid = (xcd < r ? xcd * (q + 1) : r * (q + 1) + (xcd - r) * q) + off; }
        const int nig = wgm * nN, gid = wgid / nig, fm = gid * wgm, gsz = (nM - fm) < wgm ? (nM - fm) : wgm;
        u.pm = fm + ((wgid % nig) % gsz); u.pn = (wgid % nig) / gsz; return true;
    }
    __device__ __forceinline__ void a_ready(const Unit&) const {}
    __device__ __forceinline__ void done(const Unit&) const {}
};

__device__ __forceinline__ unsigned cvt_pk_bf16(float lo, float hi) { unsigned r; asm volatile("v_cvt_pk_bf16_f32 %0, %1, %2" : "=v"(r) : "v"(lo), "v"(hi)); return r; }
typedef float f32x2 __attribute__((ext_vector_type(2)));
__device__ __forceinline__ float silu_f(float x) { return x * __builtin_amdgcn_rcpf(1.0f + __builtin_amdgcn_exp2f(-1.4426950408889634f * x)); }
__device__ __forceinline__ u32x4 pack8(const f32x4 a, const f32x4 b) { u32x4 w; w.x = cvt_pk_bf16(a[0], a[1]); w.y = cvt_pk_bf16(a[2], a[3]); w.z = cvt_pk_bf16(b[0], b[1]); w.w = cvt_pk_bf16(b[2], b[3]); return w; }

struct EpiResid {
    static constexpr bool PERM = true, AFTER_DRAIN = false;
    const bf16_t* base; float* out; const float* gate; const bf16_t* Y; const float* gate2;
    __device__ __forceinline__ void operator()(const f32x4 (&acc)[2][2][4][2], const Unit& u, int wr, int wc, int fr, int fq) const {
        asm volatile("" : "+v"(fr), "+v"(fq));
        const int b = u.pm >> 5, col0 = u.pn * BM + wc * 32 + 8 * fq;
        const float* gp = gate + (size_t)b * 6144 + col0; const float* gp2 = gate2 + (size_t)b * 6144 + col0;
        f32x4 gv[2][2], g2[2][2];
#pragma unroll
        for (int bj = 0; bj < 2; ++bj)
#pragma unroll
            for (int n = 0; n < 2; ++n) { gv[bj][n] = *(const f32x4*)(gp + bj * HALF + 4 * n); g2[bj][n] = *(const f32x4*)(gp2 + bj * HALF + 4 * n); }
#pragma unroll
        for (int ai = 0; ai < 2; ++ai)
#pragma unroll
            for (int mh = 0; mh < 2; ++mh) {
                u32x4 bs[2][2], yv[2][2];
#pragma unroll
                for (int mm = 0; mm < 2; ++mm) { const size_t off = (size_t)(u.pm * BM + ai * HALF + wr * 64 + (2 * mh + mm) * 16 + fr) * 1024 + col0;
#pragma unroll
                    for (int bj = 0; bj < 2; ++bj) { bs[mm][bj] = *(const u32x4*)(base + off + bj * HALF); yv[mm][bj] = *(const u32x4*)(Y + off + bj * HALF); } }
#pragma unroll
                for (int mm = 0; mm < 2; ++mm) { const int m = 2 * mh + mm; const size_t off = (size_t)(u.pm * BM + ai * HALF + wr * 64 + m * 16 + fr) * 1024 + col0;
#pragma unroll
                    for (int bj = 0; bj < 2; ++bj) { const u32x4 y = yv[mm][bj], xw = bs[mm][bj];
                        const f32x4 x0 = (f32x4){__uint_as_float(xw.x << 16), __uint_as_float(xw.x & 0xffff0000u), __uint_as_float(xw.y << 16), __uint_as_float(xw.y & 0xffff0000u)};
                        const f32x4 x1 = (f32x4){__uint_as_float(xw.z << 16), __uint_as_float(xw.z & 0xffff0000u), __uint_as_float(xw.w << 16), __uint_as_float(xw.w & 0xffff0000u)};
                        const f32x4 y0 = (f32x4){__uint_as_float(y.x << 16), __uint_as_float(y.x & 0xffff0000u), __uint_as_float(y.y << 16), __uint_as_float(y.y & 0xffff0000u)};
                        const f32x4 y1 = (f32x4){__uint_as_float(y.z << 16), __uint_as_float(y.z & 0xffff0000u), __uint_as_float(y.w << 16), __uint_as_float(y.w & 0xffff0000u)};
                        *(f32x4*)(out + off + bj * HALF) = x0 + g2[bj][0] * y0 + gv[bj][0] * acc[ai][bj][m][0];
                        *(f32x4*)(out + off + bj * HALF + 4) = x1 + g2[bj][1] * y1 + gv[bj][1] * acc[ai][bj][m][1]; } }
                asm volatile("" ::: "memory");
            }
    }
};
struct EpiResidX2 {
    static constexpr bool PERM = true, AFTER_DRAIN = false;
    bf16_t* X; const float* gate; const unsigned char* Y8; size_t yxtra; const float* gate2; const float* d0;
    __device__ __forceinline__ void operator()(const f32x4 (&acc)[2][2][4][2], const Unit& u, int wr, int wc, int fr, int fq) const {
        asm volatile("" : "+v"(fr), "+v"(fq));
        const int b = u.pm >> 5, col0 = u.pn * BM + wc * 32 + 8 * fq;
#pragma unroll
        for (int bj = 0; bj < 2; ++bj) {
            const float* gp = gate + (size_t)b * 6144 + col0 + bj * HALF; const float* gp2 = gate2 + (size_t)b * 6144 + col0 + bj * HALF; const float* dp = d0 + (size_t)b * 1024 + col0 + bj * HALF;
            const f32x4 gv0 = *(const f32x4*)gp, gv1 = *(const f32x4*)(gp + 4), gm0 = *(const f32x4*)gp2, gm1 = *(const f32x4*)(gp2 + 4);
            const f32x4 dd0 = gm0 * *(const f32x4*)dp, dd1 = gm1 * *(const f32x4*)(dp + 4), g20 = gm0 * 0.0625f, g21 = gm1 * 0.0625f;
#pragma unroll
            for (int ai = 0; ai < 2; ++ai)
#pragma unroll
                for (int mh = 0; mh < 2; ++mh) {
                    u32x4 bs[2]; unsigned long long yv[2];
#pragma unroll
                    for (int mm = 0; mm < 2; ++mm) { const int row = u.pm * BM + ai * HALF + wr * 64 + (2 * mh + mm) * 16 + fr;
                        bs[mm] = *(const u32x4*)(X + (size_t)row * 1024 + col0 + bj * HALF);
                        yv[mm] = *(const unsigned long long*)(Y8 + (size_t)(u.pm >> 4) * yxtra + (size_t)row * 1024 + col0 + bj * HALF); }
#pragma unroll
                    for (int mm = 0; mm < 2; ++mm) { const int m = 2 * mh + mm; const int row = u.pm * BM + ai * HALF + wr * 64 + m * 16 + fr;
                        const u32x4 xw = bs[mm]; const unsigned ya = (unsigned)yv[mm], yb = (unsigned)(yv[mm] >> 32);
                        const f32x4 x0 = (f32x4){__uint_as_float(xw.x << 16), __uint_as_float(xw.x & 0xffff0000u), __uint_as_float(xw.y << 16), __uint_as_float(xw.y & 0xffff0000u)};
                        const f32x4 x1 = (f32x4){__uint_as_float(xw.z << 16), __uint_as_float(xw.z & 0xffff0000u), __uint_as_float(xw.w << 16), __uint_as_float(xw.w & 0xffff0000u)};
                        const f32x4 y0 = (f32x4){__builtin_amdgcn_cvt_f32_fp8(ya, 0), __builtin_amdgcn_cvt_f32_fp8(ya, 1), __builtin_amdgcn_cvt_f32_fp8(ya, 2), __builtin_amdgcn_cvt_f32_fp8(ya, 3)};
                        const f32x4 y1 = (f32x4){__builtin_amdgcn_cvt_f32_fp8(yb, 0), __builtin_amdgcn_cvt_f32_fp8(yb, 1), __builtin_amdgcn_cvt_f32_fp8(yb, 2), __builtin_amdgcn_cvt_f32_fp8(yb, 3)};
                        *(u32x4*)(X + (size_t)row * 1024 + col0 + bj * HALF) = pack8(x0 + g20 * y0 + dd0 + gv0 * acc[ai][bj][m][0], x1 + g21 * y1 + dd1 + gv1 * acc[ai][bj][m][1]); }
                    asm volatile("" ::: "memory");
                }
        }
    }
};
struct EpiPlain {
    static constexpr bool PERM = true, AFTER_DRAIN = false;
    bf16_t* O;
    __device__ __forceinline__ void operator()(const f32x4 (&acc)[2][2][4][2], const Unit& u, int wr, int wc, int fr, int fq) const {
        asm volatile("" : "+v"(fr), "+v"(fq));
        const int row0 = u.pm * BM + wr * 64 + fr, col0 = u.pn * BM + wc * 32 + 8 * fq;
#pragma unroll
        for (int ai = 0; ai < 2; ++ai)
#pragma unroll
            for (int m = 0; m < 4; ++m) { bf16_t* rowp = O + (size_t)(row0 + ai * HALF + m * 16) * 1024 + col0;
#pragma unroll
                for (int bj = 0; bj < 2; ++bj) *(u32x4*)(rowp + bj * HALF) = pack8(acc[ai][bj][m][0], acc[ai][bj][m][1]); }
    }
};

struct EpiPlain8 {
    static constexpr bool PERM = true, AFTER_DRAIN = false;
    unsigned char* O; size_t xtra;
    __device__ __forceinline__ void operator()(const f32x4 (&acc)[2][2][4][2], const Unit& u, int wr, int wc, int fr, int fq) const {
        asm volatile("" : "+v"(fr), "+v"(fq));
        const int row0 = u.pm * BM + wr * 64 + fr, col0 = u.pn * BM + wc * 32 + 8 * fq;
#pragma unroll
        for (int ai = 0; ai < 2; ++ai)
#pragma unroll
            for (int m = 0; m < 4; ++m) { unsigned char* rowp = O + (size_t)(u.pm >> 4) * xtra + (size_t)(row0 + ai * HALF + m * 16) * 1024 + col0;
#pragma unroll
                for (int bj = 0; bj < 2; ++bj) { const f32x4 a = acc[ai][bj][m][0] * 16.0f, b = acc[ai][bj][m][1] * 16.0f; unsigned w0 = 0u, w1 = 0u;
                    w0 = __builtin_amdgcn_cvt_pk_fp8_f32(a[0], a[1], w0, false); w0 = __builtin_amdgcn_cvt_pk_fp8_f32(a[2], a[3], w0, true);
                    w1 = __builtin_amdgcn_cvt_pk_fp8_f32(b[0], b[1], w1, false); w1 = __builtin_amdgcn_cvt_pk_fp8_f32(b[2], b[3], w1, true);
                    *(unsigned long long*)(rowp + bj * HALF) = (unsigned long long)w0 | ((unsigned long long)w1 << 32); } }
    }
};

struct EpiSwiglu {
    static constexpr bool PERM = true, AFTER_DRAIN = false;
    bf16_t* O; int ldc; size_t xtra;
    __device__ __forceinline__ void operator()(const f32x4 (&acc)[2][2][4][2], const Unit& u, int wr, int wc, int fr, int fq) const {
        asm volatile("" : "+v"(fr), "+v"(fq));
        const int row0 = u.pm * BM + wr * 64 + fr, col0 = u.pn * HALF + wc * 32 + 8 * fq;
#pragma unroll
        for (int ai = 0; ai < 2; ++ai)
#pragma unroll
            for (int m = 0; m < 4; ++m) { bf16_t* rowp = O + (size_t)(u.pm >> 4) * xtra + (size_t)(row0 + ai * HALF + m * 16) * ldc + col0;
                f32x4 r0, r1;
#pragma unroll
                for (int e = 0; e < 4; ++e) { r0[e] = silu_f(acc[ai][0][m][0][e]) * acc[ai][1][m][0][e]; r1[e] = silu_f(acc[ai][0][m][1][e]) * acc[ai][1][m][1][e]; }
                *(u32x4*)rowp = pack8(r0, r1); }
    }
};

struct EpiSwiglu8 {
    static constexpr bool PERM = true, AFTER_DRAIN = false;
    unsigned char* O; int ldc; size_t xtra;
    __device__ __forceinline__ void operator()(const f32x4 (&acc)[2][2][4][2], const Unit& u, int wr, int wc, int fr, int fq) const {
        asm volatile("" : "+v"(fr), "+v"(fq));
        const int row0 = u.pm * BM + wr * 64 + fr, col0 = u.pn * HALF + wc * 32 + 8 * fq;
#pragma unroll
        for (int ai = 0; ai < 2; ++ai)
#pragma unroll
            for (int m = 0; m < 4; ++m) { unsigned char* rowp = O + (size_t)(u.pm >> 4) * xtra + (size_t)(row0 + ai * HALF + m * 16) * ldc + col0;
                f32x4 r0, r1;
#pragma unroll
                for (int e = 0; e < 4; ++e) { r0[e] = silu_f(acc[ai][0][m][0][e]) * acc[ai][1][m][0][e]; r1[e] = silu_f(acc[ai][0][m][1][e]) * acc[ai][1][m][1][e]; }
                unsigned w0 = 0u, w1 = 0u; w0 = __builtin_amdgcn_cvt_pk_fp8_f32(r0[0], r0[1], w0, false); w0 = __builtin_amdgcn_cvt_pk_fp8_f32(r0[2], r0[3], w0, true);
                w1 = __builtin_amdgcn_cvt_pk_fp8_f32(r1[0], r1[1], w1, false); w1 = __builtin_amdgcn_cvt_pk_fp8_f32(r1[2], r1[3], w1, true);
                *(unsigned long long*)rowp = (unsigned long long)w0 | ((unsigned long long)w1 << 32); }
    }
};

struct EpiConvIn {
    static constexpr bool PERM = true, AFTER_DRAIN = false;
    bf16_t* BG; bf16_t* UU;
    __device__ __forceinline__ void operator()(const f32x4 (&acc)[2][2][4][2], const Unit& u, int wr, int wc, int fr, int fq) const {
        asm volatile("" : "+v"(fr), "+v"(fq));
        const int row0 = u.pm * BM + wr * 64 + fr;
        if (u.pn < 4) {
            const int col0 = u.pn * BM + wc * 32 + 8 * fq;
#pragma unroll
            for (int ai = 0; ai < 2; ++ai)
#pragma unroll
                for (int m = 0; m < 4; ++m) { bf16_t* rowp = BG + (size_t)(row0 + ai * HALF + m * 16) * 1024 + col0;
#pragma unroll
                    for (int bj = 0; bj < 2; ++bj) *(u32x4*)(rowp + bj * HALF) = pack8(acc[ai][bj][m][0], acc[ai][bj][m][1]); }
        } else {
            const int col0 = (u.pn - 4) * HALF + wc * 32 + 8 * fq;
#pragma unroll
            for (int ai = 0; ai < 2; ++ai)
#pragma unroll
                for (int m = 0; m < 4; ++m) { bf16_t* rowp = UU + (size_t)(row0 + ai * HALF + m * 16) * 1024 + col0;
                    *(u32x4*)rowp = pack8(acc[ai][0][m][0] * acc[ai][1][m][0], acc[ai][0][m][1] * acc[ai][1][m][1]); }
        }
    }
};

struct EpiQKV {
    static constexpr bool PERM = true, AFTER_DRAIN = false;
    bf16_t *Q, *K, *V; const float *qg, *kg; PG8_LAS float* ss; float qscale; float* kmean; size_t vxtra; const float* cvec;
    __device__ __forceinline__ void operator()(const f32x4 (&acc)[2][2][4][2], const Unit& u, int wr, int wc, int fr, int fq) const {
        asm volatile("" : "+v"(fr), "+v"(fq));
        const int t = u.pn >> 2, colt = (u.pn & 3) * BM;
        const int row0 = u.pm * BM + wr * 64 + fr, col0 = colt + wc * 32 + 8 * fq;
        if (t == 2) {
#pragma unroll
            for (int ai = 0; ai < 2; ++ai)
#pragma unroll
                for (int m = 0; m < 4; ++m) { bf16_t* rowp = V + (size_t)(u.pm >> 4) * vxtra + (size_t)(row0 + ai * HALF + m * 16) * 1024 + col0;
#pragma unroll
                    for (int bj = 0; bj < 2; ++bj) *(u32x4*)(rowp + bj * HALF) = pack8(acc[ai][bj][m][0], acc[ai][bj][m][1]); }
            return;
        }
        const float* cp = cvec + (size_t)(u.pm >> 5) * 3072 + u.pn * BM + wc * 32 + 8 * fq;
#pragma unroll
        for (int bj = 0; bj < 2; ++bj) { asm volatile("" : "+v"(cp)); const f32x4 cb0 = *(const f32x4*)(cp + bj * HALF), cb1 = *(const f32x4*)(cp + bj * HALF + 4);
#pragma unroll
            for (int ai = 0; ai < 2; ++ai)
#pragma unroll
                for (int m = 0; m < 4; ++m) { const f32x4 a = acc[ai][bj][m][0] + cb0, b = acc[ai][bj][m][1] + cb1;
                    float s = (a[0] * a[0] + a[1] * a[1]) + (a[2] * a[2] + a[3] * a[3]) + (b[0] * b[0] + b[1] * b[1]) + (b[2] * b[2] + b[3] * b[3]);
                    s += __shfl_xor(s, 16); s += __shfl_xor(s, 32);
                    if (fq == 0) ss[(ai * HALF + wr * 64 + m * 16 + fr) * 8 + bj * 4 + wc] = s; } }
        asm volatile("s_waitcnt lgkmcnt(0)" ::: "memory"); __builtin_amdgcn_s_barrier(); asm volatile("" ::: "memory");
        const float* gain = (t == 0) ? qg : kg; const float sc = (t == 0) ? qscale : 1.0f;
        const f32x4 g0 = *(const f32x4*)(gain + wc * 32 + 8 * fq) * sc, g1 = *(const f32x4*)(gain + wc * 32 + 8 * fq + 4) * sc;
        bf16_t* base = (t == 0) ? Q : K;
#pragma unroll
        for (int bj = 0; bj < 2; ++bj) { asm volatile("" : "+v"(cp)); const f32x4 cb0 = *(const f32x4*)(cp + bj * HALF), cb1 = *(const f32x4*)(cp + bj * HALF + 4);
#pragma unroll
            for (int ai = 0; ai < 2; ++ai)
#pragma unroll
                for (int m = 0; m < 4; ++m) { const int r = ai * HALF + wr * 64 + m * 16 + fr; bf16_t* rowp = base + (size_t)(u.pm * BM + r) * 1024 + col0;
                    const f32x4 p = *(const PG8_LAS f32x4*)(ss + r * 8 + bj * 4);
                    const float rstd = __builtin_amdgcn_rsqf(((p[0] + p[1]) + (p[2] + p[3])) * (1.0f / 128.0f) + 1e-6f);
                    const f32x4 v0 = (acc[ai][bj][m][0] + cb0) * rstd * g0, v1 = (acc[ai][bj][m][1] + cb1) * rstd * g1;
                    *(u32x4*)(rowp + bj * HALF) = pack8(v0, v1);
                    asm volatile("" ::: "memory"); } }
        if (t == 1) {
            PG8_LAS float* km = ss + 2048;
#pragma unroll
            for (int bj = 0; bj < 2; ++bj) { f32x4 c0 = (f32x4){0.f, 0.f, 0.f, 0.f}, c1 = c0; asm volatile("" : "+v"(cp)); const f32x4 cb0 = *(const f32x4*)(cp + bj * HALF), cb1 = *(const f32x4*)(cp + bj * HALF + 4);
#pragma unroll
                for (int ai = 0; ai < 2; ++ai)
#pragma unroll
                    for (int m = 0; m < 4; ++m) { const f32x4 p = *(const PG8_LAS f32x4*)(ss + (ai * HALF + wr * 64 + m * 16 + fr) * 8 + bj * 4);
                        const float rstd = __builtin_amdgcn_rsqf(((p[0] + p[1]) + (p[2] + p[3])) * (1.0f / 128.0f) + 1e-6f);
                        c0 += (acc[ai][bj][m][0] + cb0) * rstd; c1 += (acc[ai][bj][m][1] + cb1) * rstd; }
                c0 = c0 * g0; c1 = c1 * g1;
#pragma unroll
                for (int e = 0; e < 4; ++e) { float a = c0[e], b = c1[e];
                    a += __shfl_xor(a, 1); b += __shfl_xor(b, 1); a += __shfl_xor(a, 2); b += __shfl_xor(b, 2); a += __shfl_xor(a, 4); b += __shfl_xor(b, 4); a += __shfl_xor(a, 8); b += __shfl_xor(b, 8);
                    if (fr == 0) { km[wr * 256 + bj * HALF + wc * 32 + 8 * fq + e] = a; km[wr * 256 + bj * HALF + wc * 32 + 8 * fq + 4 + e] = b; } }
                asm volatile("" ::: "memory"); }
            asm volatile("s_waitcnt lgkmcnt(0)" ::: "memory"); __builtin_amdgcn_s_barrier(); asm volatile("" ::: "memory");
            const int tid = (wr * 4 + wc) * 64 + fq * 16 + fr;
            if (tid < 256) { const float v = (km[tid] + km[256 + tid]) * (1.0f / 256.0f);
                const int h = (u.pn & 3) * 2 + (tid >> 7), b = u.pm >> 5, blk = u.pm & 31;
                kmean[(size_t)((b * 8 + h) * 32 + blk) * 128 + (tid & 127)] = v; }
        }
    }
};

template <class Epi, class Sched, bool ALIGN_EPI = false, bool SP2 = false, bool F8 = false>
__device__ __forceinline__ void gemm_phase(PG8_LAS unsigned char* lds, const Gemm g, const Sched& S, const Epi& E) {
    const int tid = threadIdx.x, wid = __builtin_amdgcn_readfirstlane(tid >> 6), lane = tid & 63, wr = wid >> 2, wc = wid & 3, fr = lane & 15, fq = lane >> 4;
    const int K = g.K, nt = K / BK;
    unsigned voffA[2], voffB[2];
#pragma unroll
    for (int i = 0; i < 2; ++i) { int R, C; stage_rc(tid * 16 + i * 8192, R, C); const int Rb = Epi::PERM ? ((R & ~31) + perm32(R & 31)) : R;
        voffA[i] = (unsigned)(R * K + C) * 2u; voffB[i] = (unsigned)(Rb * K + C) * 2u; }
    const size_t kstep = (size_t)(BK * 2);
    const size_t hstep = (size_t)HALF * K * 2;
    const size_t tstep = 2 * hstep;
    const unsigned ldsw = (unsigned)wid * 1024u;
    const int aoff = lds_byte(wr * 64 + fr, fq * 8), boff = lds_byte(wc * 32 + fr, fq * 8);
#define PG8_SA(b, h) (((b) * 2 + (h)) * HTB)
#define PG8_SB(b, h) ((4 + (b) * 2 + (h)) * HTB)
#define PG8_STAGE(bufoff, gbase, voff) do { _Pragma("unroll") for (int _i = 0; _i < 2; ++_i) \
        __builtin_amdgcn_global_load_lds((const unsigned*)((const char*)(gbase) + (voff)[_i]), (PG8_LAS unsigned*)(lds + (bufoff) + ldsw + _i * 8192), 16, 0, 0); } while (0)
#define PG8_LD16(off) (*(const PG8_LAS i32x4_*)(lds + (off)))
#define PG8_LDA(dst, b, h) do { _Pragma("unroll") for (int m = 0; m < 4; ++m) { \
        if constexpr (F8) dst##8[m] = __builtin_shufflevector(PG8_LD16(PG8_SA(b, h) + aoff + m * 2048), PG8_LD16(PG8_SA(b, h) + aoff + m * 2048 + 1024), 0, 1, 2, 3, 4, 5, 6, 7); \
        else { _Pragma("unroll") for (int k = 0; k < 2; ++k) dst[m][k] = *(const PG8_LAS bf16x8*)(lds + PG8_SA(b, h) + aoff + m * 2048 + k * 1024); } } } while (0)
#define PG8_LDB(dst, b, h) do { _Pragma("unroll") for (int n = 0; n < 2; ++n) { \
        if constexpr (F8) dst##8[n] = __builtin_shufflevector(PG8_LD16(PG8_SB(b, h) + boff + n * 2048), PG8_LD16(PG8_SB(b, h) + boff + n * 2048 + 1024), 0, 1, 2, 3, 4, 5, 6, 7); \
        else { _Pragma("unroll") for (int k = 0; k < 2; ++k) dst[n][k] = *(const PG8_LAS bf16x8*)(lds + PG8_SB(b, h) + boff + n * 2048 + k * 1024); } } } while (0)
#define PG8_MMA(ai, bj, At, Bt) do { __builtin_amdgcn_s_setprio(1); _Pragma("unroll") for (int m = 0; m < 4; ++m) _Pragma("unroll") for (int n = 0; n < 2; ++n) { \
        if constexpr (F8) asm volatile("v_mfma_scale_f32_16x16x128_f8f6f4 %0, %1, %2, %0, %3, %4 op_sel_hi:[0,0,0]" : "+v"(acc[ai][bj][m][n]) : "v"(Bt##8[n]), "v"(At##8[m]), "v"(f8sa), "v"(f8sb)); \
        else { _Pragma("unroll") for (int k = 0; k < 2; ++k) acc[ai][bj][m][n] = __builtin_amdgcn_mfma_f32_16x16x32_bf16(Bt[n][k], At[m][k], acc[ai][bj][m][n], 0, 0, 0); } } \
        __builtin_amdgcn_s_setprio(0); } while (0)
#define PG8_WAIT_V(n) asm volatile("s_waitcnt vmcnt(" #n ")" ::: "memory")
#define PG8_WAIT_L(n) asm volatile("s_waitcnt lgkmcnt(" #n ")" ::: "memory")
#define PG8_BAR __builtin_amdgcn_s_barrier()
#define PG8_SCHED __builtin_amdgcn_sched_barrier(0)
    Unit cur, nxt; int ui = 0;
    if (!S.next(0, cur)) return;
    f32x4 acc[2][2][4][2];
#pragma unroll
    for (int a = 0; a < 2; ++a)
#pragma unroll
        for (int b = 0; b < 2; ++b)
#pragma unroll
            for (int m = 0; m < 4; ++m)
#pragma unroll
                for (int n = 0; n < 2; ++n) acc[a][b][m][n] = (f32x4){0.f, 0.f, 0.f, 0.f};
    bf16x8 At[4][2], B0[2][2], B1[2][2];
    typedef int i32x4_ __attribute__((ext_vector_type(4))); typedef int i32x8_ __attribute__((ext_vector_type(8)));
    const int f8sa = g.sa, f8sb = g.sb;
    i32x8_ At8[4], B08[2], B18[2];
    const char* cA = (const char*)g.A + (size_t)cur.pm * tstep + (size_t)(cur.pm >> 4) * g.axtra; const char* cB = (const char*)g.Bt + (size_t)cur.pn * tstep;
    S.a_ready(cur);
    if constexpr (SP2) {
        PG8_STAGE(PG8_SB(0, 0), cB, voffB); PG8_STAGE(PG8_SB(0, 1), cB + hstep, voffB); PG8_STAGE(PG8_SA(0, 0), cA, voffA); PG8_STAGE(PG8_SA(0, 1), cA + hstep, voffA);
        if (wr == 1) PG8_BAR;
        PG8_WAIT_V(2); PG8_BAR;
        PG8_STAGE(PG8_SB(1, 0), cB + kstep, voffB); PG8_STAGE(PG8_SA(1, 0), cA + kstep, voffA); PG8_STAGE(PG8_SB(1, 1), cB + hstep + kstep, voffB);
        PG8_WAIT_V(6); PG8_BAR;
    } else {
        PG8_STAGE(PG8_SB(0, 0), cB, voffB); PG8_STAGE(PG8_SA(0, 0), cA, voffA); PG8_STAGE(PG8_SB(0, 1), cB + hstep, voffB); PG8_STAGE(PG8_SA(0, 1), cA + hstep, voffA);
        if (wr == 1) PG8_BAR;
        PG8_WAIT_V(4); PG8_BAR;
        PG8_STAGE(PG8_SB(1, 0), cB + kstep, voffB); PG8_STAGE(PG8_SA(1, 0), cA + kstep, voffA); PG8_STAGE(PG8_SB(1, 1), cB + hstep + kstep, voffB);
        PG8_WAIT_V(6); PG8_BAR;
    }
    for (;;) {
        const bool has_next = S.next(ui + 1, nxt);
        const char* nA = has_next ? (const char*)g.A + (size_t)nxt.pm * tstep + (size_t)(nxt.pm >> 4) * g.axtra : cA; const char* nB = has_next ? (const char*)g.Bt + (size_t)nxt.pn * tstep : cB;
        for (int t = 0; t < nt; t += 2) {
            const bool last = (t == nt - 2);
            const char* a1 = cA + (size_t)(t + 1) * kstep;
            const char* a2 = last ? nA : cA + (size_t)(t + 2) * kstep; const char* b2 = last ? nB : cB + (size_t)(t + 2) * kstep;
            const char* a3 = a2 + kstep; const char* b3 = b2 + kstep;
            if (last && has_next) S.a_ready(nxt);
            if constexpr (SP2) {
            PG8_LDB(B0, 0, 0); PG8_LDB(B1, 0, 1); PG8_SCHED; PG8_LDA(At, 0, 0); PG8_STAGE(PG8_SA(1, 1), a1 + hstep, voffA);
            PG8_WAIT_V(8); PG8_WAIT_L(0); PG8_BAR; PG8_MMA(0, 0, At, B0); PG8_MMA(0, 1, At, B1); PG8_BAR; PG8_SCHED;
            PG8_LDA(At, 0, 1); PG8_STAGE(PG8_SB(0, 0), b2, voffB); PG8_STAGE(PG8_SB(0, 1), b2 + hstep, voffB); PG8_STAGE(PG8_SA(0, 0), a2, voffA);
            PG8_WAIT_V(8); PG8_WAIT_L(0); PG8_BAR; PG8_MMA(1, 0, At, B0); PG8_MMA(1, 1, At, B1); PG8_BAR; PG8_SCHED;
            PG8_LDB(B0, 1, 0); PG8_LDB(B1, 1, 1); PG8_SCHED; PG8_LDA(At, 1, 0); PG8_STAGE(PG8_SA(0, 1), a2 + hstep, voffA);
            PG8_WAIT_V(8); PG8_WAIT_L(0); PG8_BAR; PG8_MMA(0, 0, At, B0); PG8_MMA(0, 1, At, B1); PG8_BAR; PG8_SCHED;
            PG8_LDA(At, 1, 1); PG8_STAGE(PG8_SB(1, 0), b3, voffB); PG8_STAGE(PG8_SB(1, 1), b3 + hstep, voffB); PG8_STAGE(PG8_SA(1, 0), a3, voffA);
            PG8_WAIT_V(8); PG8_WAIT_L(0); PG8_BAR; PG8_MMA(1, 0, At, B0); PG8_MMA(1, 1, At, B1); PG8_BAR; PG8_SCHED;
            } else {
            PG8_LDB(B0, 0, 0); PG8_SCHED; PG8_LDA(At, 0, 0); PG8_STAGE(PG8_SA(1, 1), a1 + hstep, voffA);
            PG8_WAIT_L(8); PG8_BAR; PG8_WAIT_L(0); PG8_MMA(0, 0, At, B0); PG8_BAR; PG8_SCHED;
            PG8_LDB(B1, 0, 1); PG8_STAGE(PG8_SB(0, 0), b2, voffB);
            PG8_BAR; PG8_WAIT_L(0); PG8_MMA(0, 1, At, B1); PG8_BAR;
            PG8_LDA(At, 0, 1); PG8_STAGE(PG8_SA(0, 0), a2, voffA);
            PG8_BAR; PG8_WAIT_L(0); PG8_MMA(1, 0, At, B0); PG8_BAR; PG8_SCHED;
            PG8_STAGE(PG8_SB(0, 1), b2 + hstep, voffB);
            PG8_WAIT_V(6); PG8_BAR; PG8_MMA(1, 1, At, B1); PG8_BAR;
            PG8_LDB(B0, 1, 0); PG8_SCHED; PG8_LDA(At, 1, 0); PG8_STAGE(PG8_SA(0, 1), a2 + hstep, voffA);
            PG8_WAIT_L(8); PG8_BAR; PG8_WAIT_L(0); PG8_MMA(0, 0, At, B0); PG8_BAR; PG8_SCHED;
            PG8_LDB(B1, 1, 1); PG8_STAGE(PG8_SB(1, 0), b3, voffB);
            PG8_BAR; PG8_WAIT_L(0); PG8_MMA(0, 1, At, B1); PG8_BAR;
            PG8_LDA(At, 1, 1); PG8_STAGE(PG8_SA(1, 0), a3, voffA);
            PG8_BAR; PG8_WAIT_L(0); PG8_MMA(1, 0, At, B0); PG8_BAR; PG8_SCHED;
            PG8_STAGE(PG8_SB(1, 1), b3 + hstep, voffB);
            PG8_WAIT_V(6); PG8_BAR; PG8_MMA(1, 1, At, B1); PG8_BAR;
            }
        }
        if constexpr (ALIGN_EPI) { if (wr == 0) PG8_BAR; }
        if constexpr (F8) asm volatile("s_nop 15\n\ts_nop 15" ::: "memory");
        if constexpr (!Epi::AFTER_DRAIN) { E(acc, cur, wr, wc, fr, fq); S.done(cur); }
        if (!has_next) break;
#pragma unroll
        for (int a = 0; a < 2; ++a)
#pragma unroll
            for (int b = 0; b < 2; ++b)
#pragma unroll
                for (int m = 0; m < 4; ++m)
#pragma unroll
                    for (int n = 0; n < 2; ++n) acc[a][b][m][n] = (f32x4){0.f, 0.f, 0.f, 0.f};
        cur = nxt; cA = nA; cB = nB; ++ui;
        if constexpr (ALIGN_EPI) { if (wr == 1) PG8_BAR; }
    }
    PG8_WAIT_V(0);
    if constexpr (!ALIGN_EPI) { if (wr == 0) PG8_BAR; }
    PG8_BAR;
    if constexpr (Epi::AFTER_DRAIN) { E.fused(acc, cur, wr, wc, fr, fq, lds, wid, lane); S.done(cur); }
#undef PG8_SA
#undef PG8_SB
#undef PG8_STAGE
#undef PG8_LDA
#undef PG8_LDB
#undef PG8_MMA
#undef PG8_WAIT_V
#undef PG8_WAIT_L
#undef PG8_BAR
#undef PG8_SCHED
}
}
#define GAS __attribute__((address_space(1)))
#define LAS __attribute__((address_space(3)))
typedef unsigned short bf16;
typedef unsigned v4u __attribute__((ext_vector_type(4)));
typedef float f32x4 __attribute__((ext_vector_type(4)));
typedef short bf16x8 __attribute__((ext_vector_type(8)));
typedef GAS unsigned gu32;
typedef GAS unsigned long long gu64;
#define RLX_AGENT __ATOMIC_RELAXED, __HIP_MEMORY_SCOPE_AGENT
#define LDS_WAIT() asm volatile("s_waitcnt lgkmcnt(0)" ::: "memory")
#define VM_WAIT() asm volatile("s_waitcnt vmcnt(0)" ::: "memory")
__device__ __forceinline__ unsigned long long rt() { return __builtin_amdgcn_s_memrealtime(); }
__device__ __forceinline__ unsigned f2bf(float f) { unsigned u = __builtin_bit_cast(unsigned, f); return (u + 0x7fffu + ((u >> 16) & 1u)) >> 16; }
__device__ __forceinline__ unsigned pk2(float lo, float hi) { return f2bf(lo) | (f2bf(hi) << 16); }

#define XB_TMO      128
#define XB_XCNT(j)  (256  + 64 * (j))
#define XB_XSUB(j)  (1280 + 64 * (j))
#define XB_XGEN(j)  (2304 + 64 * (j))
#define XB_TOP      3328
#define XB_TOPGEN   3392
#define XCD_BAR_WORDS 3456
#define XB_SPIN_CAP (1u << 18)

__device__ __forceinline__ unsigned xb_ld(unsigned* p)              { return __hip_atomic_load(p, __ATOMIC_RELAXED, __HIP_MEMORY_SCOPE_AGENT); }
__device__ __forceinline__ unsigned xb_add(unsigned* p, unsigned v) { return __hip_atomic_fetch_add(p, v, __ATOMIC_RELAXED, __HIP_MEMORY_SCOPE_AGENT); }
__device__ __forceinline__ unsigned xb_xcc_id() { return (unsigned)__builtin_amdgcn_s_getreg((3 << 11) | 20) & 0xFu; }
#define XB_SPIN(cond, bar) do { unsigned _sp = 0; while (cond) { __builtin_amdgcn_s_sleep(1); \
    if ((++_sp & 255u) == 0u) { if (xb_ld(&(bar)[XB_TMO])) break; if (_sp > XB_SPIN_CAP) { atomicAdd(&(bar)[XB_TMO], 1u); break; } } } } while (0)

struct XcdBarrier {
    unsigned* bar; unsigned x;
    volatile LAS unsigned* st;
};

__device__ __forceinline__ XcdBarrier xcd_barrier_post(unsigned* bar, volatile LAS unsigned* st) {
    XcdBarrier b; b.bar = bar; b.x = xb_xcc_id(); b.st = st;
    if (threadIdx.x == 0) (void)xb_add(&bar[XB_XCNT(b.x)], 1u);
    return b;
}
__device__ __forceinline__ void xcd_barrier_complete(unsigned* bar, unsigned x, unsigned& nloc, unsigned& nx) {
    const unsigned G = gridDim.x * gridDim.y * gridDim.z;
    unsigned sum, cnt, mine, sp = 0u;
    for (;;) {
        sum = 0u; cnt = 0u; mine = 0u;
#pragma unroll
        for (unsigned j = 0; j < 16; ++j) { const unsigned c = xb_ld(&bar[XB_XCNT(j)]); sum += c; cnt += (c > 0u) ? 1u : 0u; mine = (j == x) ? c : mine; }
        if (sum == G) break;
        __builtin_amdgcn_s_sleep(1);
        if ((++sp & 255u) == 0u) { if (xb_ld(&bar[XB_TMO])) break; if (sp > XB_SPIN_CAP) { atomicAdd(&bar[XB_TMO], 1u); break; } }
    }
    nloc = mine > 0u ? mine : 1u; nx = cnt > 0u ? cnt : 1u;
}

__device__ __forceinline__ void xcd_barrier(const XcdBarrier& b) {
    asm volatile("s_waitcnt vmcnt(0)" ::: "memory");
    __syncthreads();
    if (threadIdx.x == 0) {
        unsigned* bar = b.bar;
        __builtin_amdgcn_s_waitcnt(0);
        unsigned nloc = b.st[0], nx = b.st[1];
        if (nloc == 0u) { xcd_barrier_complete(bar, b.x, nloc, nx); b.st[0] = nloc; b.st[1] = nx; }
        const unsigned old = xb_add(&bar[XB_XSUB(b.x)], 1u);
        const unsigned gen = old / nloc;
        if (old + 1u == (gen + 1u) * nloc) {
            __builtin_amdgcn_fence(__ATOMIC_RELEASE, "agent");
            asm volatile("s_waitcnt vmcnt(0)" ::: "memory");
            const unsigned og = xb_add(&bar[XB_TOP], 1u);
            const unsigned tg = og / nx;
            if (og + 1u == (tg + 1u) * nx) xb_add(&bar[XB_TOPGEN], 1u);
            else XB_SPIN(xb_ld(&bar[XB_TOPGEN]) == tg, bar);
            __builtin_amdgcn_fence(__ATOMIC_ACQUIRE, "agent");
            xb_add(&bar[XB_XGEN(b.x)], 1u);
            asm volatile("s_waitcnt vmcnt(0)" ::: "memory");
        } else {
            XB_SPIN(xb_ld(&bar[XB_XGEN(b.x)]) == gen, bar);
            __builtin_amdgcn_fence(__ATOMIC_ACQUIRE, "agent");
            asm volatile("s_waitcnt vmcnt(0)" ::: "memory");
        }
    }
    __syncthreads();
}

constexpr int NBATCH = 4, SEQ = 8192, DM = 1024, NH = 8, HD = 128, M = NBATCH * SEQ, FF = 2816, NBLK = 32;
constexpr int NWAVES = 8, NT = NWAVES * 64;
constexpr int MODW = 6 * DM;
constexpr float QSCALE = 0.08838834764831845f * 1.4426950408889634f;
constexpr int LCAP = 8192;

constexpr size_t MiB = 1u << 20;
constexpr size_t WS_CTL = 0, CTL_ZERO_BYTES = 64 * 1024;
constexpr size_t WS_MOD = 1 * MiB;
constexpr size_t WS_C0 = 1 * MiB + 256 * 1024, WS_D0 = 1 * MiB + 320 * 1024;
constexpr size_t WS_KMEAN = 1 * MiB + 512 * 1024;
constexpr size_t WS_WQKV = 2 * MiB, WS_WO = 8 * MiB, WS_WIN = 10 * MiB, WS_WOUT = 16 * MiB, WS_WGU0 = 18 * MiB, WS_WGU1 = 29 * MiB, WS_WDN0 = 40 * MiB, WS_WDN1 = 46 * MiB;
constexpr size_t WS_LSE = 52 * MiB;
constexpr size_t WS_XB = 56 * MiB;
constexpr size_t WS_H = 120 * MiB;
constexpr size_t WS_LIST = WS_H;
constexpr size_t WS_Z = WS_H;
constexpr size_t WS_Q = 184 * MiB;
constexpr size_t WS_YB = WS_Q, WS_BG = WS_Q;
constexpr size_t WS_K = 248 * MiB;
constexpr size_t WS_FB = WS_K, WS_UU = WS_K;
constexpr size_t WS_R = 312 * MiB, XCHUNK = 25 * MiB;
constexpr size_t WS_V = WS_R, WS_ACT = WS_R, WS_POB = WS_R + 8 * MiB;
constexpr size_t VXTRA = (XCHUNK - 8 * MiB) / 2, AXTRA = (XCHUNK - 22 * MiB) / 2;
constexpr size_t WS_END = 512 * MiB;
constexpr size_t F8_XS = 8 * MiB;
constexpr size_t PO_XS_A = 16 * MiB, PO_XS_B = XCHUNK, PO_SL = 8 * MiB;
__device__ __forceinline__ size_t po_off(int sl, int tok) { return (size_t)(tok >> 12) * (sl < 2 ? PO_XS_A : PO_XS_B) + (size_t)(sl & 1) * PO_SL + (size_t)(tok & 4095) * 1024; }
__device__ __forceinline__ size_t psc_off(int tok, int h) { return (size_t)(tok >> 12) * (16 * MiB / 4) + (4 * MiB / 4) + (size_t)((tok & 4095) * 8 + h) * 4; }
__device__ __forceinline__ size_t list_off(int bh, int j) { return (size_t)(bh >> 3) * (16 * MiB / 4) + (size_t)((bh & 7) * 32 + j) * 8192; }
constexpr int CW_QCTR = 64, CW_RANK = 2048, CW_PAIR = 3072, CW_LATE = 3584, CW_C0 = 3648, CW_D0 = 3712, CW_BAR = 4096, CW_LCNT = 8192;
static_assert((CW_LCNT + 1024) * 4 <= (int)CTL_ZERO_BYTES && CW_BAR + XCD_BAR_WORDS <= CW_LCNT, "CTL map");

constexpr int RING_BYTES = 131072, EPI_OFF = RING_BYTES, EPI_BYTES = 10240, MISC_OFF = EPI_OFF + EPI_BYTES, LDS_BYTES = 147456;

struct Ctx { LAS unsigned char* lds; volatile LAS unsigned* misc; int tid, lane, wave, vcu, G, local; };

__device__ __forceinline__ float wave_sum(float v) {
#pragma unroll
    for (int o = 1; o < 64; o <<= 1) v += __shfl_xor(v, o);
    return v;
}
__device__ __forceinline__ float bf_lo(unsigned u) { return __uint_as_float(u << 16); }
__device__ __forceinline__ float bf_hi(unsigned u) { return __uint_as_float(u & 0xffff0000u); }

__device__ __forceinline__ void transpose_item(const float* W, int K, int N, bf16* WT, int k0, int n0, int drow0, LAS float* scr, int lane) {
    float v[32];
#pragma unroll
    for (int i = 0; i < 32; ++i) { const int kk = 2 * i + (lane >> 5); v[i] = W[(size_t)(k0 + kk) * N + n0 + (lane & 31)]; }
#pragma unroll
    for (int i = 0; i < 32; ++i) { const int kk = 2 * i + (lane >> 5); scr[kk * 33 + (lane & 31)] = v[i]; }
    LDS_WAIT(); asm volatile("" ::: "memory");
    const int c = lane & 7;
#pragma unroll
    for (int j = 0; j < 4; ++j) { const int n = (lane >> 3) + 8 * j; const LAS float* s = scr + (8 * c) * 33 + n;
        v4u o; o.x = pk2(s[0 * 33], s[1 * 33]); o.y = pk2(s[2 * 33], s[3 * 33]); o.z = pk2(s[4 * 33], s[5 * 33]); o.w = pk2(s[6 * 33], s[7 * 33]);
        *(GAS v4u*)(WT + (size_t)(drow0 + n) * K + k0 + 8 * c) = o; }
    LDS_WAIT(); asm volatile("" ::: "memory");
}
__device__ __forceinline__ int pair_row(int n, int seg) { return 256 * (n >> 7) + 128 * seg + (n & 127); }

__device__ __forceinline__ void p0_prologue(const Ctx& C, const float* const* in, unsigned char* ws, int which, int wcu, int ncu) {
    LAS float* scr = (LAS float*)(C.lds + C.wave * 16384);
    if (which == 0) for (int mu = wcu; mu < 192; mu += ncu) {
        const float* cin = in[1]; const float* w_ada = in[2]; const float* b_ada = in[3]; float* mod = (float*)(ws + WS_MOD);
        LAS float* tab = (LAS float*)C.lds; LAS float* part = (LAS float*)(C.lds + 16384);
#pragma unroll
        for (int kk = 0; kk < 2; ++kk) { const int k = C.tid + NT * kk;
#pragma unroll
            for (int b = 0; b < 4; ++b) { const float x = cin[b * DM + k]; tab[k * 4 + b] = x / (1.0f + __expf(-x)); } }
        __syncthreads();
        const int l = mu / 96, col = (mu % 96) * 64 + C.lane, kw = C.wave * 128;
        const float* W = w_ada + (size_t)l * DM * MODW + (size_t)kw * MODW + col;
        float a0 = 0.f, a1 = 0.f, a2 = 0.f, a3 = 0.f;
#pragma unroll 2
        for (int k0 = 0; k0 < 128; k0 += 16) {
            float w[16];
#pragma unroll
            for (int jj = 0; jj < 16; ++jj) w[jj] = W[(size_t)(k0 + jj) * MODW];
#pragma unroll
            for (int jj = 0; jj < 16; ++jj) { const f32x4 sv = *(const LAS f32x4*)(tab + (kw + k0 + jj) * 4); a0 += sv[0] * w[jj]; a1 += sv[1] * w[jj]; a2 += sv[2] * w[jj]; a3 += sv[3] * w[jj]; }
        }
        part[(C.wave * 4 + 0) * 64 + C.lane] = a0; part[(C.wave * 4 + 1) * 64 + C.lane] = a1; part[(C.wave * 4 + 2) * 64 + C.lane] = a2; part[(C.wave * 4 + 3) * 64 + C.lane] = a3;
        __syncthreads();
        if (C.wave < 4) { float sacc = 0.f;
#pragma unroll
            for (int w8 = 0; w8 < 8; ++w8) sacc += part[(w8 * 4 + C.wave) * 64 + C.lane];
            mod[(size_t)(l * 4 + C.wave) * MODW + col] = sacc + b_ada[l * MODW + col]; }
        __syncthreads();
    }
    const int NGW = ncu * NWAVES;
    constexpr int I_QKV = 16 * 96, I_O = 16 * 32, I_IN = 16 * 96, I_OUT = 16 * 32, I_GU = 16 * 176, I_DN = 44 * 32;
    constexpr int NITEMS = I_QKV + I_O + I_IN + I_OUT + 2 * I_GU + 2 * I_DN;
    struct TItem { const float* W; bf16* WT; int K, N, k0, n0, drow, f8; };
#define P0_DESC(D, IT) do { int r = (IT); \
        if (r < I_QKV) { D = TItem{in[6], (bf16*)(ws + WS_WQKV), DM, 3 * DM, 64 * (r / 96), 32 * (r % 96), 32 * (r % 96), 1}; break; } r -= I_QKV; \
        if (r < I_O) { D = TItem{in[7], (bf16*)(ws + WS_WO), DM, DM, 64 * (r / 32), 32 * (r % 32), 32 * (r % 32), 1}; break; } r -= I_O; \
        if (r < I_IN) { const int n0_ = 32 * (r % 96); D = TItem{in[10], (bf16*)(ws + WS_WIN), DM, 3 * DM, 64 * (r / 96), n0_, n0_ < DM ? n0_ : (n0_ < 2 * DM ? DM + pair_row(n0_ - DM, 0) : DM + pair_row(n0_ - 2 * DM, 1)), 0}; break; } r -= I_IN; \
        if (r < I_OUT) { D = TItem{in[12], (bf16*)(ws + WS_WOUT), DM, DM, 64 * (r / 32), 32 * (r % 32), 32 * (r % 32), 0}; break; } r -= I_OUT; \
        if (r < 2 * I_GU) { const int l_ = r / I_GU; r -= l_ * I_GU; const int n0_ = 32 * (r % 176); \
            D = TItem{in[13] + (size_t)l_ * DM * 2 * FF, (bf16*)(ws + (l_ ? WS_WGU1 : WS_WGU0)), DM, 2 * FF, 64 * (r / 176), n0_, n0_ < FF ? pair_row(n0_, 0) : pair_row(n0_ - FF, 1), 0}; break; } r -= 2 * I_GU; \
        { const int l_ = r / I_DN; r -= l_ * I_DN; D = TItem{in[14] + (size_t)l_ * FF * DM, (bf16*)(ws + (l_ ? WS_WDN1 : WS_WDN0)), FF, DM, 64 * (r / 32), 32 * (r % 32), 32 * (r % 32), l_}; } } while (0)
#define P0_LOAD(V, D) do { const float* wp_ = (D).W + (size_t)((D).k0 + (C.lane >> 5)) * (D).N + (D).n0 + (C.lane & 31); _Pragma("unroll") for (int i = 0; i < 32; ++i) V[i] = wp_[(size_t)(2 * i) * (D).N]; } while (0)
    const int gw = (which ? I_QKV : 0) + wcu * NWAVES + C.wave, IEND = which ? NITEMS : I_QKV;
    if (gw < IEND) {
        TItem cur, nx1; float v[32], v1[32];
        P0_DESC(cur, gw); P0_LOAD(v, cur); nx1 = cur;
        if (gw + NGW < IEND) { P0_DESC(nx1, gw + NGW); P0_LOAD(v1, nx1); }
        for (int it = gw; it < IEND; it += NGW) {
            TItem nx2 = nx1; float v2[32]; const bool has1 = it + NGW < IEND, has2 = it + 2 * NGW < IEND;
            if (has2) { P0_DESC(nx2, it + 2 * NGW); P0_LOAD(v2, nx2); }
#pragma unroll
            for (int i = 0; i < 32; ++i) scr[(2 * i + (C.lane >> 5)) * 33 + (C.lane & 31)] = v[i];
            LDS_WAIT(); asm volatile("" ::: "memory");
            const int c = C.lane & 7;
#pragma unroll
            for (int j = 0; j < 4; ++j) { const int n = (C.lane >> 3) + 8 * j; const LAS float* s = scr + (8 * c) * 33 + n;
                if (cur.f8) { unsigned w0 = 0u, w1 = 0u;
                    w0 = __builtin_amdgcn_cvt_pk_fp8_f32(32.f * s[0 * 33], 32.f * s[1 * 33], w0, false); w0 = __builtin_amdgcn_cvt_pk_fp8_f32(32.f * s[2 * 33], 32.f * s[3 * 33], w0, true);
                    w1 = __builtin_amdgcn_cvt_pk_fp8_f32(32.f * s[4 * 33], 32.f * s[5 * 33], w1, false); w1 = __builtin_amdgcn_cvt_pk_fp8_f32(32.f * s[6 * 33], 32.f * s[7 * 33], w1, true);
                    *(GAS unsigned long long*)((GAS unsigned char*)cur.WT + (size_t)(cur.drow + n) * cur.K + cur.k0 + 8 * c) = (unsigned long long)w0 | ((unsigned long long)w1 << 32); }
                else { v4u o; o.x = pk2(s[0 * 33], s[1 * 33]); o.y = pk2(s[2 * 33], s[3 * 33]); o.z = pk2(s[4 * 33], s[5 * 33]); o.w = pk2(s[6 * 33], s[7 * 33]);
                    *(GAS v4u*)(cur.WT + (size_t)(cur.drow + n) * cur.K + cur.k0 + 8 * c) = o; } }
            LDS_WAIT(); asm volatile("" ::: "memory");
            if (has1) { cur = nx1; nx1 = nx2;
#pragma unroll
                for (int i = 0; i < 32; ++i) { v[i] = v1[i]; v1[i] = v2[i]; } }
        }
    }
#undef P0_DESC
#undef P0_LOAD
}


__device__ __forceinline__ void gemv4_phase(const Ctx& C, const float* __restrict__ W, int ldw, int ncols, const float* __restrict__ svec, int sstride, float* __restrict__ out, int ostride, int wcu) {
    if (wcu * 16 >= ncols) return;
    LAS float* tab = (LAS float*)C.lds; LAS float* part = (LAS float*)(C.lds + 16384);
#pragma unroll
    for (int kk = 0; kk < 2; ++kk) { const int k = C.tid + NT * kk;
#pragma unroll
        for (int b = 0; b < 4; ++b) tab[k * 4 + b] = svec[(size_t)b * sstride + k]; }
    __syncthreads();
    const int cc = C.lane & 15, ks = C.lane >> 4, k0 = C.wave * 128 + ks * 32;
    const float* wp = W + (size_t)k0 * ldw + wcu * 16 + cc;
    float a0 = 0.f, a1 = 0.f, a2 = 0.f, a3 = 0.f;
#pragma unroll 2
    for (int k = 0; k < 32; k += 16) { float w[16];
#pragma unroll
        for (int jj = 0; jj < 16; ++jj) w[jj] = wp[(size_t)(k + jj) * ldw];
#pragma unroll
        for (int jj = 0; jj < 16; ++jj) { const f32x4 sv = *(const LAS f32x4*)(tab + (k0 + k + jj) * 4); a0 += sv[0] * w[jj]; a1 += sv[1] * w[jj]; a2 += sv[2] * w[jj]; a3 += sv[3] * w[jj]; } }
    a0 += __shfl_xor(a0, 16); a1 += __shfl_xor(a1, 16); a2 += __shfl_xor(a2, 16); a3 += __shfl_xor(a3, 16);
    a0 += __shfl_xor(a0, 32); a1 += __shfl_xor(a1, 32); a2 += __shfl_xor(a2, 32); a3 += __shfl_xor(a3, 32);
    if (C.lane < 16) *(LAS f32x4*)(part + (C.wave * 16 + cc) * 4) = (f32x4){a0, a1, a2, a3};
    __syncthreads();
    if (C.tid < 64) { const int col = C.tid & 15, b = C.tid >> 4; float s = 0.f;
#pragma unroll
        for (int w8 = 0; w8 < 8; ++w8) s += part[(w8 * 16 + col) * 4 + b];
        out[(size_t)b * ostride + wcu * 16 + col] = s; }
    __syncthreads();
}

template <bool XB, bool HY, bool HY2, bool HXO, bool H8 = false, bool HD0 = false, bool Y8 = false>
__device__ __forceinline__ void modulate_phase(const Ctx& C, const void* __restrict__ Xv, const float* __restrict__ gain, const float* __restrict__ modl, int sh_off, int sc_off, bf16* __restrict__ Hout,
                                               const bf16* __restrict__ Y = nullptr, int g_off = 0, const bf16* __restrict__ Y2 = nullptr, int g2_off = 0, bf16* Xout = nullptr, const float* __restrict__ d0 = nullptr) {
    const int gw = C.vcu * NWAVES + C.wave, NGW = C.G * NWAVES;
    for (int rg = gw; rg < M / 16; rg += NGW) {
        const int row0 = rg * 16, b = row0 >> 13;
        f32x4 Gv[4], Sv[4], Yg[4], Yg2[4], Yd[4];
#pragma unroll
        for (int j = 0; j < 4; ++j) { const int col = 4 * C.lane + 256 * j;
            const f32x4 g = *(const f32x4*)(gain + col), sc = *(const f32x4*)(modl + (size_t)b * MODW + sc_off + col);
            Gv[j] = g * (sc + 1.0f); Sv[j] = *(const f32x4*)(modl + (size_t)b * MODW + sh_off + col);
            if constexpr (HY) Yg[j] = *(const f32x4*)(modl + (size_t)b * MODW + g_off + col);
            if constexpr (HD0) Yd[j] = Yg[j] * *(const f32x4*)(d0 + (size_t)b * DM + col);
            if constexpr (Y8) Yg[j] = Yg[j] * 0.0625f;
            if constexpr (HY2) Yg2[j] = *(const f32x4*)(modl + (size_t)b * MODW + g2_off + col); }
        struct Buf { f32x4 v[2][4]; unsigned long long xb[2][4], y[2][4], y2[2][4]; };
        auto load = [&](Buf& B, int r) __attribute__((always_inline)) {
#pragma unroll
            for (int q = 0; q < 2; ++q) { const size_t ro = (size_t)(row0 + r + q) * DM;
                if constexpr (XB) { const GAS unsigned long long* xr = (const GAS unsigned long long*)((const bf16*)Xv + ro) + C.lane;
#pragma unroll
                    for (int j = 0; j < 4; ++j) B.xb[q][j] = xr[64 * j]; }
                else { const GAS f32x4* xr = (const GAS f32x4*)((const float*)Xv + ro) + C.lane;
#pragma unroll
                    for (int j = 0; j < 4; ++j) B.v[q][j] = xr[64 * j]; }
                if constexpr (HY && Y8) { const GAS unsigned* yr = (const GAS unsigned*)((const GAS unsigned char*)Y + (size_t)((row0 + r + q) >> 12) * F8_XS + (size_t)((row0 + r + q) & 4095) * DM) + C.lane;
#pragma unroll
                    for (int j = 0; j < 4; ++j) B.y[q][j] = yr[64 * j]; }
                if constexpr (HY && !Y8) { const GAS unsigned long long* yr = (const GAS unsigned long long*)(Y + ro) + C.lane;
#pragma unroll
                    for (int j = 0; j < 4; ++j) B.y[q][j] = yr[64 * j]; }
                if constexpr (HY2) { const GAS unsigned long long* yr = (const GAS unsigned long long*)(Y2 + ro) + C.lane;
#pragma unroll
                    for (int j = 0; j < 4; ++j) B.y2[q][j] = yr[64 * j]; } }
        };
        auto comp = [&](Buf& B, int r) __attribute__((always_inline)) {
#pragma unroll
            for (int q = 0; q < 2; ++q) { const size_t ro = (size_t)(row0 + r + q) * DM; float s = 0.f;
#pragma unroll
                for (int j = 0; j < 4; ++j) {
                    if constexpr (XB) { const unsigned lo = (unsigned)B.xb[q][j], hi = (unsigned)(B.xb[q][j] >> 32); B.v[q][j] = (f32x4){bf_lo(lo), bf_hi(lo), bf_lo(hi), bf_hi(hi)}; }
                    if constexpr (HY && Y8) { const unsigned w = (unsigned)B.y[q][j]; B.v[q][j] = B.v[q][j] + Yg[j] * (f32x4){__builtin_amdgcn_cvt_f32_fp8(w, 0), __builtin_amdgcn_cvt_f32_fp8(w, 1), __builtin_amdgcn_cvt_f32_fp8(w, 2), __builtin_amdgcn_cvt_f32_fp8(w, 3)}; }
                    if constexpr (HY && !Y8) { const unsigned lo = (unsigned)B.y[q][j], hi = (unsigned)(B.y[q][j] >> 32); B.v[q][j] = B.v[q][j] + Yg[j] * (f32x4){bf_lo(lo), bf_hi(lo), bf_lo(hi), bf_hi(hi)}; }
                    if constexpr (HD0) B.v[q][j] = B.v[q][j] + Yd[j];
                    if constexpr (HY2) { const unsigned lo = (unsigned)B.y2[q][j], hi = (unsigned)(B.y2[q][j] >> 32); B.v[q][j] = B.v[q][j] + Yg2[j] * (f32x4){bf_lo(lo), bf_hi(lo), bf_lo(hi), bf_hi(hi)}; }
                    s += (B.v[q][j].x * B.v[q][j].x + B.v[q][j].y * B.v[q][j].y) + (B.v[q][j].z * B.v[q][j].z + B.v[q][j].w * B.v[q][j].w); }
                if constexpr (HXO) { GAS unsigned long long* xo = (GAS unsigned long long*)(Xout + ro) + C.lane;
#pragma unroll
                    for (int j = 0; j < 4; ++j) xo[64 * j] = (unsigned long long)pk2(B.v[q][j].x, B.v[q][j].y) | ((unsigned long long)pk2(B.v[q][j].z, B.v[q][j].w) << 32); }
                const float rstd = __builtin_amdgcn_rsqf(wave_sum(s) * (1.0f / DM) + 1e-6f);
                if constexpr (H8) {
                    GAS unsigned* o4 = (GAS unsigned*)((GAS unsigned char*)Hout + (size_t)((row0 + r + q) >> 12) * F8_XS + (size_t)((row0 + r + q) & 4095) * DM) + C.lane;
#pragma unroll
                    for (int j = 0; j < 4; ++j) { const f32x4 o = B.v[q][j] * rstd * Gv[j];
                        unsigned w = 0u; w = __builtin_amdgcn_cvt_pk_fp8_f32(o.x, o.y, w, false); w = __builtin_amdgcn_cvt_pk_fp8_f32(o.z, o.w, w, true); o4[64 * j] = w; }
                } else {
                GAS unsigned long long* o8 = (GAS unsigned long long*)(Hout + ro) + C.lane;
#pragma unroll
                for (int j = 0; j < 4; ++j) { const f32x4 o = B.v[q][j] * rstd * Gv[j] + Sv[j];
                    o8[64 * j] = (unsigned long long)pk2(o.x, o.y) | ((unsigned long long)pk2(o.z, o.w) << 32); } } }
        };
        Buf A, Bb;
        load(A, 0);
        for (int r = 0; r < 12; r += 4) { load(Bb, r + 2); comp(A, r); load(A, r + 4); comp(Bb, r + 2); }
        load(Bb, 14); comp(A, 12); comp(Bb, 14);
    }
}

__device__ __forceinline__ void kmean_phase(const Ctx& C, const bf16* Kb, float* kmean) {
    LAS float* part = (LAS float*)C.lds;
    const int ch = C.tid & 15, rg = C.tid >> 4;
    for (int u = C.vcu; u < 1024; u += C.G) {
        const int bh = u >> 5, j = u & 31, b = bh >> 3, h = bh & 7;
        const bf16* Kg = Kb + (size_t)(b * SEQ + j * 256 + rg * 8) * DM + h * HD + ch * 8;
        float a[8];
#pragma unroll
        for (int e = 0; e < 8; ++e) a[e] = 0.f;
#pragma unroll
        for (int r = 0; r < 8; ++r) { const v4u w = *(const v4u*)(Kg + (size_t)r * DM);
            a[0] += bf_lo(w.x); a[1] += bf_hi(w.x); a[2] += bf_lo(w.y); a[3] += bf_hi(w.y); a[4] += bf_lo(w.z); a[5] += bf_hi(w.z); a[6] += bf_lo(w.w); a[7] += bf_hi(w.w); }
        __syncthreads();
        *(LAS f32x4*)(part + rg * 128 + ch * 8) = (f32x4){a[0], a[1], a[2], a[3]}; *(LAS f32x4*)(part + rg * 128 + ch * 8 + 4) = (f32x4){a[4], a[5], a[6], a[7]};
        __syncthreads();
        if (C.tid < 128) { float s = 0.f;
#pragma unroll 8
            for (int g = 0; g < 32; ++g) s += part[g * 128 + C.tid];
            kmean[(size_t)(bh * 32 + j) * 128 + C.tid] = s * (1.0f / 256.0f); }
    }
}

typedef float f32x16r __attribute__((ext_vector_type(16)));
#define ROUTE_INS(SC, JJ) { const float sc_ = (SC); const int jj_ = (JJ); if (sc_ > v2) { if (sc_ > v1) { v2 = v1; i2 = i1; if (sc_ > v0) { v1 = v0; i1 = i0; v0 = sc_; i0 = jj_; } else { v1 = sc_; i1 = jj_; } } else { v2 = sc_; i2 = jj_; } } }
__device__ __forceinline__ void route_phase(const Ctx& C, const bf16* Qb, const float* kmean, unsigned* lists, gu32* lcnt) {
    const int r32 = C.lane & 31, hi = C.lane >> 5;
    for (int u = C.vcu; u < 512; u += C.G) {
        int bh = u >> 4, qc = (u & 256) ? 15 - (u & 15) : (u & 15);
        if (C.local) { const int w = C.vcu & 63, k = u >> 8; bh = 8 * (C.vcu >> 6) + 4 * k + (w >> 4); qc = k ? 15 - (w & 15) : (w & 15); }
        const int b = bh >> 3, h = bh & 7;
        const int s = qc * 512 + C.tid, nb = __builtin_amdgcn_readfirstlane(s >> 8);
        bf16x8 kh[8], kl[8];
        { const float* kp = kmean + (size_t)bh * 4096 + r32 * 128 + 8 * hi;
#pragma unroll
            for (int t = 0; t < 8; ++t) { const f32x4 a = *(const f32x4*)(kp + 16 * t), c = *(const f32x4*)(kp + 16 * t + 4);
                pg8::u32x4 wh, wl;
                wh.x = pg8::cvt_pk_bf16(a[0], a[1]); wh.y = pg8::cvt_pk_bf16(a[2], a[3]); wh.z = pg8::cvt_pk_bf16(c[0], c[1]); wh.w = pg8::cvt_pk_bf16(c[2], c[3]);
                wl.x = pg8::cvt_pk_bf16(a[0] - bf_lo(wh.x), a[1] - bf_hi(wh.x)); wl.y = pg8::cvt_pk_bf16(a[2] - bf_lo(wh.y), a[3] - bf_hi(wh.y));
                wl.z = pg8::cvt_pk_bf16(c[0] - bf_lo(wh.z), c[1] - bf_hi(wh.z)); wl.w = pg8::cvt_pk_bf16(c[2] - bf_lo(wh.w), c[3] - bf_hi(wh.w));
                kh[t] = __builtin_bit_cast(bf16x8, wh); kl[t] = __builtin_bit_cast(bf16x8, wl); } }
        const float NEG = -__builtin_inff();
        int i0 = -1, i1 = -1, i2 = -1;
#pragma unroll
        for (int tl = 0; tl < 2; ++tl) {
            const bf16* qp = Qb + (size_t)(b * SEQ + qc * 512 + C.wave * 64 + tl * 32 + r32) * DM + h * HD + 8 * hi;
            bf16x8 qf[8];
#pragma unroll
            for (int t = 0; t < 8; ++t) qf[t] = *(const bf16x8*)(qp + 16 * t);
            f32x16r acc;
#pragma unroll
            for (int r = 0; r < 16; ++r) acc[r] = 0.f;
#pragma unroll
            for (int t = 0; t < 8; ++t) { acc = __builtin_amdgcn_mfma_f32_32x32x16_bf16(kh[t], qf[t], acc, 0, 0, 0); acc = __builtin_amdgcn_mfma_f32_32x32x16_bf16(kl[t], qf[t], acc, 0, 0, 0); }
            float v0 = NEG, v1 = NEG, v2 = NEG; int j0 = -1, j1 = -1, j2 = -1;
            { int i0 = -1, i1 = -1, i2 = -1;
#pragma unroll
                for (int r = 0; r < 16; ++r) { const int j = (r & 3) + 8 * (r >> 2) + 4 * hi; if (j < nb) ROUTE_INS(acc[r], j) }
                const auto a0 = __builtin_amdgcn_permlane32_swap(__float_as_uint(v0), __float_as_uint(v0), false, false), a1 = __builtin_amdgcn_permlane32_swap(__float_as_uint(v1), __float_as_uint(v1), false, false),
                           a2 = __builtin_amdgcn_permlane32_swap(__float_as_uint(v2), __float_as_uint(v2), false, false);
                const auto b0 = __builtin_amdgcn_permlane32_swap((unsigned)i0, (unsigned)i0, false, false), b1 = __builtin_amdgcn_permlane32_swap((unsigned)i1, (unsigned)i1, false, false),
                           b2 = __builtin_amdgcn_permlane32_swap((unsigned)i2, (unsigned)i2, false, false);
                v0 = NEG; v1 = NEG; v2 = NEG; i0 = -1; i1 = -1; i2 = -1;
                ROUTE_INS(__uint_as_float(a0[0]), (int)b0[0]) ROUTE_INS(__uint_as_float(a1[0]), (int)b1[0]) ROUTE_INS(__uint_as_float(a2[0]), (int)b2[0])
                ROUTE_INS(__uint_as_float(a0[1]), (int)b0[1]) ROUTE_INS(__uint_as_float(a1[1]), (int)b1[1]) ROUTE_INS(__uint_as_float(a2[1]), (int)b2[1])
                j0 = i0; j1 = i1; j2 = i2; }
            if (hi == tl) { i0 = j0; i1 = j1; i2 = j2; }
        }
        unsigned long long mymask = 0ull;
        for (int jj = 0; jj < nb; ++jj) { const bool hit = (i0 == jj) | (i1 == jj) | (i2 == jj); const unsigned long long mk = __ballot(hit); if (C.lane == jj) mymask = mk; }
        const int n = __popcll(mymask); unsigned base = 0u;
        if (C.lane < nb && n > 0) base = __hip_atomic_fetch_add(lcnt + bh * 32 + C.lane, (unsigned)n, __ATOMIC_RELAXED, __HIP_MEMORY_SCOPE_AGENT);
        const unsigned long long below = (1ull << C.lane) - 1ull;
#pragma unroll
        for (int t = 0; t < 3; ++t) { const int it = t == 0 ? i0 : (t == 1 ? i1 : i2); const int src = it < 0 ? 0 : it;
            const unsigned bs = __shfl(base, src); const unsigned mlo = __shfl((unsigned)mymask, src), mhi = __shfl((unsigned)(mymask >> 32), src);
            const unsigned long long mk = ((unsigned long long)mhi << 32) | mlo;
            const unsigned pos = bs + (unsigned)__popcll(mk & below);
            if (it >= 0 && pos < (unsigned)LCAP) lists[list_off(bh, it) + pos] = ((unsigned)s << 2) | (unsigned)(t + 1); }
    }
}

namespace moba {
__device__ const unsigned short ATT_SCHED_PAIR[64 * 8] = {
    0, 135, 192, 65535, 65535, 65535, 65535, 65535,
    1, 134, 193, 65535, 65535, 65535, 65535, 65535,
    2, 133, 194, 65535, 65535, 65535, 65535, 65535,
    3, 132, 195, 65535, 65535, 65535, 65535, 65535,
    4, 131, 196, 65535, 65535, 65535, 65535, 65535,
    5, 130, 197, 65535, 65535, 65535, 65535, 65535,
    6, 129, 198, 65535, 65535, 65535, 65535, 65535,
    7, 128, 199, 65535, 65535, 65535, 65535, 65535,
    8, 143, 184, 240, 65535, 65535, 65535, 65535,
    9, 142, 185, 241, 65535, 65535, 65535, 65535,
    10, 141, 186, 242, 65535, 65535, 65535, 65535,
    11, 140, 187, 243, 65535, 65535, 65535, 65535,
    12, 139, 188, 244, 65535, 65535, 65535, 65535,
    13, 138, 189, 245, 65535, 65535, 65535, 65535,
    14, 137, 190, 246, 65535, 65535, 65535, 65535,
    15, 136, 191, 247, 65535, 65535, 65535, 65535,
    16, 104, 183, 232, 65535, 65535, 65535, 65535,
    17, 105, 182, 233, 65535, 65535, 65535, 65535,
    18, 106, 181, 234, 65535, 65535, 65535, 65535,
    19, 107, 180, 235, 65535, 65535, 65535, 65535,
    20, 108, 179, 236, 65535, 65535, 65535, 65535,
    21, 109, 178, 237, 65535, 65535, 65535, 65535,
    22, 110, 177, 238, 65535, 65535, 65535, 65535,
    23, 111, 176, 239, 65535, 65535, 65535, 65535,
    24, 95, 160, 224, 65535, 65535, 65535, 65535,
    25, 94, 161, 225, 65535, 65535, 65535, 65535,
    26, 93, 162, 226, 65535, 65535, 65535, 65535,
    27, 92, 163, 227, 65535, 65535, 65535, 65535,
    28, 91, 164, 228, 65535, 65535, 65535, 65535,
    29, 90, 165, 229, 65535, 65535, 65535, 65535,
    30, 89, 166, 230, 65535, 65535, 65535, 65535,
    31, 88, 167, 231, 65535, 65535, 65535, 65535,
    32, 103, 127, 208, 65535, 65535, 65535, 65535,
    33, 102, 126, 209, 65535, 65535, 65535, 65535,
    34, 101, 125, 210, 65535, 65535, 65535, 65535,
    35, 100, 124, 211, 65535, 65535, 65535, 65535,
    36, 99, 123, 212, 65535, 65535, 65535, 65535,
    37, 98, 122, 213, 65535, 65535, 65535, 65535,
    38, 97, 121, 214, 65535, 65535, 65535, 65535,
    39, 96, 120, 215, 65535, 65535, 65535, 65535,
    40, 80, 144, 175, 65535, 65535, 65535, 65535,
    41, 81, 145, 174, 65535, 65535, 65535, 65535,
    42, 82, 146, 173, 65535, 65535, 65535, 65535,
    43, 83, 147, 172, 65535, 65535, 65535, 65535,
    44, 84, 148, 171, 65535, 65535, 65535, 65535,
    45, 85, 149, 170, 65535, 65535, 65535, 65535,
    46, 86, 150, 169, 65535, 65535, 65535, 65535,
    47, 87, 151, 168, 65535, 65535, 65535, 65535,
    48, 72, 112, 200, 65535, 65535, 65535, 65535,
    49, 73, 113, 201, 65535, 65535, 65535, 65535,
    50, 74, 114, 202, 65535, 65535, 65535, 65535,
    51, 75, 115, 203, 65535, 65535, 65535, 65535,
    52, 76, 116, 204, 65535, 65535, 65535, 65535,
    53, 77, 117, 205, 65535, 65535, 65535, 65535,
    54, 78, 118, 206, 65535, 65535, 65535, 65535,
    55, 79, 119, 207, 65535, 65535, 65535, 65535,
    56, 64, 159, 216, 248, 65535, 65535, 65535,
    57, 65, 158, 217, 249, 65535, 65535, 65535,
    58, 66, 157, 218, 250, 65535, 65535, 65535,
    59, 67, 156, 219, 251, 65535, 65535, 65535,
    60, 68, 155, 220, 252, 65535, 65535, 65535,
    61, 69, 154, 221, 253, 65535, 65535, 65535,
    62, 70, 153, 222, 254, 65535, 65535, 65535,
    63, 71, 152, 223, 255, 65535, 65535, 65535,
};
__device__ const unsigned short ATT_SCHED[256 * 8] = {
    0, 552, 545, 65535, 65535, 65535, 65535, 65535,
    1, 556, 565, 65535, 65535, 65535, 65535, 65535,
    2, 560, 564, 65535, 65535, 65535, 65535, 65535,
    3, 513, 588, 65535, 65535, 65535, 65535, 65535,
    4, 480, 612, 65535, 65535, 65535, 65535, 65535,
    5, 524, 589, 65535, 65535, 65535, 65535, 65535,
    6, 498, 611, 65535, 65535, 65535, 65535, 65535,
    7, 457, 664, 65535, 65535, 65535, 65535, 65535,
    8, 458, 663, 65535, 65535, 65535, 65535, 65535,
    9, 459, 656, 65535, 65535, 65535, 65535, 65535,
    10, 460, 655, 65535, 65535, 65535, 65535, 65535,
    11, 491, 620, 65535, 65535, 65535, 65535, 65535,
    12, 492, 630, 65535, 65535, 65535, 65535, 65535,
    13, 493, 623, 65535, 65535, 65535, 65535, 65535,
    14, 530, 601, 65535, 65535, 65535, 65535, 65535,
    15, 531, 603, 65535, 65535, 65535, 65535, 65535,
    16, 523, 605, 65535, 65535, 65535, 65535, 65535,
    17, 522, 607, 65535, 65535, 65535, 65535, 65535,
    18, 537, 591, 65535, 65535, 65535, 65535, 65535,
    19, 534, 594, 65535, 65535, 65535, 65535, 65535,
    20, 536, 593, 65535, 65535, 65535, 65535, 65535,
    21, 535, 596, 65535, 65535, 65535, 65535, 65535,
    22, 539, 595, 65535, 65535, 65535, 65535, 65535,
    23, 466, 651, 65535, 65535, 65535, 65535, 65535,
    24, 386, 784, 65535, 65535, 65535, 65535, 65535,
    25, 387, 782, 65535, 65535, 65535, 65535, 65535,
    26, 388, 799, 65535, 65535, 65535, 65535, 65535,
    27, 389, 798, 65535, 65535, 65535, 65535, 65535,
    28, 390, 797, 65535, 65535, 65535, 65535, 65535,
    29, 391, 796, 65535, 65535, 65535, 65535, 65535,
    30, 352, 842, 65535, 65535, 65535, 65535, 65535,
    31, 456, 644, 65535, 65535, 65535, 65535, 65535,
    32, 540, 786, 1019, 65535, 65535, 65535, 65535,
    33, 504, 915, 946, 65535, 65535, 65535, 65535,
    34, 428, 964, 1017, 65535, 65535, 65535, 65535,
    35, 427, 991, 1009, 65535, 65535, 65535, 65535,
    36, 426, 990, 997, 65535, 65535, 65535, 65535,
    37, 425, 965, 996, 65535, 65535, 65535, 65535,
    38, 424, 966, 995, 65535, 65535, 65535, 65535,
    39, 461, 951, 986, 65535, 65535, 65535, 65535,
    40, 547, 792, 968, 65535, 65535, 65535, 65535,
    41, 561, 791, 969, 65535, 65535, 65535, 65535,
    42, 515, 790, 992, 65535, 65535, 65535, 65535,
    43, 558, 789, 971, 65535, 65535, 65535, 65535,
    44, 518, 885, 903, 65535, 65535, 65535, 65535,
    45, 519, 854, 931, 65535, 65535, 65535, 65535,
    46, 568, 809, 911, 65535, 65535, 65535, 65535,
    47, 566, 736, 1011, 65535, 65535, 65535, 65535,
    48, 567, 737, 1020, 65535, 65535, 65535, 65535,
    49, 600, 714, 977, 65535, 65535, 65535, 65535,
    50, 514, 881, 904, 65535, 65535, 65535, 65535,
    51, 602, 716, 979, 65535, 65535, 65535, 65535,
    52, 541, 893, 920, 65535, 65535, 65535, 65535,
    53, 604, 712, 981, 65535, 65535, 65535, 65535,
    54, 528, 872, 919, 65535, 65535, 65535, 65535,
    55, 606, 715, 983, 65535, 65535, 65535, 65535,
    56, 538, 892, 906, 65535, 65535, 65535, 65535,
    57, 520, 864, 896, 65535, 65535, 65535, 65535,
    58, 521, 880, 898, 65535, 65535, 65535, 65535,
    59, 526, 877, 899, 65535, 65535, 65535, 65535,
    60, 529, 866, 927, 65535, 65535, 65535, 65535,
    61, 577, 725, 970, 65535, 65535, 65535, 65535,
    62, 576, 728, 976, 65535, 65535, 65535, 65535,
    63, 497, 913, 942, 65535, 65535, 65535, 65535,
    64, 416, 693, 999, 65535, 65535, 65535, 65535,
    65, 417, 673, 998, 65535, 65535, 65535, 65535,
    66, 418, 765, 940, 65535, 65535, 65535, 65535,
    67, 419, 709, 973, 65535, 65535, 65535, 65535,
    68, 420, 695, 1010, 65535, 65535, 65535, 65535,
    69, 421, 724, 972, 65535, 65535, 65535, 65535,
    70, 422, 723, 980, 65535, 65535, 65535, 65535,
    71, 423, 726, 967, 65535, 65535, 65535, 65535,
    72, 490, 680, 889, 65535, 65535, 65535, 65535,
    73, 489, 681, 890, 65535, 65535, 65535, 65535,
    74, 488, 682, 887, 65535, 65535, 65535, 65535,
    75, 487, 683, 888, 65535, 65535, 65535, 65535,
    76, 507, 694, 878, 65535, 65535, 65535, 65535,
    77, 429, 722, 962, 65535, 65535, 65535, 65535,
    78, 430, 731, 982, 65535, 65535, 65535, 65535,
    79, 431, 743, 943, 65535, 65535, 65535, 65535,
    80, 432, 745, 944, 65535, 65535, 65535, 65535,
    81, 433, 747, 945, 65535, 65535, 65535, 65535,
    82, 434, 732, 984, 65535, 65535, 65535, 65535,
    83, 435, 721, 985, 65535, 65535, 65535, 65535,
    84, 436, 734, 961, 65535, 65535, 65535, 65535,
    85, 437, 748, 949, 65535, 65535, 65535, 65535,
    86, 438, 751, 950, 65535, 65535, 65535, 65535,
    87, 439, 767, 907, 65535, 65535, 65535, 65535,
    88, 440, 696, 1023, 65535, 65535, 65535, 65535,
    89, 465, 697, 953, 65535, 65535, 65535, 65535,
    90, 455, 698, 954, 65535, 65535, 65535, 65535,
    91, 454, 699, 955, 65535, 65535, 65535, 65535,
    92, 453, 700, 956, 65535, 65535, 65535, 65535,
    93, 452, 701, 957, 65535, 65535, 65535, 65535,
    94, 451, 702, 958, 65535, 65535, 65535, 65535,
    95, 450, 703, 959, 65535, 65535, 65535, 65535,
    96, 502, 640, 657, 65535, 65535, 65535, 65535,
    97, 501, 641, 658, 65535, 65535, 65535, 65535,
    98, 500, 642, 659, 65535, 65535, 65535, 65535,
    99, 499, 643, 660, 65535, 65535, 65535, 65535,
    100, 525, 609, 661, 65535, 65535, 65535, 65535,
    101, 469, 646, 727, 65535, 65535, 65535, 65535,
    102, 463, 636, 757, 65535, 65535, 65535, 65535,
    103, 462, 647, 730, 65535, 65535, 65535, 65535,
    104, 464, 648, 705, 65535, 65535, 65535, 65535,
    105, 393, 689, 768, 65535, 65535, 65535, 65535,
    106, 394, 688, 769, 65535, 65535, 65535, 65535,
    107, 395, 704, 754, 65535, 65535, 65535, 65535,
    108, 396, 583, 909, 65535, 65535, 65535, 65535,
    109, 397, 581, 910, 65535, 65535, 65535, 65535,
    110, 398, 582, 921, 65535, 65535, 65535, 65535,
    111, 399, 586, 922, 65535, 65535, 65535, 65535,
    112, 400, 590, 912, 65535, 65535, 65535, 65535,
    113, 401, 690, 776, 65535, 65535, 65535, 65535,
    114, 402, 686, 778, 65535, 65535, 65535, 65535,
    115, 403, 685, 780, 65535, 65535, 65535, 65535,
    116, 404, 707, 750, 65535, 65535, 65535, 65535,
    117, 405, 706, 749, 65535, 65535, 65535, 65535,
    118, 392, 621, 874, 65535, 65535, 65535, 65535,
    119, 407, 599, 925, 65535, 65535, 65535, 65535,
    120, 408, 580, 926, 65535, 65535, 65535, 65535,
    121, 409, 613, 884, 65535, 65535, 65535, 65535,
    122, 410, 666, 831, 65535, 65535, 65535, 65535,
    123, 411, 639, 873, 65535, 65535, 65535, 65535,
    124, 412, 638, 894, 65535, 65535, 65535, 65535,
    125, 353, 674, 853, 65535, 65535, 65535, 65535,
    126, 414, 670, 800, 65535, 65535, 65535, 65535,
    127, 415, 671, 830, 65535, 65535, 65535, 65535,
    128, 406, 448, 908, 65535, 65535, 65535, 65535,
    174, 285, 592, 840, 65535, 65535, 65535, 65535,
    130, 304, 672, 807, 65535, 65535, 65535, 65535,
    131, 301, 760, 739, 65535, 65535, 65535, 65535,
    132, 284, 720, 841, 65535, 65535, 65535, 65535,
    133, 281, 756, 812, 65535, 65535, 65535, 65535,
    134, 282, 753, 828, 65535, 65535, 65535, 65535,
    135, 279, 755, 826, 65535, 65535, 65535, 65535,
    136, 280, 735, 851, 65535, 65535, 65535, 65535,
    137, 277, 777, 771, 65535, 65535, 65535, 65535,
    138, 316, 758, 738, 65535, 65535, 65535, 65535,
    139, 317, 710, 766, 65535, 65535, 65535, 65535,
    140, 276, 744, 823, 65535, 65535, 65535, 65535,
    141, 273, 729, 857, 65535, 65535, 65535, 65535,
    142, 274, 691, 923, 65535, 65535, 65535, 65535,
    143, 271, 692, 924, 65535, 65535, 65535, 65535,
    144, 272, 742, 808, 65535, 65535, 65535, 65535,
    145, 269, 746, 802, 65535, 65535, 65535, 65535,
    146, 270, 752, 801, 65535, 65535, 65535, 65535,
    147, 267, 770, 787, 65535, 65535, 65535, 65535,
    148, 268, 773, 788, 65535, 65535, 65535, 65535,
    149, 265, 772, 779, 65535, 65535, 65535, 65535,
    150, 266, 775, 783, 65535, 65535, 65535, 65535,
    151, 263, 774, 781, 65535, 65535, 65535, 65535,
    182, 319, 449, 974, 65535, 65535, 65535, 65535,
    180, 318, 485, 914, 65535, 65535, 65535, 65535,
    181, 275, 484, 993, 65535, 65535, 65535, 65535,
    178, 278, 483, 994, 65535, 65535, 65535, 65535,
    179, 315, 482, 917, 65535, 65535, 65535, 65535,
    176, 314, 481, 918, 65535, 65535, 65535, 65535,
    177, 313, 543, 843, 65535, 65535, 65535, 65535,
    159, 256, 717, 855, 65535, 65535, 65535, 65535,
    160, 320, 546, 713, 65535, 65535, 65535, 65535,
    161, 376, 527, 708, 65535, 65535, 65535, 65535,
    162, 322, 563, 718, 65535, 65535, 65535, 65535,
    163, 323, 562, 719, 65535, 65535, 65535, 65535,
    164, 324, 517, 795, 65535, 65535, 65535, 65535,
    165, 325, 512, 794, 65535, 65535, 65535, 65535,
    166, 326, 494, 814, 65535, 65535, 65535, 65535,
    167, 327, 495, 852, 65535, 65535, 65535, 65535,
    168, 328, 447, 938, 65535, 65535, 65535, 65535,
    169, 329, 446, 937, 65535, 65535, 65535, 65535,
    170, 330, 445, 939, 65535, 65535, 65535, 65535,
    171, 331, 444, 934, 65535, 65535, 65535, 65535,
    172, 332, 443, 930, 65535, 65535, 65535, 65535,
    173, 333, 442, 933, 65535, 65535, 65535, 65535,
    129, 365, 503, 901, 65535, 65535, 65535, 65535,
    175, 335, 441, 932, 65535, 65535, 65535, 65535,
    157, 336, 675, 711, 65535, 65535, 65535, 65535,
    158, 337, 597, 839, 65535, 65535, 65535, 65535,
    155, 338, 544, 895, 65535, 65535, 65535, 65535,
    156, 339, 548, 886, 65535, 65535, 65535, 65535,
    153, 340, 549, 883, 65535, 65535, 65535, 65535,
    154, 341, 550, 879, 65535, 65535, 65535, 65535,
    152, 342, 551, 875, 65535, 65535, 65535, 65535,
    183, 343, 516, 793, 65535, 65535, 65535, 65535,
    184, 344, 542, 785, 65535, 65535, 65535, 65535,
    185, 345, 505, 803, 65535, 65535, 65535, 65535,
    186, 346, 506, 824, 65535, 65535, 65535, 65535,
    187, 347, 486, 820, 65535, 65535, 65535, 65535,
    188, 289, 508, 905, 65535, 65535, 65535, 65535,
    189, 349, 509, 821, 65535, 65535, 65535, 65535,
    190, 350, 510, 818, 65535, 65535, 65535, 65535,
    191, 351, 511, 822, 65535, 65535, 65535, 65535,
    192, 288, 385, 935, 65535, 65535, 65535, 65535,
    193, 348, 496, 687, 65535, 65535, 65535, 65535,
    194, 290, 384, 941, 65535, 65535, 65535, 65535,
    195, 291, 479, 859, 65535, 65535, 65535, 65535,
    196, 292, 478, 863, 65535, 65535, 65535, 65535,
    197, 293, 477, 862, 65535, 65535, 65535, 65535,
    198, 294, 476, 861, 65535, 65535, 65535, 65535,
    199, 295, 475, 834, 65535, 65535, 65535, 65535,
    200, 296, 474, 860, 65535, 65535, 65535, 65535,
    201, 297, 473, 849, 65535, 65535, 65535, 65535,
    202, 298, 472, 850, 65535, 65535, 65535, 65535,
    203, 299, 471, 847, 65535, 65535, 65535, 65535,
    204, 300, 470, 848, 65535, 65535, 65535, 65535,
    205, 283, 669, 665, 65535, 65535, 65535, 65535,
    206, 302, 468, 845, 65535, 65535, 65535, 65535,
    207, 303, 467, 846, 65535, 65535, 65535, 65535,
    208, 286, 587, 733, 65535, 65535, 65535, 65535,
    209, 305, 578, 645, 65535, 65535, 65535, 65535,
    210, 306, 579, 662, 65535, 65535, 65535, 65535,
    211, 307, 553, 679, 65535, 65535, 65535, 65535,
    212, 308, 555, 678, 65535, 65535, 65535, 65535,
    213, 309, 557, 677, 65535, 65535, 65535, 65535,
    214, 310, 559, 676, 65535, 65535, 65535, 65535,
    243, 311, 533, 633, 65535, 65535, 65535, 65535,
    242, 312, 532, 632, 65535, 65535, 65535, 65535,
    217, 258, 569, 759, 65535, 65535, 65535, 65535,
    218, 257, 570, 741, 65535, 65535, 65535, 65535,
    219, 260, 571, 740, 65535, 65535, 65535, 65535,
    220, 259, 572, 764, 65535, 65535, 65535, 65535,
    221, 262, 573, 762, 65535, 65535, 65535, 65535,
    222, 261, 574, 761, 65535, 65535, 65535, 65535,
    223, 264, 575, 763, 65535, 65535, 65535, 65535,
    224, 383, 668, 876, 897, 65535, 65535, 65535,
    225, 381, 667, 856, 936, 65535, 65535, 65535,
    226, 382, 598, 900, 952, 65535, 65535, 65535,
    227, 379, 637, 833, 987, 65535, 65535, 65535,
    228, 380, 634, 836, 988, 65535, 65535, 65535,
    229, 377, 635, 835, 989, 65535, 65535, 65535,
    230, 378, 649, 838, 929, 65535, 65535, 65535,
    231, 375, 650, 837, 928, 65535, 65535, 65535,
    232, 321, 653, 858, 1000, 65535, 65535, 65535,
    233, 373, 631, 829, 1001, 65535, 65535, 65535,
    234, 374, 628, 817, 1002, 65535, 65535, 65535,
    235, 371, 629, 816, 1003, 65535, 65535, 65535,
    236, 372, 626, 815, 1004, 65535, 65535, 65535,
    237, 369, 627, 827, 1005, 65535, 65535, 65535,
    238, 370, 624, 819, 1006, 65535, 65535, 65535,
    239, 367, 625, 813, 1007, 65535, 65535, 65535,
    240, 368, 622, 825, 1008, 65535, 65535, 65535,
    241, 334, 652, 844, 1022, 65535, 65535, 65535,
    216, 366, 654, 916, 1021, 65535, 65535, 65535,
    215, 363, 684, 871, 975, 65535, 65535, 65535,
    244, 364, 618, 811, 1012, 65535, 65535, 65535,
    245, 361, 619, 806, 1013, 65535, 65535, 65535,
    246, 362, 616, 810, 1014, 65535, 65535, 65535,
    247, 359, 617, 805, 1015, 65535, 65535, 65535,
    248, 360, 614, 804, 1016, 65535, 65535, 65535,
    249, 357, 615, 870, 948, 65535, 65535, 65535,
    250, 358, 585, 867, 1018, 65535, 65535, 65535,
    251, 355, 584, 868, 960, 65535, 65535, 65535,
    252, 356, 610, 865, 947, 65535, 65535, 65535,
    253, 413, 554, 882, 978, 65535, 65535, 65535,
    254, 354, 608, 832, 963, 65535, 65535, 65535,
    255, 287, 891, 869, 902, 65535, 65535, 65535
};
typedef float f32x16 __attribute__((ext_vector_type(16)));
typedef short s16x4 __attribute__((ext_vector_type(4)));
__device__ __forceinline__ int v_st(int k, int c) { return ((k >> 3) * 4 + (c >> 5)) * 512 + ((k & 7) * 32 + (c & 31)) * 2; }
__device__ __forceinline__ int v_rd_base(int lane) { return ((lane & 3) << 3) | (((lane >> 2) & 3) << 6) | (((lane >> 4) & 1) << 5) | (((lane >> 5) & 1) << 8); }
constexpr int v_rd_off(int d0, int ks, int half) { return d0 * 512 + ks * 4096 + half * 2048; }
template <int OFF> __device__ __forceinline__ s16x4 tr_read(int vb) { s16x4 r; asm volatile("ds_read_b64_tr_b16 %0, %1 offset:%2" : "=&v"(r) : "v"(vb), "i"(OFF) : "memory"); return r; }
__device__ __forceinline__ unsigned cvtpk(float lo, float hi) { unsigned r; asm volatile("v_cvt_pk_bf16_f32 %0, %1, %2" : "=v"(r) : "v"(lo), "v"(hi)); return r; }
#define MOBA_RD8(S, D0) if (abl & 64) { S##l0 = fk; S##h0 = fk; S##l1 = fk; S##h1 = fk; S##l2 = fk; S##h2 = fk; S##l3 = fk; S##h3 = fk; } else { S##l0 = tr_read<v_rd_off(D0, 0, 0)>(vb); S##h0 = tr_read<v_rd_off(D0, 0, 1)>(vb); S##l1 = tr_read<v_rd_off(D0, 1, 0)>(vb); S##h1 = tr_read<v_rd_off(D0, 1, 1)>(vb); \
                        S##l2 = tr_read<v_rd_off(D0, 2, 0)>(vb); S##h2 = tr_read<v_rd_off(D0, 2, 1)>(vb); S##l3 = tr_read<v_rd_off(D0, 3, 0)>(vb); S##h3 = tr_read<v_rd_off(D0, 3, 1)>(vb); }
#define MOBA_PK(L, H) (bf16x8){L[0], L[1], L[2], L[3], H[0], H[1], H[2], H[3]}
#define MOBA_MM(S, OD) OD = __builtin_amdgcn_mfma_f32_32x32x16_bf16(MOBA_PK(S##l0, S##h0), pb0, OD, 0, 0, 0); OD = __builtin_amdgcn_mfma_f32_32x32x16_bf16(MOBA_PK(S##l1, S##h1), pb1, OD, 0, 0, 0); \
                       OD = __builtin_amdgcn_mfma_f32_32x32x16_bf16(MOBA_PK(S##l2, S##h2), pb2, OD, 0, 0, 0); OD = __builtin_amdgcn_mfma_f32_32x32x16_bf16(MOBA_PK(S##l3, S##h3), pb3, OD, 0, 0, 0)
#define MOBA_WAIT(N) asm volatile("s_waitcnt lgkmcnt(" #N ")" ::: "memory"); __builtin_amdgcn_sched_barrier(0)
__device__ __forceinline__ void pv_all(f32x16 (&o)[4], int vb, bf16x8 pb0, bf16x8 pb1, bf16x8 pb2, bf16x8 pb3, int abl = 0) {
    const s16x4 fk = {pb0[0], pb0[1], pb0[2], pb0[3]};
    s16x4 Al0, Ah0, Al1, Ah1, Al2, Ah2, Al3, Ah3, Bl0, Bh0, Bl1, Bh1, Bl2, Bh2, Bl3, Bh3;
#define MOBA_MM2(OA, OB) OA = __builtin_amdgcn_mfma_f32_32x32x16_bf16(MOBA_PK(Al0, Ah0), pb0, OA, 0, 0, 0); OB = __builtin_amdgcn_mfma_f32_32x32x16_bf16(MOBA_PK(Bl0, Bh0), pb0, OB, 0, 0, 0); \
                         OA = __builtin_amdgcn_mfma_f32_32x32x16_bf16(MOBA_PK(Al1, Ah1), pb1, OA, 0, 0, 0); OB = __builtin_amdgcn_mfma_f32_32x32x16_bf16(MOBA_PK(Bl1, Bh1), pb1, OB, 0, 0, 0); \
                         OA = __builtin_amdgcn_mfma_f32_32x32x16_bf16(MOBA_PK(Al2, Ah2), pb2, OA, 0, 0, 0); OB = __builtin_amdgcn_mfma_f32_32x32x16_bf16(MOBA_PK(Bl2, Bh2), pb2, OB, 0, 0, 0); \
                         OA = __builtin_amdgcn_mfma_f32_32x32x16_bf16(MOBA_PK(Al3, Ah3), pb3, OA, 0, 0, 0); OB = __builtin_amdgcn_mfma_f32_32x32x16_bf16(MOBA_PK(Bl3, Bh3), pb3, OB, 0, 0, 0)
    MOBA_RD8(A, 0); MOBA_RD8(B, 1);
    MOBA_WAIT(0); MOBA_MM2(o[0], o[1]); __builtin_amdgcn_sched_barrier(0);
    MOBA_RD8(A, 2); MOBA_RD8(B, 3);
    MOBA_WAIT(0); MOBA_MM2(o[2], o[3]);
#undef MOBA_MM2
}
#undef MOBA_RD8
#undef MOBA_PK
#undef MOBA_MM
#undef MOBA_WAIT
__device__ __forceinline__ float max3f(float a, float b, float c) { float r; asm("v_max3_f32 %0, %1, %2, %3" : "=v"(r) : "v"(a), "v"(b), "v"(c)); return r; }
__device__ __forceinline__ bf16x8 pack_p(const f32x16& p, int base) {
    v4u w; w.x = cvtpk(p[base + 0], p[base + 1]); w.y = cvtpk(p[base + 2], p[base + 3]); w.z = cvtpk(p[base + 4], p[base + 5]); w.w = cvtpk(p[base + 6], p[base + 7]);
    return __builtin_bit_cast(bf16x8, w);
}

typedef int i32x4m __attribute__((ext_vector_type(4))); typedef int i32x8m __attribute__((ext_vector_type(8)));
__device__ __forceinline__ void attn_phase(const Ctx& C, const bf16* Qb, const bf16* Kb, const bf16* Vb, const unsigned* lists, const unsigned* lcnt, gu32* qctr,
                                           bf16* POa, bf16* POb, float* LSE, const float* q_gain, const float* k_gain, int abl = 0) {
    LAS unsigned char* lds = C.lds;
    const int lane = C.lane, r32 = lane & 31, hi = lane >> 5;
    int koff[4];
#pragma unroll
    for (int c4 = 0; c4 < 4; ++c4) koff[c4] = r32 * 128 + ((((c4 >> 1) * 4 + 2 * hi + (c4 & 1)) ^ (r32 & 7)) << 4);
    const int vb0 = (int)(uintptr_t)(lds + 65536) + v_rd_base(lane);
    bool bounded;
    { float gq = 0.f, gk = 0.f;
#pragma unroll
        for (int i = 0; i < 2; ++i) { gq = fmaxf(gq, fabsf(q_gain[lane + 64 * i])); gk = fmaxf(gk, fabsf(k_gain[lane + 64 * i])); }
#pragma unroll
        for (int o_ = 1; o_ < 64; o_ <<= 1) { gq = fmaxf(gq, __shfl_xor(gq, o_)); gk = fmaxf(gk, __shfl_xor(gk, o_)); }
        bounded = (gq * gk * 11.313708499f * 1.4426950408889634f * 1.02f) <= 40.0f; }
#ifdef ATTN_PROBE
    unsigned long long pr_step = 0, pr_nstep = 0, pr_stage = 0, pr_nunit = 0, pr_tile = 0, pr_ntile = 0, pr_ta = 0, pr_tb = 0, pr_tc = 0; const unsigned long long pr_t0 = clock64();
#define PR_T() clock64()
#endif
    const bool tab = (C.G == 256); const unsigned short* sched = C.local ? ATT_SCHED_PAIR + (C.vcu & 63) * 8 : ATT_SCHED + (blockIdx.x & 255) * 8;
    const unsigned bh0 = 8u * (unsigned)(C.vcu >> 6);
#define MOBA_SCHED(K) ((K) < 8 ? (C.local ? (sched[K] == 0xFFFFu ? 0xFFFFu : ((unsigned)(sched[K] >> 3) << 5) + bh0 + (unsigned)(sched[K] & 7)) : (unsigned)sched[K]) : 0xFFFFu)
    unsigned u = tab ? MOBA_SCHED(0) : (unsigned)blockIdx.x;
    for (int k = 0; u < 1024u; ++k) {
        const int j = (int)(u >> 5), bh = (int)(u & 31u), b = bh >> 3, h = bh & 7;
#ifdef ATTN_PROBE
        const unsigned long long pr_s0 = PR_T();
#endif
        v4u kreg[8], vreg[8];
        int tidv = C.tid; asm volatile("" : "+v"(tidv));
        { const bf16* Kg = Kb + (size_t)(b * SEQ + j * 256) * DM + h * HD; const bf16* Vg = Vb + (size_t)((b * SEQ + j * 256) >> 12) * VXTRA + (size_t)(b * SEQ + j * 256) * DM + h * HD;
#pragma unroll
            for (int i = 0; i < 8; ++i) { const int c = tidv + i * NT, row = c >> 4, ch = c & 15;
                kreg[i] = *(const v4u*)(Kg + (size_t)row * DM + ch * 8); vreg[i] = *(const v4u*)(Vg + (size_t)row * DM + ch * 8); } }
        int cnt = (int)lcnt[bh * 32 + j]; cnt = cnt > LCAP ? LCAP : cnt;
        const unsigned* lst = lists + list_off(bh, j);
        const int G = (cnt + 31) >> 5, ntiles = G + 8;
        int r32l = r32; asm volatile("" : "+v"(r32l));
#define MOBA_ENTRY(E, T) do { if ((T) >= G) E = ((unsigned)(j * 256 + (7 - ((T) - G)) * 32 + r32l) << 2); else E = lst[(T) * 32 + r32l]; } while (0)
#define MOBA_LOADQ(QV, E) do { const bf16* qp_ = Qb + (size_t)(b * SEQ + ((abl & 2) ? r32 : (int)(((E) >> 2) & 8191u))) * DM + h * HD + hi * 8; _Pragma("unroll") for (int d0 = 0; d0 < 8; ++d0) QV[d0] = *(const bf16x8*)(qp_ + d0 * 16); } while (0)
#define MOBA_FETCH(T) do { int t_ = 0; if (lane == 0) t_ = (int)__hip_atomic_fetch_add((LAS unsigned*)(C.misc + 1), 1u, __ATOMIC_RELAXED, __HIP_MEMORY_SCOPE_WORKGROUP); T = __builtin_amdgcn_readfirstlane(t_); } while (0)
        int t0 = C.wave, t1 = C.wave + 8; unsigned e0 = 0u, e1 = 0u;
        if (t0 < ntiles) MOBA_ENTRY(e0, t0);
        if (t1 < ntiles) MOBA_ENTRY(e1, t1);
#ifdef ATTN_PROBE
        asm volatile("s_waitcnt vmcnt(0) lgkmcnt(0)" ::: "memory"); const unsigned long long pr_s1 = PR_T();
#endif
        __syncthreads();
#ifdef ATTN_PROBE
        const unsigned long long pr_s2 = PR_T();
#endif
        if (C.tid == 0) C.misc[1] = 16u;
        bf16x8 qr[8];
        MOBA_LOADQ(qr, e0);
#pragma unroll
        for (int i = 0; i < 8; ++i) { const int c = tidv + i * NT, row = c >> 4, ch = c & 15;
            { const v4u kw = kreg[i]; unsigned w0 = 0u, w1 = 0u;
                w0 = __builtin_amdgcn_cvt_pk_fp8_f32(bf_lo(kw.x), bf_hi(kw.x), w0, false); w0 = __builtin_amdgcn_cvt_pk_fp8_f32(bf_lo(kw.y), bf_hi(kw.y), w0, true);
                w1 = __builtin_amdgcn_cvt_pk_fp8_f32(bf_lo(kw.z), bf_hi(kw.z), w1, false); w1 = __builtin_amdgcn_cvt_pk_fp8_f32(bf_lo(kw.w), bf_hi(kw.w), w1, true);
                const int s_ = ch >> 1, off_ = (s_ >> 2) * 64 + (ch & 1) * 32 + (s_ & 3) * 8;
                *(LAS unsigned long long*)(lds + row * 128 + ((((off_ >> 4) ^ (row & 7)) << 4) | (off_ & 8))) = (unsigned long long)w0 | ((unsigned long long)w1 << 32); }
            *(LAS v4u*)(lds + 65536 + (row >> 6) * 16384 + v_st(row & 63, ch * 8)) = vreg[i]; }
        __syncthreads();
#ifdef ATTN_PROBE
        { const unsigned long long pr_s3 = PR_T(); pr_stage += pr_s3 - pr_s0; pr_nunit += 1; pr_ta += pr_s1 - pr_s0; pr_tb += pr_s2 - pr_s1; pr_tc += pr_s3 - pr_s2; }
#endif
        unsigned opk[16]; unsigned oent = 0u; float olse = 0.f, oscl = 0.f; bool ovalid = false;
#define MOBA_FLUSH() do { if (ovalid) { const int sq_ = (int)((oent >> 2) & 8191u), sl_ = (int)(oent & 3u); \
            unsigned char* dst_ = (unsigned char*)(sl_ < 2 ? POa : POb) + po_off(sl_, b * SEQ + sq_) + h * HD + 16 * hi; \
            _Pragma("unroll") for (int i_ = 0; i_ < 4; ++i_) { v4u w_; w_.x = opk[4 * i_]; w_.y = opk[4 * i_ + 1]; w_.z = opk[4 * i_ + 2]; w_.w = opk[4 * i_ + 3]; *(v4u*)(dst_ + 32 * i_) = w_; } \
            if (hi == 0) ((float*)POa)[psc_off(b * SEQ + sq_, h) + sl_] = oscl; \
            if (hi == 0) LSE[((size_t)bh * SEQ + sq_) * 4 + sl_] = olse; } } while (0)
        if ((abl & 128) && C.wave >= 4) t0 = ntiles;
        while (t0 < ntiles) {
            bf16x8 qn[8];
            MOBA_LOADQ(qn, e1);
            int t2; unsigned e2 = 0u; MOBA_FETCH(t2); if (t2 < ntiles) MOBA_ENTRY(e2, t2);
            if (!(abl & 1)) MOBA_FLUSH();
            const int sq = (int)((e0 >> 2) & 8191u);
            const bool causal = t0 >= G; const int nkt = (abl & 4) ? 1 : (causal ? (((7 - (t0 - G)) >> 1) + 1) : 4);
            const bool valid = causal || (t0 * 32 + r32 < cnt);
#ifdef ATTN_PROBE
            const unsigned long long pr_a = PR_T();
#endif
            const int qpos = sq & 255;
            float m = bounded ? 0.0f : -1e30f, l = 0.f; f32x16 o[4];
#pragma unroll
            for (int d0 = 0; d0 < 4; ++d0) o[d0] = f32x16{};
            i32x8m q8[2];
#pragma unroll
            for (int s2 = 0; s2 < 2; ++s2) { unsigned w[8];
#pragma unroll
                for (int s = 0; s < 4; ++s) { const v4u qw = __builtin_bit_cast(v4u, qr[4 * s2 + s]); unsigned w0 = 0u, w1 = 0u;
                    w0 = __builtin_amdgcn_cvt_pk_fp8_f32(bf_lo(qw.x), bf_hi(qw.x), w0, false); w0 = __builtin_amdgcn_cvt_pk_fp8_f32(bf_lo(qw.y), bf_hi(qw.y), w0, true);
                    w1 = __builtin_amdgcn_cvt_pk_fp8_f32(bf_lo(qw.z), bf_hi(qw.z), w1, false); w1 = __builtin_amdgcn_cvt_pk_fp8_f32(bf_lo(qw.w), bf_hi(qw.w), w1, true);
                    w[2 * s] = w0; w[2 * s + 1] = w1; }
                q8[s2] = (i32x8m){(int)w[0], (int)w[1], (int)w[2], (int)w[3], (int)w[4], (int)w[5], (int)w[6], (int)w[7]}; }
#ifdef ATTN_PROBE
            const unsigned long long pr_b = PR_T();
#endif
            for (int kt = 0; kt < nkt; ++kt) {
                f32x16 p0 = f32x16{}, p1 = f32x16{};
#define MOBA_KRD(DST, C4, HALF) asm volatile("ds_read_b128 %0, %1 offset:%2" : "=&v"(DST) : "v"(kbase + koff[C4]), "i"((HALF) * 4096) : "memory")
#define MOBA_KWAIT(N) asm volatile("s_waitcnt lgkmcnt(" #N ")" ::: "memory"); __builtin_amdgcn_sched_barrier(0)
#define MOBA_CAT(A, B) __builtin_shufflevector(__builtin_bit_cast(i32x4m, A), __builtin_bit_cast(i32x4m, B), 0, 1, 2, 3, 4, 5, 6, 7)
                { const int kbase = (int)(uintptr_t)lds + kt * 8192;
                    v4u ka0, ka1, kb0, kb1, ka2, ka3, kb2, kb3;
                    MOBA_KRD(ka0, 0, 0); MOBA_KRD(ka1, 1, 0); MOBA_KRD(kb0, 0, 1); MOBA_KRD(kb1, 1, 1);
                    MOBA_KRD(ka2, 2, 0); MOBA_KRD(ka3, 3, 0); MOBA_KRD(kb2, 2, 1); MOBA_KRD(kb3, 3, 1);
                    MOBA_KWAIT(4);
                    p0 = __builtin_amdgcn_mfma_scale_f32_32x32x64_f8f6f4(MOBA_CAT(ka0, ka1), q8[0], p0, 0, 0, 0, 127, 0, 127);
                    p1 = __builtin_amdgcn_mfma_scale_f32_32x32x64_f8f6f4(MOBA_CAT(kb0, kb1), q8[0], p1, 0, 0, 0, 127, 0, 127);
                    MOBA_KWAIT(0);
                    p0 = __builtin_amdgcn_mfma_scale_f32_32x32x64_f8f6f4(MOBA_CAT(ka2, ka3), q8[1], p0, 0, 0, 0, 127, 0, 127);
                    p1 = __builtin_amdgcn_mfma_scale_f32_32x32x64_f8f6f4(MOBA_CAT(kb2, kb3), q8[1], p1, 0, 0, 0, 127, 0, 127); __builtin_amdgcn_sched_barrier(0); }
#undef MOBA_KRD
#undef MOBA_KWAIT
#undef MOBA_CAT
                if (causal && kt == nkt - 1) { const float NEG = -__builtin_inff(); const int kb = kt * 64 + 4 * hi;
#pragma unroll
                    for (int r = 0; r < 16; ++r) { const int kv = kb + (r & 3) + 8 * (r >> 2); if (kv > qpos) p0[r] = NEG; if (kv + 32 > qpos) p1[r] = NEG; } }
                if (!(abl & 8)) {
                float ps = 0.f;
                if (bounded) {
#pragma unroll
                    for (int r = 0; r < 16; ++r) { p0[r] = __builtin_amdgcn_exp2f(p0[r]); p1[r] = __builtin_amdgcn_exp2f(p1[r]); ps += p0[r] + p1[r]; }
                } else {
                float pm = max3f(p0[0], p1[0], p0[1]), pm2 = max3f(p1[1], p0[2], p1[2]);
#pragma unroll
                for (int r = 3; r < 15; r += 3) { pm = max3f(pm, p0[r], p1[r]); pm2 = max3f(pm2, p0[r + 1], p1[r + 1]); pm = max3f(pm, p0[r + 2], p1[r + 2]); }
                pm = max3f(pm, pm2, p0[15]); pm = max3f(pm, p1[15], m);
                { auto rr = __builtin_amdgcn_permlane32_swap(__float_as_uint(pm), __float_as_uint(pm), false, false); pm = max3f(__uint_as_float(rr[0]), __uint_as_float(rr[1]), m); }
                if (kt == 0) m = pm;
                else if (__any(pm > m + 8.0f)) { const float mn = pm > m + 8.0f ? pm : m, alpha = __builtin_amdgcn_exp2f(m - mn); m = mn; l = l * alpha;
#pragma unroll
                    for (int d0 = 0; d0 < 4; ++d0) o[d0] = o[d0] * alpha; }
#pragma unroll
                for (int r = 0; r < 16; ++r) { p0[r] = __builtin_amdgcn_exp2f(p0[r] - m); p1[r] = __builtin_amdgcn_exp2f(p1[r] - m); ps += p0[r] + p1[r]; }
                }
                l += ps;
                }
                const bf16x8 pb0 = pack_p(p0, 0), pb1 = pack_p(p0, 8), pb2 = pack_p(p1, 0), pb3 = pack_p(p1, 8);
                const int vb = vb0 + kt * 16384;
                if (!(abl & 16)) pv_all(o, vb, pb0, pb1, pb2, pb3, abl);
                else { asm volatile("" :: "v"(pb0), "v"(pb1), "v"(pb2), "v"(pb3)); }
            }
#ifdef ATTN_PROBE
            pr_step += PR_T() - pr_b; pr_nstep += nkt;
#endif
            { auto rr = __builtin_amdgcn_permlane32_swap(__float_as_uint(l), __float_as_uint(l), false, false); l = __uint_as_float(rr[0]) + __uint_as_float(rr[1]); }
            const float inv = 1.0f / l, lse = m + __builtin_amdgcn_logf(l);
            float amax = 0.f;
#pragma unroll
            for (int d0 = 0; d0 < 4; ++d0)
#pragma unroll
                for (int r = 0; r < 16; r += 2) amax = fmaxf(amax, fmaxf(fabsf(o[d0][r]), fabsf(o[d0][r + 1])));
            { auto rr = __builtin_amdgcn_permlane32_swap(__float_as_uint(amax), __float_as_uint(amax), false, false); amax = fmaxf(__uint_as_float(rr[0]), __uint_as_float(rr[1])); }
            amax = fmaxf(amax, 1e-30f);
            const float qinv = 127.0f / amax, oscale = amax * inv * (1.0f / 127.0f);
#pragma unroll
            for (int d0 = 0; d0 < 4; ++d0) {
                unsigned wg[4];
#pragma unroll
                for (int g = 0; g < 4; ++g) { unsigned w = 0u;
#pragma unroll
                    for (int e4 = 0; e4 < 4; ++e4) w = __builtin_amdgcn_cvt_pk_u8_f32(__builtin_rintf(__builtin_fmaf(o[d0][4 * g + e4], qinv, 128.0f)), (unsigned)e4, w);
                    wg[g] = w; }
                const auto r02 = __builtin_amdgcn_permlane32_swap(wg[0], wg[2], false, false), r13 = __builtin_amdgcn_permlane32_swap(wg[1], wg[3], false, false);
                opk[4 * d0] = r02[0]; opk[4 * d0 + 1] = r02[1]; opk[4 * d0 + 2] = r13[0]; opk[4 * d0 + 3] = r13[1]; }
            oscl = oscale;
            oent = e0; olse = lse; ovalid = valid;
            t0 = t1; e0 = e1; t1 = t2; e1 = e2;
#pragma unroll
            for (int d0 = 0; d0 < 8; ++d0) qr[d0] = qn[d0];
#ifdef ATTN_PROBE
            pr_tile += PR_T() - pr_a; pr_ntile += 1;
#endif
        }
        if (!(abl & 1)) MOBA_FLUSH();
#undef MOBA_FLUSH
#undef MOBA_FETCH
#undef MOBA_ENTRY
#undef MOBA_LOADQ
        u = tab ? MOBA_SCHED(k + 1) : u + (unsigned)C.G;
    }
#ifdef ATTN_PROBE
    if (lane == 0) { unsigned long long* pc = (unsigned long long*)((unsigned*)qctr + 512);
        atomicAdd(pc + 0, pr_step); atomicAdd(pc + 1, pr_nstep); atomicAdd(pc + 2, pr_stage); atomicAdd(pc + 3, pr_nunit); atomicAdd(pc + 4, pr_tile); atomicAdd(pc + 5, pr_ntile); atomicAdd(pc + 6, clock64() - pr_t0); atomicAdd(pc + 7, 1ull); atomicAdd(pc + 8, pr_ta); atomicAdd(pc + 9, pr_tb); atomicAdd(pc + 10, pr_tc); }
#endif
}
}

__device__ __forceinline__ void combine_phase(const Ctx& C, const bf16* __restrict__ POa, const bf16* __restrict__ POb, const float* __restrict__ LSE, bf16* __restrict__ AO) {
    const int gw = C.vcu * NWAVES + C.wave, NGW = C.G * NWAVES, h = C.lane >> 3, dch = (C.lane & 7) * 16;
    for (int tg = gw; tg < M / 16; tg += NGW) {
        const int tok0 = tg * 16, b = tok0 >> 13, nbk = (tok0 & (SEQ - 1)) >> 8, nv = 1 + (nbk < 3 ? nbk : 3);
#pragma unroll 4
        for (int r = 0; r < 16; ++r) {
            const int tok = tok0 + r, s = tok & (SEQ - 1);
            const size_t bhs = (size_t)(b * NH + h) * SEQ + s;
            const f32x4 ls = *(const f32x4*)(LSE + bhs * 4);
            v4u pa[4];
#pragma unroll
            for (int i = 0; i < 4; ++i) pa[i] = *(const v4u*)((const unsigned char*)(i < 2 ? POa : POb) + po_off(i, tok) + h * HD + dch);
            const f32x4 sc4 = *(const f32x4*)((const float*)POa + psc_off(tok, h));
            float mx = ls[0]; if (nv > 1) mx = fmaxf(mx, ls[1]); if (nv > 2) mx = fmaxf(mx, ls[2]); if (nv > 3) mx = fmaxf(mx, ls[3]);
            float w[4]; float wsum = 0.f;
#pragma unroll
            for (int i = 0; i < 4; ++i) { w[i] = i < nv ? __builtin_amdgcn_exp2f(ls[i] - mx) : 0.f; wsum += w[i]; }
            const float inv = 1.0f / wsum;
            float acc[16]; float wtot = 0.f;
#pragma unroll
            for (int e = 0; e < 16; ++e) acc[e] = 0.f;
#pragma unroll
            for (int i = 0; i < 4; ++i) {
                const float wi = i < nv ? w[i] * inv * sc4[i] : 0.f;
                wtot += wi;
                const unsigned q4[4] = {pa[i].x, pa[i].y, pa[i].z, pa[i].w};
#pragma unroll
                for (int k = 0; k < 4; ++k) { acc[4 * k] += wi * (float)(q4[k] & 255u); acc[4 * k + 1] += wi * (float)((q4[k] >> 8) & 255u); acc[4 * k + 2] += wi * (float)((q4[k] >> 16) & 255u); acc[4 * k + 3] += wi * (float)(q4[k] >> 24); } }
#pragma unroll
            for (int e = 0; e < 16; ++e) acc[e] -= 128.0f * wtot;
            v4u o0;
            o0.x = __builtin_amdgcn_cvt_pk_fp8_f32(16.f * acc[2], 16.f * acc[3], __builtin_amdgcn_cvt_pk_fp8_f32(16.f * acc[0], 16.f * acc[1], 0u, false), true);
            o0.y = __builtin_amdgcn_cvt_pk_fp8_f32(16.f * acc[6], 16.f * acc[7], __builtin_amdgcn_cvt_pk_fp8_f32(16.f * acc[4], 16.f * acc[5], 0u, false), true);
            o0.z = __builtin_amdgcn_cvt_pk_fp8_f32(16.f * acc[10], 16.f * acc[11], __builtin_amdgcn_cvt_pk_fp8_f32(16.f * acc[8], 16.f * acc[9], 0u, false), true);
            o0.w = __builtin_amdgcn_cvt_pk_fp8_f32(16.f * acc[14], 16.f * acc[15], __builtin_amdgcn_cvt_pk_fp8_f32(16.f * acc[12], 16.f * acc[13], 0u, false), true);
            *(v4u*)((unsigned char*)AO + (size_t)(tok >> 12) * F8_XS + (size_t)(tok & 4095) * DM + h * HD + dch) = o0;
        }
    }
}

#ifdef ATTN_SELFCHECK
__device__ __forceinline__ void check_phase(const Ctx& C, const bf16* Qb, const bf16* Kb, const bf16* Vb, const float* kmean, const bf16* AO, gu32* bad, gu32* skipped) {
    const int gw = C.vcu * NWAVES + C.wave, lane = C.lane;
    for (int rep = 0; rep < 4; ++rep) {
    const unsigned i = (unsigned)gw + 2048u * (unsigned)rep;
    const int b = i & 3, h = (i >> 2) & 7;
    int s;
    if (i < 512u) { const int k = i >> 5; const int offs[4] = {0, 1, 254, 255}; s = (k & 3) * 256 + offs[(k >> 2) & 3]; }
    else s = (int)((i * 2654435761u) >> 12) & (SEQ - 1);
    const int nb = s >> 8, bh = b * 8 + h;
    const bf16* qp = Qb + (size_t)(b * SEQ + s) * DM + h * HD;
    const unsigned qw = *(const unsigned*)(qp + 2 * lane); const float q0 = bf_lo(qw), q1 = bf_hi(qw);
    const float NEG = -__builtin_inff();
    float v0 = NEG, v1 = NEG, v2 = NEG, v3 = NEG; int i0 = -1, i1 = -1, i2 = -1;
    for (int j = 0; j < nb; ++j) { const float* km = kmean + (size_t)(bh * 32 + j) * 128; const float sc = wave_sum(q0 * km[2 * lane] + q1 * km[2 * lane + 1]);
        if (sc > v3) v3 = sc;
        if (sc > v2) { v3 = v2; if (sc > v1) { v2 = v1; i2 = i1; if (sc > v0) { v1 = v0; i1 = i0; v0 = sc; i0 = j; } else { v1 = sc; i1 = j; } } else { v2 = sc; i2 = j; } } }
    if (nb > 3 && (v2 - v3) < 2e-3f * (fabsf(v2) + fabsf(v3)) + 1e-6f) { if (lane == 0) atomicAdd((unsigned*)skipped, 1u); continue; }
    float m = -1e30f, l = 0.f, o0 = 0.f, o1 = 0.f;
    for (int t = 0; t < 4; ++t) { const int blk = t == 0 ? nb : (t == 1 ? i0 : (t == 2 ? i1 : i2)); if (blk < 0) continue;
        const int nk = t == 0 ? (s & 255) + 1 : 256;
        for (int k = 0; k < nk; ++k) { const size_t row = (size_t)(b * SEQ + blk * 256 + k) * DM + h * HD + 2 * lane;
            const unsigned kw = *(const unsigned*)(Kb + row), vw = *(const unsigned*)(Vb + (size_t)((b * SEQ + blk * 256 + k) >> 12) * VXTRA + row);
            const float sc = wave_sum(q0 * bf_lo(kw) + q1 * bf_hi(kw));
            const float mn = fmaxf(m, sc), al = __builtin_amdgcn_exp2f(m - mn), p = __builtin_amdgcn_exp2f(sc - mn); m = mn;
            l = l * al + p; o0 = o0 * al + p * bf_lo(vw); o1 = o1 * al + p * bf_hi(vw); } }
    const unsigned aw = *(const unsigned*)(AO + (size_t)(b * SEQ + s) * DM + h * HD + 2 * lane);
    const float r0 = o0 / l, r1 = o1 / l, e0 = fabsf(r0 - bf_lo(aw)), e1 = fabsf(r1 - bf_hi(aw));
    const bool wrong = !(e0 <= 2.5e-3f + 0.01f * fabsf(r0)) || !(e1 <= 2.5e-3f + 0.01f * fabsf(r1));
    if (__any(wrong)) { if (lane == 0) atomicAdd((unsigned*)bad, 1u); }
    }
}
#endif

__device__ __forceinline__ void conv_phase(const Ctx& C, const bf16* __restrict__ BG, const bf16* __restrict__ UU, const float* __restrict__ cw, bf16* __restrict__ Z) {
    const int gw = C.vcu * NWAVES + C.wave, NGW = C.G * NWAVES;
    for (int wu = gw * 2; wu < (M / 16) * 2; wu += ((wu & 1) ? NGW * 2 - 1 : 1)) {
        const int rg = wu >> 1, c0 = (wu & 1) * 512 + C.lane * 8, row0 = rg * 16;
        float w0[8], w1[8], w2[8];
#pragma unroll
        for (int e = 0; e < 8; ++e) { w0[e] = cw[c0 + e]; w1[e] = cw[DM + c0 + e]; w2[e] = cw[2 * DM + c0 + e]; }
        float p2[8], p1[8];
        if ((row0 & (SEQ - 1)) == 0) {
#pragma unroll
            for (int e = 0; e < 8; ++e) { p2[e] = 0.f; p1[e] = 0.f; }
        } else {
            const v4u a = *(const v4u*)(UU + (size_t)(row0 - 2) * DM + c0), c = *(const v4u*)(UU + (size_t)(row0 - 1) * DM + c0);
            p2[0] = bf_lo(a.x); p2[1] = bf_hi(a.x); p2[2] = bf_lo(a.y); p2[3] = bf_hi(a.y); p2[4] = bf_lo(a.z); p2[5] = bf_hi(a.z); p2[6] = bf_lo(a.w); p2[7] = bf_hi(a.w);
            p1[0] = bf_lo(c.x); p1[1] = bf_hi(c.x); p1[2] = bf_lo(c.y); p1[3] = bf_hi(c.y); p1[4] = bf_lo(c.z); p1[5] = bf_hi(c.z); p1[6] = bf_lo(c.w); p1[7] = bf_hi(c.w);
        }
#pragma unroll 4
        for (int r = 0; r < 16; ++r) {
            const v4u a = *(const v4u*)(UU + (size_t)(row0 + r) * DM + c0), g = *(const v4u*)(BG + (size_t)(row0 + r) * DM + c0);
            float cu[8], bg[8], z[8];
            cu[0] = bf_lo(a.x); cu[1] = bf_hi(a.x); cu[2] = bf_lo(a.y); cu[3] = bf_hi(a.y); cu[4] = bf_lo(a.z); cu[5] = bf_hi(a.z); cu[6] = bf_lo(a.w); cu[7] = bf_hi(a.w);
            bg[0] = bf_lo(g.x); bg[1] = bf_hi(g.x); bg[2] = bf_lo(g.y); bg[3] = bf_hi(g.y); bg[4] = bf_lo(g.z); bg[5] = bf_hi(g.z); bg[6] = bf_lo(g.w); bg[7] = bf_hi(g.w);
#pragma unroll
            for (int e = 0; e < 8; ++e) { z[e] = bg[e] * (w0[e] * p2[e] + w1[e] * p1[e] + w2[e] * cu[e]); p2[e] = p1[e]; p1[e] = cu[e]; }
            v4u o; o.x = pk2(z[0], z[1]); o.y = pk2(z[2], z[3]); o.z = pk2(z[4], z[5]); o.w = pk2(z[6], z[7]);
            *(v4u*)(Z + (size_t)(row0 + r) * DM + c0) = o;
        }
    }
}

__device__ __forceinline__ void xcd_local_barrier(const XcdBarrier& b) {
    asm volatile("s_waitcnt vmcnt(0)" ::: "memory");
    __syncthreads();
    if (threadIdx.x == 0) {
        unsigned* bar = b.bar;
        __builtin_amdgcn_s_waitcnt(0);
        const unsigned nloc = b.st[0];
        const unsigned old = xb_add(&bar[XB_XSUB(b.x)], 1u);
        const unsigned gen = old / nloc;
        if (old + 1u == (gen + 1u) * nloc) xb_add(&bar[XB_XGEN(b.x)], 1u);
        else XB_SPIN(xb_ld(&bar[XB_XGEN(b.x)]) == gen, bar);
        __builtin_amdgcn_fence(__ATOMIC_ACQUIRE, "agent");
        asm volatile("s_waitcnt vmcnt(0)" ::: "memory");
    }
    __syncthreads();
}

__device__ __forceinline__ void xcd_pair_barrier(const XcdBarrier& b, unsigned* ptop) {
    asm volatile("s_waitcnt vmcnt(0)" ::: "memory");
    __syncthreads();
    if (threadIdx.x == 0) {
        unsigned* bar = b.bar;
        __builtin_amdgcn_s_waitcnt(0);
        const unsigned nloc = b.st[0];
        const unsigned old = xb_add(&bar[XB_XSUB(b.x)], 1u);
        const unsigned gen = old / nloc;
        if (old + 1u == (gen + 1u) * nloc) {
            __builtin_amdgcn_fence(__ATOMIC_RELEASE, "agent");
            asm volatile("s_waitcnt vmcnt(0)" ::: "memory");
            const unsigned og = xb_add(ptop, 1u);
            const unsigned tg = og / 2u;
            if (og + 1u == (tg + 1u) * 2u) xb_add(ptop + 64, 1u);
            else XB_SPIN(xb_ld(ptop + 64) == tg, bar);
            __builtin_amdgcn_fence(__ATOMIC_ACQUIRE, "agent");
            xb_add(&bar[XB_XGEN(b.x)], 1u);
            asm volatile("s_waitcnt vmcnt(0)" ::: "memory");
        } else {
            XB_SPIN(xb_ld(&bar[XB_XGEN(b.x)]) == gen, bar);
            __builtin_amdgcn_fence(__ATOMIC_ACQUIRE, "agent");
            asm volatile("s_waitcnt vmcnt(0)" ::: "memory");
        }
    }
    __syncthreads();
}

#ifndef KN_WGM_QKV
#define KN_WGM_QKV 4
#endif
#ifndef KN_WGM_GU
#define KN_WGM_GU 4
#endif
#ifndef KN_WGM_RES
#define KN_WGM_RES 4
#endif
#ifndef ATTN_ABL
#define ATTN_ABL 0
#endif
#ifndef KN_SP2
#define KN_SP2 true
#endif
#ifndef KN_ALIGN_RES
#define KN_ALIGN_RES true
#endif
#ifndef KN_ALIGN_FFN
#define KN_ALIGN_FFN true
#endif
constexpr int N_PHASES = 17;
struct Args { const float* in[15]; float* out; unsigned char* ws; int ph_lo, ph_hi; };
static_assert(sizeof(Args) == 15 * 8 + 8 + 8 + 8, "Args has no padding");

__global__ void __launch_bounds__(NT, 2) moba_fwd(Args args) {
    extern __shared__ __attribute__((aligned(16))) unsigned char lds_raw[];
    Ctx C;
    C.lds = (LAS unsigned char*)lds_raw; C.misc = (volatile LAS unsigned*)(C.lds + MISC_OFF);
    C.tid = threadIdx.x; C.lane = C.tid & 63; C.wave = __builtin_amdgcn_readfirstlane(C.tid >> 6);
    C.local = 0; C.G = gridDim.x; { const int bx = blockIdx.x; C.vcu = (C.G % 8 == 0) ? (bx % 8) * (C.G / 8) + bx / 8 : bx; }
    unsigned char* ws = args.ws;
    gu32* ctl = (gu32*)(ws + WS_CTL);
    if (C.tid < 32) C.misc[C.tid] = 0u;
    __syncthreads();
    const int lo = args.ph_lo, hi = args.ph_hi;
    XcdBarrier bar; bar.bar = (unsigned*)ctl + CW_BAR; bar.x = 0; bar.st = nullptr;
    if (hi - lo > 1) { bar = xcd_barrier_post((unsigned*)ctl + CW_BAR, C.misc + 8);
        if (C.tid == 0) C.misc[12] = __hip_atomic_fetch_add(ctl + CW_RANK + 64 * bar.x, 1u, __ATOMIC_RELAXED, __HIP_MEMORY_SCOPE_AGENT); }
    bool local = false; int cvb = (int)blockIdx.x;
#ifndef PHASE_MASK
#define PHASE_MASK 0x1ffff
#endif
#define IN(k) ((((PHASE_MASK) >> (k)) & 1) && lo <= (k) && (k) < hi)
#ifndef REPEAT_MASK
#define REPEAT_MASK 0
#endif
#define REP(k) (((REPEAT_MASK) >> (k)) & 1)
#define SEAM(k) do { if (IN(k) && IN((k) + 1)) xcd_barrier(bar); } while (0)
    const float* x = args.in[0]; float* out = args.out;
    float* mod = (float*)(ws + WS_MOD); float* kmean = (float*)(ws + WS_KMEAN);
    bf16* HB = (bf16*)(ws + WS_H); bf16* QB = (bf16*)(ws + WS_Q); bf16* KB = (bf16*)(ws + WS_K); bf16* VB = (bf16*)(ws + WS_V);
    bf16* POa = (bf16*)out; bf16* POb = (bf16*)(ws + WS_POB); float* LSE = (float*)(ws + WS_LSE); unsigned* lists = (unsigned*)(ws + WS_LIST);
    bf16* FB = (bf16*)(ws + WS_FB); bf16* YB = (bf16*)(ws + WS_YB);
    bf16* ACT = (bf16*)(ws + WS_ACT); bf16* BG = (bf16*)(ws + WS_BG); bf16* UU = (bf16*)(ws + WS_UU); bf16* ZB = (bf16*)(ws + WS_Z);
    bf16* XR = (bf16*)(ws + WS_XB);
    LAS unsigned char* ring = C.lds;

    if (IN(0)) p0_prologue(C, args.in, ws, 0, C.vcu, C.G); SEAM(0);
    if (lo == 0 && hi == N_PHASES && IN(0)) {
        if (C.tid == 0) { unsigned nz = 0, below = 0; bool ok = C.G == 256;
            for (unsigned j = 0; j < 16; ++j) { const unsigned c = xb_ld(bar.bar + XB_XCNT(j)); if (c) { ok = ok && c == 32u; ++nz; if (j < bar.x) ++below; } }
            ok = ok && nz == 8u && C.misc[12] < 32u;
#ifdef FORCE_NO_LOCAL
            ok = false;
#endif
            C.misc[13] = ok ? (0x80000000u | (below * 32u + C.misc[12])) : 0u; }
        __syncthreads();
        const unsigned w = C.misc[13];
        if (w >> 31) { local = true; C.local = 1; C.vcu = (int)(w & 255u); cvb = (C.vcu & 31) * 8 + (C.vcu >> 5); }
#ifdef STAGGER_TICKS
        if (local && C.vcu >= 128) { const unsigned long long t0_ = __builtin_amdgcn_s_memrealtime(); while (__builtin_amdgcn_s_memrealtime() - t0_ < (unsigned long long)(STAGGER_TICKS)) __builtin_amdgcn_s_sleep(8); }
#endif
    }
    if (IN(0)) {
        const bool do_late = !local || C.vcu >= 128;
        if (do_late) p0_prologue(C, args.in, ws, 1, local ? C.vcu - 128 : C.vcu, local ? 128 : C.G);
        if (local) { if (do_late) { asm volatile("s_waitcnt vmcnt(0)" ::: "memory"); __syncthreads();
                         if (C.tid == 0) { __builtin_amdgcn_fence(__ATOMIC_RELEASE, "agent"); asm volatile("s_waitcnt vmcnt(0)" ::: "memory"); (void)xb_add((unsigned*)ctl + CW_LATE, 1u); } } }
        else if (IN(1) && hi - lo > 1) xcd_barrier(bar);
    }
    float* C0 = (float*)(ws + WS_C0); float* D0 = (float*)(ws + WS_D0);
#define CNT_PUBLISH(W) do { asm volatile("s_waitcnt vmcnt(0)" ::: "memory"); __syncthreads(); \
        if (C.tid == 0) { __builtin_amdgcn_fence(__ATOMIC_RELEASE, "agent"); asm volatile("s_waitcnt vmcnt(0)" ::: "memory"); (void)xb_add((unsigned*)ctl + (W), 1u); } } while (0)
#define CNT_WAIT(W, N) do { if (C.tid == 0) { XB_SPIN(xb_ld((unsigned*)ctl + (W)) < (unsigned)(N), bar.bar); __builtin_amdgcn_fence(__ATOMIC_ACQUIRE, "agent"); asm volatile("s_waitcnt vmcnt(0)" ::: "memory"); } \
        __syncthreads(); } while (0)
    if (IN(0) && (!local || C.vcu < 128)) {
        for (int w = C.vcu; w < 192; w += local ? 128 : C.G) gemv4_phase(C, args.in[6], 3 * DM, 3 * DM, mod, MODW, C0, 3 * DM, w);
        CNT_PUBLISH(CW_C0); }
#define PSEAM(k) do { if (IN(k) && IN((k) + 1)) { if (local) xcd_pair_barrier(bar, (unsigned*)ctl + CW_PAIR + 128 * (C.vcu >> 6)); else xcd_barrier(bar); } } while (0)
#define LSEAM(k) do { if (IN(k) && IN((k) + 1)) { if (local) xcd_local_barrier(bar); else xcd_barrier(bar); } } while (0)
    if (IN(1)) for (int rep = 0; rep <= REP(1); ++rep) { if (rep) xcd_barrier(bar); modulate_phase<false, false, false, true, true>(C, x, args.in[4], mod, 0, DM, HB, nullptr, 0, nullptr, 0, XR); } LSEAM(1);
    if (IN(0) && IN(2)) CNT_WAIT(CW_C0, local ? 128 : C.G);
    if (IN(2)) for (int rep = 0; rep <= REP(2); ++rep) { if (rep) xcd_barrier(bar); pg8::Gemm g{HB, (const bf16*)(ws + WS_WQKV), M, 3 * DM, DM / 2, F8_XS - 4 * MiB, 122, 127};     pg8::StaticOrder S; S.init(M, 3 * DM, C.G, cvb, KN_WGM_QKV);
        pg8::EpiQKV E{QB, KB, VB, args.in[8], args.in[9], (LAS float*)(C.lds + EPI_OFF), QSCALE, kmean, VXTRA, C0};
        pg8::gemm_phase<pg8::EpiQKV, pg8::StaticOrder, true, KN_SP2, true>(ring, g, S, E); } PSEAM(2);
    if (IN(0) && IN(3) && (C.vcu & 3) == 0) { gemv4_phase(C, args.in[7], DM, DM, C0 + 2 * DM, 3 * DM, D0, DM, C.vcu >> 2); CNT_PUBLISH(CW_D0); }
    if (IN(3)) for (int rep = 0; rep <= REP(3); ++rep) { if (rep) xcd_barrier(bar); route_phase(C, QB, kmean, lists, ctl + CW_LCNT); } PSEAM(3);
    if (IN(4)) for (int rep = 0; rep <= REP(4); ++rep) { if (rep) xcd_barrier(bar); moba::attn_phase(C, QB, KB, VB, lists, (const unsigned*)(ws + WS_CTL) + CW_LCNT, ctl + CW_QCTR + 64 * rep, POa, POb, LSE, args.in[8], args.in[9], rep ? ATTN_ABL : 0); } PSEAM(4);
    if (IN(5)) for (int rep = 0; rep <= REP(5); ++rep) { if (rep) xcd_barrier(bar); combine_phase(C, POa, POb, LSE, HB); }
#ifdef ATTN_SELFCHECK
    xcd_barrier(bar); check_phase(C, QB, KB, VB, kmean, HB, ctl + 256, ctl + 320);
#endif
    LSEAM(5);
    if (local && IN(0) && IN(6)) {
        if (C.tid == 0) { XB_SPIN(xb_ld((unsigned*)ctl + CW_LATE) < 128u, bar.bar); __builtin_amdgcn_fence(__ATOMIC_ACQUIRE, "agent"); asm volatile("s_waitcnt vmcnt(0)" ::: "memory"); }
        __syncthreads(); }
    if (IN(6)) for (int rep = 0; rep <= REP(6); ++rep) { if (rep) xcd_barrier(bar); pg8::Gemm g{HB, (const bf16*)(ws + WS_WO), M, DM, DM / 2, F8_XS - 4 * MiB, 122, 123};     pg8::StaticOrder S; S.init(M, DM, C.G, cvb, KN_WGM_RES);
        pg8::EpiPlain8 E{(unsigned char*)YB, F8_XS - 4 * MiB};
        pg8::gemm_phase<pg8::EpiPlain8, pg8::StaticOrder, KN_ALIGN_RES, KN_SP2, true>(ring, g, S, E); } LSEAM(6);
    if (IN(0) && IN(7)) CNT_WAIT(CW_D0, C.G / 4);
    if (IN(7)) for (int rep = 0; rep <= REP(7); ++rep) { if (rep) xcd_barrier(bar); modulate_phase<true, true, false, false, false, true, true>(C, XR, args.in[5], mod, 3 * DM, 4 * DM, HB, YB, 2 * DM, nullptr, 0, nullptr, D0); } LSEAM(7);
    if (IN(8)) for (int rep = 0; rep <= REP(8); ++rep) { if (rep) xcd_barrier(bar); pg8::Gemm g{HB, (const bf16*)(ws + WS_WGU0), M, 2 * FF, DM}; pg8::StaticOrder S; S.init(M, 2 * FF, C.G, cvb, KN_WGM_GU);
        pg8::EpiSwiglu E{ACT, FF, AXTRA};
        pg8::gemm_phase<pg8::EpiSwiglu, pg8::StaticOrder, KN_ALIGN_FFN, KN_SP2>(ring, g, S, E); } LSEAM(8);
    if (IN(9)) for (int rep = 0; rep <= REP(9); ++rep) { if (rep) xcd_barrier(bar); pg8::Gemm g{ACT, (const bf16*)(ws + WS_WDN0), M, DM, FF, AXTRA * 2}; pg8::StaticOrder S; S.init(M, DM, C.G, cvb, KN_WGM_RES);
        pg8::EpiResidX2 E{XR, mod + 5 * DM, (const unsigned char*)YB, F8_XS - 4 * MiB, mod + 2 * DM, D0};
        pg8::gemm_phase<pg8::EpiResidX2, pg8::StaticOrder, KN_ALIGN_RES, KN_SP2>(ring, g, S, E); } LSEAM(9);
    const float* mod1 = mod + 4 * MODW;
    if (IN(10)) for (int rep = 0; rep <= REP(10); ++rep) { if (rep) xcd_barrier(bar); modulate_phase<true, false, false, false>(C, XR, args.in[4] + DM, mod, 4 * MODW, 4 * MODW + DM, HB); } LSEAM(10);
    if (IN(11)) for (int rep = 0; rep <= REP(11); ++rep) { if (rep) xcd_barrier(bar); pg8::Gemm g{HB, (const bf16*)(ws + WS_WIN), M, 3 * DM, DM}; pg8::StaticOrder S; S.init(M, 3 * DM, C.G, cvb, KN_WGM_QKV);
        pg8::EpiConvIn E{BG, UU};
        pg8::gemm_phase<pg8::EpiConvIn, pg8::StaticOrder, KN_ALIGN_FFN, KN_SP2>(ring, g, S, E); } PSEAM(11);
    if (IN(12)) for (int rep = 0; rep <= REP(12); ++rep) { if (rep) xcd_barrier(bar); conv_phase(C, BG, UU, args.in[11], ZB); } LSEAM(12);
    if (IN(13)) for (int rep = 0; rep <= REP(13); ++rep) { if (rep) xcd_barrier(bar); pg8::Gemm g{ZB, (const bf16*)(ws + WS_WOUT), M, DM, DM}; pg8::StaticOrder S; S.init(M, DM, C.G, cvb, KN_WGM_RES);
        pg8::EpiPlain E{YB};
        pg8::gemm_phase<pg8::EpiPlain, pg8::StaticOrder, KN_ALIGN_RES, KN_SP2>(ring, g, S, E); } LSEAM(13);
    if (IN(14)) for (int rep = 0; rep <= REP(14); ++rep) { if (rep) xcd_barrier(bar); modulate_phase<true, true, false, false>(C, XR, args.in[5] + DM, mod1, 3 * DM, 4 * DM, HB, YB, 2 * DM); } LSEAM(14);
    if (IN(15)) for (int rep = 0; rep <= REP(15); ++rep) { if (rep) xcd_barrier(bar); pg8::Gemm g{HB, (const bf16*)(ws + WS_WGU1), M, 2 * FF, DM}; pg8::StaticOrder S; S.init(M, 2 * FF, C.G, cvb, KN_WGM_GU);
        pg8::EpiSwiglu8 E{(unsigned char*)ACT, FF, XCHUNK - 4096 * (size_t)FF};
        pg8::gemm_phase<pg8::EpiSwiglu8, pg8::StaticOrder, KN_ALIGN_FFN, KN_SP2>(ring, g, S, E); } LSEAM(15);
    if (IN(16)) for (int rep = 0; rep <= REP(16); ++rep) { if (rep) xcd_barrier(bar); pg8::Gemm g{ACT, (const bf16*)(ws + WS_WDN1), M, DM, FF / 2, XCHUNK - 4096 * (size_t)FF, 122, 127};     pg8::StaticOrder S; S.init(M, DM, C.G, cvb, KN_WGM_RES);
        pg8::EpiResid E{XR, out, mod1 + 5 * DM, YB, mod1 + 2 * DM};
        pg8::gemm_phase<pg8::EpiResid, pg8::StaticOrder, KN_ALIGN_RES, KN_SP2, true>(ring, g, S, E); }
#ifdef ATTN_SELFCHECK
    xcd_barrier(bar);
    if (blockIdx.x == 0 && C.tid == 0) { const unsigned nbad = __hip_atomic_load(ctl + 256, __ATOMIC_RELAXED, __HIP_MEMORY_SCOPE_AGENT), nskip = __hip_atomic_load(ctl + 320, __ATOMIC_RELAXED, __HIP_MEMORY_SCOPE_AGENT);
        out[0] += 1.0f * (float)nbad; out[1] += 0.125f + 0.001f * (float)nskip; }
#endif
#ifdef ATTN_PROBE
    xcd_barrier(bar);
    if (blockIdx.x == 0 && C.tid == 0) { const unsigned long long* pc = (const unsigned long long*)((const unsigned*)(ctl + CW_QCTR) + 512);
        const double v0 = (double)pc[0] / (double)pc[1], v1 = 100.0 * (double)pc[0] / (double)pc[6], v2 = (double)pc[2] / (double)pc[3], v3 = (double)pc[4] / (double)pc[5], v4 = (double)pc[6] / (double)pc[7], v5 = (double)pc[1] / (double)pc[7];
        const double sel[10] = {v0, v1, v2, v3, v4, v5, (double)pc[8] / (double)pc[3], (double)pc[9] / (double)pc[3], (double)pc[10] / (double)pc[3], (double)pc[3] / (double)pc[7]};
        out[0] += exp2f(rintf(log2f((float)sel[ATTN_PROBE]) * 3.0f) * (1.0f / 3.0f)); }
#endif
#ifdef EXTRA_BARRIERS
    for (int i_ = 0; i_ < EXTRA_BARRIERS; ++i_) xcd_barrier(bar);
#endif
#undef IN
#undef SEAM
}

#ifndef MK_N_LAUNCHES
#define MK_N_LAUNCHES 1
#endif
extern "C" void kernel_launch(void* const* d_in, const int* in_sizes, int n_in, void* d_out, int out_size, void* d_ws, size_t ws_size, hipStream_t stream) {
    static int grid = 0;
    if (grid == 0) {
        if (n_in != 15 || in_sizes[0] != M * DM || out_size != M * DM || ws_size < WS_END) {
            fprintf(stderr, "kernel_launch: built for 15 inputs, x/out of %d floats, >= %zu bytes of workspace; got n_in %d, in0 %d, out %d, ws %zu; nothing launched\n", M * DM, (size_t)WS_END, n_in, n_in > 0 ? in_sizes[0] : -1, out_size, ws_size);
            grid = -1; return; }
        int dev = 0, cus = 0, per_cu = 0;
        if (hipGetDevice(&dev) != hipSuccess || hipDeviceGetAttribute(&cus, hipDeviceAttributeMultiprocessorCount, dev) != hipSuccess) { fprintf(stderr, "kernel_launch: device query failed\n"); grid = -1; return; }
        if (hipFuncSetAttribute((const void*)moba_fwd, hipFuncAttributeMaxDynamicSharedMemorySize, LDS_BYTES) != hipSuccess) { fprintf(stderr, "kernel_launch: hipFuncSetAttribute failed\n"); grid = -1; return; }
        if (hipOccupancyMaxActiveBlocksPerMultiprocessor(&per_cu, (const void*)moba_fwd, NT, LDS_BYTES) != hipSuccess || per_cu < 1) { fprintf(stderr, "kernel_launch: occupancy query reports %d workgroups per CU\n", per_cu); per_cu = 1; }
        (void)hipGetLastError();
        grid = cus;
    }
    if (grid < 0) return;
    if (hipMemsetAsync((char*)d_ws + WS_CTL, 0, CTL_ZERO_BYTES, stream) != hipSuccess) { fprintf(stderr, "kernel_launch: memset failed\n"); return; }
    Args a{};
    for (int i = 0; i < 15; ++i) a.in[i] = (const float*)d_in[i];
    a.out = (float*)d_out; a.ws = (unsigned char*)d_ws;
    if (MK_N_LAUNCHES == 1) {
        a.ph_lo = 0; a.ph_hi = N_PHASES;
        hipLaunchKernelGGL(moba_fwd, dim3(grid), dim3(NT), LDS_BYTES, stream, a);
    } else {
        for (int p = 0; p < N_PHASES; ++p) { a.ph_lo = p; a.ph_hi = p + 1; hipLaunchKernelGGL(moba_fwd, dim3(grid), dim3(NT), LDS_BYTES, stream, a); }
    }
    const hipError_t le = hipPeekAtLastError();
    if (le != hipSuccess) fprintf(stderr, "kernel_launch: launch failed: %s\n", hipGetErrorName(le));
}
```
